# Optimizing an MI355X kernel written in HIP

```python
import jax
import jax.numpy as jnp
from jax import lax
import numpy as np

D_MODEL = 2048
BATCH = 4
SEQ = 2048
DEPTH = 2

GRID_W = 64
CTX_LEN = 256
D_FF = 5632
FFN_RES = 0.5
N_MOD = 9
ROPE_DIM = 64
ROPE_BASE = 10000.0
EPS = 1e-6
RET_HEADS = 6
RET_DK = ROPE_DIM
RET_DV = 128
RET_CHUNK = 128
CONV_CH = 512
CONV_W = 31
MLA_HEADS = 6
MLA_Q_RANK = 512
MLA_KV_RANK = 256
MLA_NOPE = 128
MLA_ROPE = ROPE_DIM
MLA_DV = 128
MLA_SCALE = (MLA_NOPE + MLA_ROPE) ** -0.5
Q_BLOCK = 128
RET_W = RET_HEADS * RET_DV
MLA_W = MLA_HEADS * MLA_DV
MIX_W = RET_W + CONV_CH + MLA_W
IN_SIZES = (
    ('rq', RET_HEADS * RET_DK),
    ('rk', RET_HEADS * RET_DK),
    ('rv', RET_W),
    ('rg', RET_W),
    ('glu', 2 * CONV_CH),
    ('cq', MLA_Q_RANK),
    ('ckv', MLA_KV_RANK),
    ('kr', MLA_ROPE),
)
IN_W = 2 * RET_HEADS * RET_DK + 2 * RET_W + 2 * CONV_CH + MLA_Q_RANK + MLA_KV_RANK + MLA_ROPE

kernel_name = 'hybrid_diffusion_retention_conformer_mla_block'


def rms_norm(x, g):
    xf = x.astype(jnp.float32)
    y = xf * lax.rsqrt(jnp.mean(xf * xf, axis=-1, keepdims=True) + EPS)
    return (y * g.astype(jnp.float32)).astype(x.dtype)


def layer_norm(x, g, b):
    xf = x.astype(jnp.float32)
    mu = jnp.mean(xf, axis=-1, keepdims=True)
    var = jnp.mean(jnp.square(xf - mu), axis=-1, keepdims=True)
    y = (xf - mu) * lax.rsqrt(var + EPS) * g.astype(jnp.float32) + b.astype(jnp.float32)
    return y.astype(x.dtype)


def modulate(h, shift, scale):
    return h * (1.0 + scale) + shift


def split_cols(p):
    out = {}
    off = 0
    for name, size in IN_SIZES:
        out[name] = p[..., off:off + size]
        off += size
    return out


def axial_rope_tables(rows, rot_dim):
    quarter = rot_dim // 4
    inv = ROPE_BASE ** (-jnp.arange(quarter, dtype=jnp.float32) / quarter)
    row = jnp.repeat(jnp.arange(rows, dtype=jnp.float32), GRID_W)
    col = jnp.tile(jnp.arange(GRID_W, dtype=jnp.float32), rows)
    ang = jnp.concatenate([row[:, None] * inv, col[:, None] * inv], axis=-1)
    return jnp.cos(ang), jnp.sin(ang)


def apply_rope(x, cos, sin):
    h = x.shape[-1] // 2
    x1 = x[..., :h].astype(jnp.float32)
    x2 = x[..., h:].astype(jnp.float32)
    out = jnp.concatenate([x1 * cos - x2 * sin, x1 * sin + x2 * cos], axis=-1)
    return out.astype(x.dtype)


def ffn_half(x, g_pre, g_post, shift, scale, gate, w_in, w_out):
    h = modulate(rms_norm(x, g_pre), shift, scale)
    a, u = jnp.split(h @ w_in, 2, axis=-1)
    y = (jax.nn.silu(a) * u) @ w_out
    return x + FFN_RES * gate * rms_norm(y, g_post)


def ret_log_gamma():
    return jnp.log1p(-jnp.exp2(-5.0 - jnp.arange(RET_HEADS, dtype=jnp.float32)))


def ret_heads(t, d, cos, sin):
    B, T, _ = t.shape
    t = t.reshape(B, T, RET_HEADS, d)
    if cos is not None:
        t = apply_rope(t, cos[:, None], sin[:, None])
    return jnp.swapaxes(t, 1, 2).astype(jnp.float32)


def retention_scan(q, k, v, log_g, s0, strict):
    B, H, T, _ = q.shape
    C = RET_CHUNK
    N = T // C

    def chunks(t):
        return jnp.moveaxis(t.reshape(B, H, N, C, t.shape[-1]), 2, 0)

    i = jnp.arange(C, dtype=jnp.float32)
    diff = i[:, None] - i[None, :]
    mask = diff > 0 if strict else diff >= 0
    decay = jnp.where(mask, jnp.exp(log_g[:, None, None] * jnp.maximum(diff, 0.0)), 0.0)
    q_dec = jnp.exp(log_g[:, None] * (i + 1.0))[:, :, None]
    k_dec = jnp.exp(log_g[:, None] * (C - 1.0 - i))[:, :, None]
    c_dec = jnp.exp(log_g * C)[:, None, None]

    def step(S, blk):
        qb, kb, vb = blk
        a = jnp.einsum('bhid,bhjd->bhij', qb, kb) * decay
        o = jnp.einsum('bhij,bhjv->bhiv', a, vb) + jnp.einsum('bhid,bhdv->bhiv', qb * q_dec, S)
        S = c_dec * S + jnp.einsum('bhjd,bhjv->bhdv', kb * k_dec, vb)
        return S, o

    S, o = lax.scan(step, s0, (chunks(q), chunks(k), chunks(v)))
    return jnp.moveaxis(o, 0, 2).reshape(B, H, T, v.shape[-1]), S


def bi_retention(q, k, v, log_g, s0_f, s0_b):
    o_f, s_f = retention_scan(q, k, v, log_g, s0_f, False)
    o_b, s_b = retention_scan(jnp.flip(q, 2), jnp.flip(k, 2), jnp.flip(v, 2), log_g, s0_b, True)
    return o_f + jnp.flip(o_b, 2), s_f, s_b


def ret_final_states(k, v, log_g):
    L = k.shape[2]
    m = jnp.arange(L, dtype=jnp.float32)
    w_f = jnp.exp(log_g[:, None] * (L - 1.0 - m))
    w_b = jnp.exp(log_g[:, None] * m)
    s_f = jnp.einsum('bhld,bhlv,hl->bhdv', k, v, w_f)
    s_b = jnp.einsum('bhld,bhlv,hl->bhdv', k, v, w_b)
    return s_f, s_b


def ret_output(o, g, gn):
    mu = jnp.mean(o, axis=-1, keepdims=True)
    var = jnp.mean(jnp.square(o - mu), axis=-1, keepdims=True)
    o = (o - mu) * lax.rsqrt(var + EPS)
    B, H, T, dv = o.shape
    o = jnp.swapaxes(o, 1, 2).reshape(B, T, H * dv) * gn.astype(jnp.float32)
    return (jax.nn.silu(g.astype(jnp.float32)) * o).astype(g.dtype)


def conformer_conv(glu_in, dw, dw_b, ln_g, ln_b, pw):
    a, b = jnp.split(glu_in, 2, axis=-1)
    u = a * jax.nn.sigmoid(b)
    u = lax.conv_general_dilated(
        u, dw[:, None, :].astype(u.dtype), window_strides=(1,),
        padding=((CONV_W // 2, CONV_W // 2),),
        dimension_numbers=('NWC', 'WIO', 'NWC'),
        feature_group_count=CONV_CH) + dw_b
    u = jax.nn.silu(layer_norm(u, ln_g, ln_b))
    return u @ pw


def mla_q(cq, q_norm, w_uq, cos, sin):
    B, T, _ = cq.shape
    q = (rms_norm(cq, q_norm) @ w_uq).reshape(B, T, MLA_HEADS, MLA_NOPE + MLA_ROPE)
    if cos is not None:
        q = jnp.concatenate([q[..., :MLA_NOPE], apply_rope(q[..., MLA_NOPE:], cos[:, None], sin[:, None])], axis=-1)
    return q


def mla_kv(ckv, kr, kv_norm, w_ukv, cos, sin):
    B, T, _ = ckv.shape
    kv = (rms_norm(ckv, kv_norm) @ w_ukv).reshape(B, T, MLA_HEADS, MLA_NOPE + MLA_DV)
    k_nope, v = kv[..., :MLA_NOPE], kv[..., MLA_NOPE:]
    if cos is not None:
        kr = apply_rope(kr, cos, sin)
    k = jnp.concatenate([k_nope, jnp.broadcast_to(kr[:, :, None, :], (B, T, MLA_HEADS, MLA_ROPE))], axis=-1)
    return k, v


def softmax_attend(q, k, v):
    s = jnp.einsum('bqhd,bkhd->bhqk', q.astype(jnp.float32), k.astype(jnp.float32)) * MLA_SCALE
    p = jax.nn.softmax(s, axis=-1)
    return jnp.einsum('bhqk,bkhv->bqhv', p, v.astype(jnp.float32)).astype(v.dtype)


def latent_attention(q, k_lat, v_lat, k_ctx, v_ctx):
    k = jnp.concatenate([k_ctx, k_lat], axis=1)
    v = jnp.concatenate([v_ctx, v_lat], axis=1)
    B, S, H, d = q.shape
    qb = jnp.moveaxis(q.reshape(B, S // Q_BLOCK, Q_BLOCK, H, d), 1, 0)
    o = lax.map(lambda blk: softmax_attend(blk, k, v), qb)
    return jnp.moveaxis(o, 0, 1).reshape(B, S, H * MLA_DV)


def token_mix(hx, hc, cos, sin, w_in, w_out, ret_gn, cv_dw, cv_dw_b, cv_ln_g, cv_ln_b, cv_pw,
              q_norm, w_uq, kv_norm, w_ukv, ctx_out):
    B, L, _ = hc.shape
    log_g = ret_log_gamma()
    px = split_cols(hx @ w_in)
    if ctx_out:
        pc = split_cols(hc @ w_in)
    else:
        wb = split_cols(w_in)
        pc = {n: hc @ wb[n] for n in ('rk', 'rv', 'ckv', 'kr')}

    kc = ret_heads(pc['rk'], RET_DK, None, None) * RET_DK ** -0.5
    vc = ret_heads(pc['rv'], RET_DV, None, None)
    qx = ret_heads(px['rq'], RET_DK, cos, sin)
    kx = ret_heads(px['rk'], RET_DK, cos, sin) * RET_DK ** -0.5
    vx = ret_heads(px['rv'], RET_DV, None, None)
    if ctx_out:
        qc = ret_heads(pc['rq'], RET_DK, None, None)
        zero = jnp.zeros((B, RET_HEADS, RET_DK, RET_DV), jnp.float32)
        oc_ret, s_f, s_b = bi_retention(qc, kc, vc, log_g, zero, zero)
    else:
        s_f, s_b = ret_final_states(kc, vc, log_g)
    ox_ret, _, _ = bi_retention(qx, kx, vx, log_g, s_f, s_b)
    yx_ret = ret_output(ox_ret, px['rg'], ret_gn)

    yx_conv = conformer_conv(px['glu'], cv_dw, cv_dw_b, cv_ln_g, cv_ln_b, cv_pw)

    k_c, v_c = mla_kv(pc['ckv'], pc['kr'], kv_norm, w_ukv, None, None)
    k_x, v_x = mla_kv(px['ckv'], px['kr'], kv_norm, w_ukv, cos, sin)
    q_x = mla_q(px['cq'], q_norm, w_uq, cos, sin)
    yx_mla = latent_attention(q_x, k_x, v_x, k_c, v_c)

    yx = jnp.concatenate([yx_ret, yx_conv, yx_mla], axis=-1) @ w_out
    if not ctx_out:
        return yx, None

    yc_ret = ret_output(oc_ret, pc['rg'], ret_gn)
    yc_conv = conformer_conv(pc['glu'], cv_dw, cv_dw_b, cv_ln_g, cv_ln_b, cv_pw)
    q_c = mla_q(pc['cq'], q_norm, w_uq, None, None)
    yc_mla = softmax_attend(q_c, k_c, v_c).reshape(B, L, MLA_W)
    yc = jnp.concatenate([yc_ret, yc_conv, yc_mla], axis=-1) @ w_out
    return yx, yc


def setup_inputs(seed: int = 0) -> dict:
    key = jax.random.key(seed)
    ks = jax.random.split(key, 24)
    f32 = jnp.float32
    L, D = DEPTH, D_MODEL

    def w(k, shape, fan_in, scale=1.0):
        return jax.random.normal(k, shape, f32) * (scale * fan_in ** -0.5)

    def gain(k, shape):
        return 1.0 + 0.02 * jax.random.normal(k, shape, f32)

    def small(k, shape):
        return 0.01 * jax.random.normal(k, shape, f32)

    return {
        'x': jax.random.normal(ks[0], (BATCH, SEQ, D), f32),
        'c': jax.random.normal(ks[1], (BATCH, D), f32),
        'ctx': jax.random.normal(ks[2], (BATCH, CTX_LEN, D), f32),
        'c_ctx': jax.random.normal(ks[3], (D,), f32),
        'w_ada': w(ks[4], (L, D, N_MOD * D), D, 0.5),
        'b_ada': small(ks[5], (L, N_MOD * D)),
        'norm_g': gain(ks[6], (L, 6, D)),
        'w_ffa_in': w(ks[7], (L, D, 2 * D_FF), D),
        'w_ffa_out': w(ks[8], (L, D_FF, D), D_FF),
        'w_ffb_in': w(ks[9], (L, D, 2 * D_FF), D),
        'w_ffb_out': w(ks[10], (L, D_FF, D), D_FF),
        'w_in': w(ks[11], (L, D, IN_W), D),
        'w_out': w(ks[12], (L, MIX_W, D), MIX_W),
        'ret_gn': gain(ks[13], (L, RET_W)),
        'cv_dw': w(ks[14], (L, CONV_W, CONV_CH), CONV_W),
        'cv_dw_b': small(ks[15], (L, CONV_CH)),
        'cv_ln_g': gain(ks[16], (L, CONV_CH)),
        'cv_ln_b': small(ks[17], (L, CONV_CH)),
        'cv_pw': w(ks[18], (L, CONV_CH, CONV_CH), CONV_CH),
        'mla_q_norm': gain(ks[19], (L, MLA_Q_RANK)),
        'w_uq': w(ks[20], (L, MLA_Q_RANK, MLA_HEADS * (MLA_NOPE + MLA_ROPE)), MLA_Q_RANK),
        'mla_kv_norm': gain(ks[21], (L, MLA_KV_RANK)),
        'w_ukv': w(ks[22], (L, MLA_KV_RANK, MLA_HEADS * (MLA_NOPE + MLA_DV)), MLA_KV_RANK),
    }


def reference(x, c, ctx, c_ctx, w_ada, b_ada, norm_g, w_ffa_in, w_ffa_out, w_ffb_in, w_ffb_out,
              w_in, w_out, ret_gn, cv_dw, cv_dw_b, cv_ln_g, cv_ln_b, cv_pw,
              mla_q_norm, w_uq, mla_kv_norm, w_ukv):
    B, S, D = x.shape
    rows = S // GRID_W
    cos, sin = axial_rope_tables(rows, ROPE_DIM)
    sc = jax.nn.silu(c)
    scc = jax.nn.silu(c_ctx)
    cx = ctx
    for l in range(DEPTH):
        last = l == DEPTH - 1
        mx = (sc @ w_ada[l] + b_ada[l]).reshape(B, N_MOD, D)
        mc = (scc @ w_ada[l] + b_ada[l]).reshape(N_MOD, D)
        ng = norm_g[l]

        x = ffn_half(x, ng[0], ng[1], mx[:, 0:1], mx[:, 1:2], mx[:, 2:3], w_ffa_in[l], w_ffa_out[l])
        cx = ffn_half(cx, ng[0], ng[1], mc[0], mc[1], mc[2], w_ffa_in[l], w_ffa_out[l])

        hx = modulate(rms_norm(x, ng[2]), mx[:, 3:4], mx[:, 4:5])
        hc = modulate(rms_norm(cx, ng[2]), mc[3], mc[4])
        yx, yc = token_mix(hx, hc, cos, sin, w_in[l], w_out[l], ret_gn[l], cv_dw[l], cv_dw_b[l],
                           cv_ln_g[l], cv_ln_b[l], cv_pw[l], mla_q_norm[l], w_uq[l],
                           mla_kv_norm[l], w_ukv[l], not last)
        x = x + mx[:, 5:6] * rms_norm(yx, ng[3])

        x = ffn_half(x, ng[4], ng[5], mx[:, 6:7], mx[:, 7:8], mx[:, 8:9], w_ffb_in[l], w_ffb_out[l])
        if not last:
            cx = cx + mc[5] * rms_norm(yc, ng[3])
            cx = ffn_half(cx, ng[4], ng[5], mc[6], mc[7], mc[8], w_ffb_in[l], w_ffb_out[l])
    return x
```

```cpp
#include <hip/hip_runtime.h>
#include <hip/hip_cooperative_groups.h>
#include <cstdio>
namespace cg = cooperative_groups;

#define ONE_LAUNCH 0
namespace pg8 {
#define PG8_LAS __attribute__((address_space(3)))
typedef unsigned short bf16_t;
typedef short bf16x8 __attribute__((ext_vector_type(8)));
typedef float f32x4 __attribute__((ext_vector_type(4)));
typedef unsigned u32x4 __attribute__((ext_vector_type(4)));
constexpr int BM = 256, BK = 64, HALF = 128, HTB = HALF * BK * 2  , STAGE_BYTES = 8 * HTB, NXCD = 8, WGM = 8;

__host__ __device__ __forceinline__ int lds_byte(int r, int c) { const int st = (r >> 4) * 2 + (c >> 5), rr = r & 15, cc = c & 31, ob = rr * 64 + cc * 2; return st * 1024 + (ob ^ (((ob >> 9) & 1) << 5)); }
__host__ __device__ __forceinline__ void stage_rc(int b, int& R, int& C) { const int st = b / 1024, sb = b % 1024, swz = sb ^ (((sb >> 9) & 1) << 5); R = (st >> 1) * 16 + swz / 64; C = (st & 1) * 32 + (swz % 64) / 2; }
__host__ __device__ __forceinline__ int perm32(int rho) { const int n = rho >> 4, i = rho & 15; return 8 * (i >> 2) + 4 * n + (i & 3); }

struct Unit { int pm, pn; };
struct Gemm { const bf16_t* A; const bf16_t* Bt; int M, N, K; };

struct StaticOrder {
    int nM, nN, nwg, G, c;
    __host__ __device__ void init(int M, int N, int G_, int c_) { nM = M / BM; nN = N / BM; nwg = nM * nN; G = G_; c = c_; }
    __host__ __device__ bool next(int i, Unit& u) const {
        const long L = (long)i * G + c; if (L >= nwg) return false;
        int wgid = (int)L; { const int q = nwg / NXCD, r = nwg % NXCD, xcd = wgid % NXCD, off = wgid / NXCD; wgid = (xcd < r ? xcd * (q + 1) : r * (q + 1) + (xcd - r) * q) + off; }
        const int nig = WGM * nN, gid = wgid / nig, fm = gid * WGM, gsz = (nM - fm) < WGM ? (nM - fm) : WGM;
        u.pm = fm + ((wgid % nig) % gsz); u.pn = (wgid % nig) / gsz; return true;
    }
    __device__ __forceinline__ void a_ready(const Unit&) const {}
    __device__ __forceinline__ void done(const Unit&) const {}
};
__device__ __forceinline__ unsigned cvt_pk_bf16(float lo, float hi) { unsigned r; asm volatile("v_cvt_pk_bf16_f32 %0, %1, %2" : "=v"(r) : "v"(lo), "v"(hi)); return r; }
typedef float f32x2 __attribute__((ext_vector_type(2)));

template <class Epi, class Sched, bool STAMP = false>
__device__ __forceinline__ void gemm_phase(PG8_LAS unsigned char* lds, const Gemm g, const Sched& S, const Epi& E, unsigned long long* stamps) {
    const int tid = threadIdx.x, wid = __builtin_amdgcn_readfirstlane(tid >> 6), lane = tid & 63, wr = wid >> 2, wc = wid & 3, fr = lane & 15, fq = lane >> 4;
    const int K = g.K, nt = K / BK;
    int ts_lo = 0, ts_hi = 0, nts = 0; const unsigned long long rt_entry = STAMP ? (unsigned long long)wall_clock64() : 0ull;
#define PG8_STAMP() do { if (STAMP && wid == 0 && nts < 64) { const unsigned long long _c = (unsigned long long)clock64(); \
        ts_lo = (lane == nts) ? (int)(unsigned)_c : ts_lo; ts_hi = (lane == nts) ? (int)(unsigned)(_c >> 32) : ts_hi; ++nts; } } while (0)
    PG8_STAMP();
    unsigned voffA[2], voffB[2];
#pragma unroll
    for (int i = 0; i < 2; ++i) { int R, C; stage_rc(tid * 16 + i * 8192, R, C); const int Rb = Epi::PERM ? ((R & ~31) + perm32(R & 31)) : R;
        voffA[i] = (unsigned)(R * K + C) * 2u; voffB[i] = (unsigned)(Rb * K + C) * 2u; }
    const size_t kstep = (size_t)(BK * 2);
    const size_t hstep = (size_t)HALF * K * 2;
    const size_t tstep = 2 * hstep;
    const unsigned ldsw = (unsigned)wid * 1024u;
    const int aoff = lds_byte(wr * 64 + fr, fq * 8), boff = lds_byte(wc * 32 + fr, fq * 8);
#define PG8_SA(b, h) (((b) * 2 + (h)) * HTB)
#define PG8_SB(b, h) ((4 + (b) * 2 + (h)) * HTB)
#define PG8_STAGE(bufoff, gbase, voff) do { _Pragma("unroll") for (int _i = 0; _i < 2; ++_i) \
        __builtin_amdgcn_global_load_lds((const unsigned*)((const char*)(gbase) + (voff)[_i]), (PG8_LAS unsigned*)(lds + (bufoff) + ldsw + _i * 8192), 16, 0, 0); } while (0)
#define PG8_LDA(dst, b, h) do { _Pragma("unroll") for (int m = 0; m < 4; ++m) _Pragma("unroll") for (int k = 0; k < 2; ++k) dst[m][k] = *(const PG8_LAS bf16x8*)(lds + PG8_SA(b, h) + aoff + m * 2048 + k * 1024); } while (0)
#define PG8_LDB(dst, b, h) do { _Pragma("unroll") for (int n = 0; n < 2; ++n) _Pragma("unroll") for (int k = 0; k < 2; ++k) dst[n][k] = *(const PG8_LAS bf16x8*)(lds + PG8_SB(b, h) + boff + n * 2048 + k * 1024); } while (0)
#define PG8_MMA(ai, bj, At, Bt) do { __builtin_amdgcn_s_setprio(1); _Pragma("unroll") for (int m = 0; m < 4; ++m) _Pragma("unroll") for (int n = 0; n < 2; ++n) _Pragma("unroll") for (int k = 0; k < 2; ++k) \
        acc[ai][bj][m][n] = __builtin_amdgcn_mfma_f32_16x16x32_bf16(Bt[n][k], At[m][k], acc[ai][bj][m][n], 0, 0, 0); __builtin_amdgcn_s_setprio(0); } while (0)
#define PG8_WAIT_V(n) asm volatile("s_waitcnt vmcnt(" #n ")" ::: "memory")
#define PG8_WAIT_L(n) asm volatile("s_waitcnt lgkmcnt(" #n ")" ::: "memory")
#define PG8_BAR __builtin_amdgcn_s_barrier()
#define PG8_SCHED __builtin_amdgcn_sched_barrier(0)
    Unit cur, nxt; int ui = 0;
    if (!S.next(0, cur)) return;
    f32x4 acc[2][2][4][2];
#pragma unroll
    for (int a = 0; a < 2; ++a)
#pragma unroll
        for (int b = 0; b < 2; ++b)
#pragma unroll
            for (int m = 0; m < 4; ++m)
#pragma unroll
                for (int n = 0; n < 2; ++n) acc[a][b][m][n] = (f32x4){0.f, 0.f, 0.f, 0.f};
    bf16x8 At[4][2], B0[2][2], B1[2][2];
    const char* cA = (const char*)g.A + (size_t)cur.pm * tstep; const char* cB = (const char*)g.Bt + (size_t)cur.pn * tstep;
    S.a_ready(cur);
    PG8_STAGE(PG8_SB(0, 0), cB, voffB); PG8_STAGE(PG8_SA(0, 0), cA, voffA); PG8_STAGE(PG8_SB(0, 1), cB + hstep, voffB); PG8_STAGE(PG8_SA(0, 1), cA + hstep, voffA);
    if (wr == 1) PG8_BAR;
    PG8_WAIT_V(4); PG8_BAR;
    PG8_STAGE(PG8_SB(1, 0), cB + kstep, voffB); PG8_STAGE(PG8_SA(1, 0), cA + kstep, voffA); PG8_STAGE(PG8_SB(1, 1), cB + hstep + kstep, voffB);
    PG8_WAIT_V(6); PG8_BAR;
    PG8_STAMP();
    for (;;) {
        const bool has_next = S.next(ui + 1, nxt);
        const char* nA = has_next ? (const char*)g.A + (size_t)nxt.pm * tstep : cA; const char* nB = has_next ? (const char*)g.Bt + (size_t)nxt.pn * tstep : cB;
        for (int t = 0; t < nt; t += 2) {
            const bool last = (t == nt - 2);
            const char* a1 = cA + (size_t)(t + 1) * kstep;
            const char* a2 = last ? nA : cA + (size_t)(t + 2) * kstep; const char* b2 = last ? nB : cB + (size_t)(t + 2) * kstep;
            const char* a3 = a2 + kstep; const char* b3 = b2 + kstep;
            if (last && has_next) S.a_ready(nxt);
            PG8_LDB(B0, 0, 0); PG8_SCHED; PG8_LDA(At, 0, 0); PG8_STAGE(PG8_SA(1, 1), a1 + hstep, voffA);
            PG8_WAIT_L(8); PG8_BAR; PG8_WAIT_L(0); PG8_MMA(0, 0, At, B0); PG8_BAR; PG8_SCHED;
            PG8_LDB(B1, 0, 1); PG8_STAGE(PG8_SB(0, 0), b2, voffB);
            PG8_BAR; PG8_WAIT_L(0); PG8_MMA(0, 1, At, B1); PG8_BAR;
            PG8_LDA(At, 0, 1); PG8_STAGE(PG8_SA(0, 0), a2, voffA);
            PG8_BAR; PG8_WAIT_L(0); PG8_MMA(1, 0, At, B0); PG8_BAR; PG8_SCHED;
            PG8_STAGE(PG8_SB(0, 1), b2 + hstep, voffB);
            PG8_WAIT_V(6); PG8_BAR; PG8_MMA(1, 1, At, B1); PG8_BAR;
            PG8_LDB(B0, 1, 0); PG8_SCHED; PG8_LDA(At, 1, 0); PG8_STAGE(PG8_SA(0, 1), a2 + hstep, voffA);
            PG8_WAIT_L(8); PG8_BAR; PG8_WAIT_L(0); PG8_MMA(0, 0, At, B0); PG8_BAR; PG8_SCHED;
            PG8_LDB(B1, 1, 1); PG8_STAGE(PG8_SB(1, 0), b3, voffB);
            PG8_BAR; PG8_WAIT_L(0); PG8_MMA(0, 1, At, B1); PG8_BAR;
            PG8_LDA(At, 1, 1); PG8_STAGE(PG8_SA(1, 0), a3, voffA);
            PG8_BAR; PG8_WAIT_L(0); PG8_MMA(1, 0, At, B0); PG8_BAR; PG8_SCHED;
            PG8_STAGE(PG8_SB(1, 1), b3 + hstep, voffB);
            PG8_WAIT_V(6); PG8_BAR; PG8_MMA(1, 1, At, B1); PG8_BAR;
        }
        PG8_STAMP();
        if constexpr (!Epi::AFTER_DRAIN) { E(acc, cur, wr, wc, fr, fq); S.done(cur); }
        PG8_STAMP();
        if (!has_next) break;
#pragma unroll
        for (int a = 0; a < 2; ++a)
#pragma unroll
            for (int b = 0; b < 2; ++b)
#pragma unroll
                for (int m = 0; m < 4; ++m)
#pragma unroll
                    for (int n = 0; n < 2; ++n) acc[a][b][m][n] = (f32x4){0.f, 0.f, 0.f, 0.f};
        cur = nxt; cA = nA; cB = nB; ++ui;
    }
    PG8_WAIT_V(0);
    if (wr == 0) PG8_BAR;
    PG8_BAR;
    if constexpr (Epi::AFTER_DRAIN) { E.fused(acc, cur, wr, wc, fr, fq, lds, wid, lane); S.done(cur); }
    PG8_STAMP();
    if (STAMP && wid == 0) { stamps[lane] = lane < nts ? (((unsigned long long)(unsigned)ts_hi << 32) | (unsigned)ts_lo) : 0ull;
        if (lane == 62) stamps[62] = rt_entry; if (lane == 63) stamps[63] = (unsigned long long)wall_clock64(); }
#undef PG8_STAMP
#undef PG8_SA
#undef PG8_SB
#undef PG8_STAGE
#undef PG8_LDA
#undef PG8_LDB
#undef PG8_MMA
#undef PG8_WAIT_V
#undef PG8_WAIT_L
#undef PG8_BAR
#undef PG8_SCHED
}
}

using namespace pg8;
#define LAS PG8_LAS
typedef unsigned u32x2 __attribute__((ext_vector_type(2)));

constexpr int D = 2048, NBATCH = 4, SEQ = 2048, CTXL = 256, DFF = 5632;
constexpr int MLAT = NBATCH * SEQ, MCTX = NBATCH * CTXL, MR = MLAT + MCTX;
constexpr int INW = 4160, INWP = 4352;
constexpr int OFF_RQ = 0, OFF_RK = 384, OFF_RV = 768, OFF_RG = 1536, OFF_GLU = 2304, OFF_CQ = 3328, OFF_CKV = 3840, OFF_KR = 4096;
constexpr int NKEY = CTXL + SEQ;
constexpr int NCH = 18;
constexpr float EPS = 1e-6f;
constexpr int NTHR = 512;
constexpr int LDS_BYTES = 151552;

constexpr size_t SZ_WFFIN = (size_t)2 * DFF * D * 2;
constexpr size_t SZ_WFFOUT = (size_t)D * DFF * 2;
constexpr size_t SZ_WIN = (size_t)INWP * D * 2;
constexpr size_t SZ_WOUT = (size_t)D * D * 2;
constexpr size_t SZ_WUQ = (size_t)1280 * 512 * 2;
constexpr size_t SZ_WUKV = (size_t)1536 * 256 * 2;
constexpr size_t SZ_WPW = (size_t)512 * 512 * 2;
constexpr size_t WS_WFFIN = 0;
constexpr size_t WS_WFFOUT = WS_WFFIN + 4 * SZ_WFFIN;
constexpr size_t WS_WIN = WS_WFFOUT + 4 * SZ_WFFOUT;
constexpr size_t WS_WOUT = WS_WIN + 2 * SZ_WIN;
constexpr size_t WS_WUQ = WS_WOUT + 2 * SZ_WOUT;
constexpr size_t WS_WUKV = WS_WUQ + 2 * SZ_WUQ;
constexpr size_t WS_WPW = WS_WUKV + 2 * SZ_WUKV;
constexpr size_t WS_MOD = WS_WPW + 2 * SZ_WPW;
constexpr size_t WS_X = WS_MOD + (size_t)2 * 5 * 18432 * 4;
constexpr size_t WS_H = WS_X + (size_t)MR * D * 4;
constexpr size_t WS_Y = WS_H + (size_t)MR * D * 2;
constexpr size_t WS_P = WS_Y + (size_t)MR * D * 4;
constexpr size_t WS_QR = WS_P + (size_t)MR * INWP * 4;
constexpr size_t WS_KR = WS_QR + (size_t)MR * 384 * 4;
constexpr size_t WS_CQN = WS_KR + (size_t)MR * 384 * 4;
constexpr size_t WS_CKVN = WS_CQN + (size_t)MR * 512 * 2;
constexpr size_t WS_CVN = WS_CKVN + (size_t)MR * 256 * 2;
constexpr size_t WS_QF = WS_CVN + (size_t)MR * 512 * 2;
constexpr size_t WS_KVF = WS_QF + (size_t)MR * 1280 * 4;
constexpr size_t WS_QB = WS_KVF + (size_t)MR * 1536 * 4;
constexpr size_t WS_KB = WS_QB + (size_t)NBATCH * 6 * NKEY * 192 * 2;
constexpr size_t WS_VT = WS_KB + (size_t)NBATCH * 6 * NKEY * 192 * 2;
constexpr size_t WS_CAT = WS_VT + (size_t)NBATCH * 6 * 128 * NKEY * 2;
constexpr size_t WS_SF = WS_CAT + (size_t)MR * D * 2;
constexpr size_t WS_SB = WS_SF + (size_t)NBATCH * 6 * NCH * 8192 * 4;
constexpr size_t WS_END = WS_SB + (size_t)NBATCH * 6 * NCH * 8192 * 4;

struct Args { const float* in[23]; float* out; unsigned char* ws; int ph_lo, ph_hi; };

__device__ __forceinline__ float wave_sum(float v) {
#pragma unroll
    for (int o = 32; o; o >>= 1) v += __shfl_xor(v, o);
    return v;
}
__device__ __forceinline__ float siluf(float a) { return a / (1.f + __expf(-a)); }
__device__ __forceinline__ float sigmf(float a) { return 1.f / (1.f + __expf(-a)); }
__device__ __forceinline__ bf16_t f2bf(float f) { unsigned u = __float_as_uint(f); u += 0x7FFFu + ((u >> 16) & 1u); return (bf16_t)(u >> 16); }
__device__ __forceinline__ int mod_of_row(int row) { return row < MLAT ? (row >> 11) : 4; }

__device__ __forceinline__ void get_tjob(const Args& a, int j, const float*& src, bf16_t*& dst, int& K, int& Nsrc, int& Ndst, int& mode) {
    const int l = j / 9, t = j % 9; unsigned char* ws = a.ws; mode = 0;
    if (t == 0)      { src = a.in[7] + (size_t)l * D * 2 * DFF;  dst = (bf16_t*)(ws + WS_WFFIN + (size_t)(l * 2 + 0) * SZ_WFFIN);  K = D;   Nsrc = 2 * DFF; Ndst = 2 * DFF; mode = 1; }
    else if (t == 1) { src = a.in[8] + (size_t)l * DFF * D;      dst = (bf16_t*)(ws + WS_WFFOUT + (size_t)(l * 2 + 0) * SZ_WFFOUT); K = DFF; Nsrc = D; Ndst = D; }
    else if (t == 2) { src = a.in[9] + (size_t)l * D * 2 * DFF;  dst = (bf16_t*)(ws + WS_WFFIN + (size_t)(l * 2 + 1) * SZ_WFFIN);  K = D;   Nsrc = 2 * DFF; Ndst = 2 * DFF; mode = 1; }
    else if (t == 3) { src = a.in[10] + (size_t)l * DFF * D;     dst = (bf16_t*)(ws + WS_WFFOUT + (size_t)(l * 2 + 1) * SZ_WFFOUT); K = DFF; Nsrc = D; Ndst = D; }
    else if (t == 4) { src = a.in[11] + (size_t)l * D * INW;     dst = (bf16_t*)(ws + WS_WIN + (size_t)l * SZ_WIN);   K = D;   Nsrc = INW;  Ndst = INWP; }
    else if (t == 5) { src = a.in[12] + (size_t)l * D * D;       dst = (bf16_t*)(ws + WS_WOUT + (size_t)l * SZ_WOUT); K = D;   Nsrc = D;    Ndst = D; }
    else if (t == 6) { src = a.in[20] + (size_t)l * 512 * 1152;  dst = (bf16_t*)(ws + WS_WUQ + (size_t)l * SZ_WUQ);   K = 512; Nsrc = 1152; Ndst = 1280; }
    else if (t == 7) { src = a.in[22] + (size_t)l * 256 * 1536;  dst = (bf16_t*)(ws + WS_WUKV + (size_t)l * SZ_WUKV); K = 256; Nsrc = 1536; Ndst = 1536; }
    else             { src = a.in[18] + (size_t)l * 512 * 512;   dst = (bf16_t*)(ws + WS_WPW + (size_t)l * SZ_WPW);   K = 512; Nsrc = 512;  Ndst = 512; }
}

__device__ void phase_prologue(const Args& a, LAS unsigned char* lds) {
    const int tid = threadIdx.x, G = gridDim.x, bid = blockIdx.x;
    LAS float* sl = (LAS float*)lds;
    LAS float* red = (LAS float*)(lds + 40960);
    LAS float* tl = (LAS float*)(lds + 65536);
    constexpr int NADA = 2 * 288;
    if (bid < NADA) {
        for (int i = tid; i < 5 * 2048; i += NTHR) { const int m = i >> 11, k = i & 2047; const float c = m < 4 ? a.in[1][m * 2048 + k] : a.in[3][k]; sl[i] = siluf(c); }
        __syncthreads();
    }
    int ntiles = 0;
    for (int j = 0; j < 18; ++j) { const float* s; bf16_t* d; int K, Ns, Nd, md; get_tjob(a, j, s, d, K, Ns, Nd, md); ntiles += (K >> 6) * (Nd >> 6); }
    float* MOD = (float*)(a.ws + WS_MOD);
    for (int it = bid; it < NADA + ntiles; it += G) {
        if (it < NADA) {
            const int l = it / 288, n0 = (it % 288) * 64, col = tid & 63, ks = tid >> 6;
            const float* w = a.in[4] + (size_t)l * 2048 * 18432 + n0 + col;
            float acc[5] = {0.f, 0.f, 0.f, 0.f, 0.f};
#pragma unroll 8
            for (int k = ks * 256; k < ks * 256 + 256; ++k) {
                const float wv = w[(size_t)k * 18432];
#pragma unroll
                for (int m = 0; m < 5; ++m) acc[m] += sl[m * 2048 + k] * wv;
            }
#pragma unroll
            for (int m = 0; m < 5; ++m) red[(ks * 5 + m) * 64 + col] = acc[m];
            __syncthreads();
            if (tid < 320) { const int m = tid >> 6, c = tid & 63; float s = 0.f;
#pragma unroll
                for (int q = 0; q < 8; ++q) s += red[(q * 5 + m) * 64 + c];
                MOD[((size_t)l * 5 + m) * 18432 + n0 + c] = s + a.in[5][l * 18432 + n0 + c]; }
            __syncthreads();
        } else {
            int tile = it - NADA; const float* src = nullptr; bf16_t* dst = nullptr; int K = 0, Nsrc = 0, Ndst = 0, mode = 0;
            for (int j = 0; j < 18; ++j) { get_tjob(a, j, src, dst, K, Nsrc, Ndst, mode); const int c = (K >> 6) * (Ndst >> 6); if (tile < c) break; tile -= c; }
            const int ntn = Ndst >> 6, tk = tile / ntn, tn = tile % ntn, k0 = tk * 64, n0 = tn * 64;
            { const int nn = tid & 63, kq = tid >> 6, ncol = n0 + nn;
              int scol = ncol; if (mode) { const int g32 = ncol >> 5, r = ncol & 31; scol = (r < 16) ? g32 * 16 + r : DFF + g32 * 16 + (r - 16); }
              const bool valid = scol < Nsrc;
#pragma unroll
              for (int i = 0; i < 8; ++i) { const int kk = kq + 8 * i; tl[kk * 65 + nn] = valid ? src[(size_t)(k0 + kk) * Nsrc + scol] : 0.f; } }
            __syncthreads();
            { const int n2 = tid >> 3, k8 = (tid & 7) * 8; float v[8];
#pragma unroll
              for (int j = 0; j < 8; ++j) v[j] = tl[(k8 + j) * 65 + n2];
              u32x4 w; w.x = cvt_pk_bf16(v[0], v[1]); w.y = cvt_pk_bf16(v[2], v[3]); w.z = cvt_pk_bf16(v[4], v[5]); w.w = cvt_pk_bf16(v[6], v[7]);
              *(u32x4*)(dst + (size_t)(n0 + n2) * K + k0 + k8) = w; }
            __syncthreads();
        }
    }
}

__device__ __forceinline__ void norm_mod_store(const f32x4 (&x)[8], const float* g, const float* shift, const float* scale, bf16_t* hrow, int lane) {
    float ss = 0.f;
#pragma unroll
    for (int i = 0; i < 8; ++i) ss += (x[i][0] * x[i][0] + x[i][1] * x[i][1]) + (x[i][2] * x[i][2] + x[i][3] * x[i][3]);
    ss = wave_sum(ss);
    const float r = rsqrtf(ss * (1.f / 2048.f) + EPS);
#pragma unroll
    for (int i = 0; i < 8; ++i) { const int c = lane * 4 + i * 256;
        const f32x4 gv = *(const f32x4*)(g + c), sh = *(const f32x4*)(shift + c), sc = *(const f32x4*)(scale + c);
        const f32x4 h = (x[i] * r * gv) * (sc + 1.f) + sh;
        u32x2 w; w.x = cvt_pk_bf16(h[0], h[1]); w.y = cvt_pk_bf16(h[2], h[3]);
        *(u32x2*)(hrow + c) = w; }
}

__device__ void phase_norm0(const Args& a) {
    const int lane = threadIdx.x & 63, gw = blockIdx.x * 8 + (threadIdx.x >> 6), nw = gridDim.x * 8;
    float* X = (float*)(a.ws + WS_X); bf16_t* H = (bf16_t*)(a.ws + WS_H); const float* MOD = (const float*)(a.ws + WS_MOD);
    for (int row = gw; row < MR; row += nw) {
        const float* src = row < MLAT ? a.in[0] + (size_t)row * D : a.in[2] + (size_t)(row - MLAT) * D;
        f32x4 x[8];
#pragma unroll
        for (int i = 0; i < 8; ++i) { x[i] = *(const f32x4*)(src + lane * 4 + i * 256); *(f32x4*)(X + (size_t)row * D + lane * 4 + i * 256) = x[i]; }
        const float* md = MOD + (size_t)mod_of_row(row) * 18432;
        norm_mod_store(x, a.in[6] + 0 * D, md + 0 * D, md + 1 * D, H + (size_t)row * D, lane);
    }
}

__device__ void phase_resnorm(const Args& a, int l, int gi_post, int mi_gate, float rs, bool has_next, int ln, int gi_pre, int mi_shift, int mi_scale, bool final_out, int M) {
    const int lane = threadIdx.x & 63, gw = blockIdx.x * 8 + (threadIdx.x >> 6), nw = gridDim.x * 8;
    float* X = (float*)(a.ws + WS_X); const float* Y = (const float*)(a.ws + WS_Y); bf16_t* H = (bf16_t*)(a.ws + WS_H); const float* MOD = (const float*)(a.ws + WS_MOD);
    const float* gpost = a.in[6] + (size_t)(l * 6 + gi_post) * D;
    for (int row = gw; row < M; row += nw) {
        const int m = mod_of_row(row);
        const float* gate = MOD + ((size_t)l * 5 + m) * 18432 + (size_t)mi_gate * D;
        f32x4 y[8]; float ss = 0.f;
#pragma unroll
        for (int i = 0; i < 8; ++i) { y[i] = *(const f32x4*)(Y + (size_t)row * D + lane * 4 + i * 256); ss += (y[i][0] * y[i][0] + y[i][1] * y[i][1]) + (y[i][2] * y[i][2] + y[i][3] * y[i][3]); }
        ss = wave_sum(ss);
        const float r = rsqrtf(ss * (1.f / 2048.f) + EPS);
        f32x4 x[8];
#pragma unroll
        for (int i = 0; i < 8; ++i) { const int c = lane * 4 + i * 256;
            const f32x4 xv = *(const f32x4*)(X + (size_t)row * D + c), gp = *(const f32x4*)(gpost + c), gt = *(const f32x4*)(gate + c);
            x[i] = xv + (gt * rs) * (y[i] * r * gp);
            if (final_out) *(f32x4*)(a.out + (size_t)row * D + c) = x[i]; else *(f32x4*)(X + (size_t)row * D + c) = x[i]; }
        if (has_next) { const float* md = MOD + ((size_t)ln * 5 + m) * 18432;
            norm_mod_store(x, a.in[6] + (size_t)(ln * 6 + gi_pre) * D, md + (size_t)mi_shift * D, md + (size_t)mi_scale * D, H + (size_t)row * D, lane); }
    }
}

struct EpiF32 {
    static constexpr bool PERM = false, AFTER_DRAIN = false;
    float* C; int ldc;
    __device__ __forceinline__ void operator()(const f32x4 (&acc)[2][2][4][2], const Unit& u, int wr, int wc, int fr, int fq) const {
        const int row0 = u.pm * BM + wr * 64 + fr, col0 = u.pn * BM + wc * 32 + 4 * fq;
#pragma unroll
        for (int ai = 0; ai < 2; ++ai)
#pragma unroll
            for (int m = 0; m < 4; ++m) { float* rowp = C + (size_t)(row0 + ai * HALF + m * 16) * ldc + col0;
#pragma unroll
                for (int bj = 0; bj < 2; ++bj)
#pragma unroll
                    for (int n = 0; n < 2; ++n) *(f32x4*)(rowp + bj * HALF + n * 16) = acc[ai][bj][m][n]; }
    }
};
struct EpiSwiGLU {
    static constexpr bool PERM = false, AFTER_DRAIN = false;
    bf16_t* O; int ldc;
    __device__ __forceinline__ void operator()(const f32x4 (&acc)[2][2][4][2], const Unit& u, int wr, int wc, int fr, int fq) const {
        const int row0 = u.pm * BM + wr * 64 + fr, col0 = u.pn * 128 + wc * 16 + 4 * fq;
#pragma unroll
        for (int ai = 0; ai < 2; ++ai)
#pragma unroll
            for (int m = 0; m < 4; ++m) { bf16_t* rowp = O + (size_t)(row0 + ai * HALF + m * 16) * ldc + col0;
#pragma unroll
                for (int bj = 0; bj < 2; ++bj) { const f32x4 av = acc[ai][bj][m][0], uv = acc[ai][bj][m][1]; float v[4];
#pragma unroll
                    for (int j = 0; j < 4; ++j) v[j] = siluf(av[j]) * uv[j];
                    u32x2 w; w.x = cvt_pk_bf16(v[0], v[1]); w.y = cvt_pk_bf16(v[2], v[3]);
                    *(u32x2*)(rowp + bj * 64) = w; } }
    }
};
struct EpiBf16 {
    static constexpr bool PERM = true, AFTER_DRAIN = false;
    bf16_t* O; int ldc;
    __device__ __forceinline__ void operator()(const f32x4 (&acc)[2][2][4][2], const Unit& u, int wr, int wc, int fr, int fq) const {
        const int row0 = u.pm * BM + wr * 64 + fr, col0 = u.pn * BM + wc * 32 + 8 * fq;
#pragma unroll
        for (int ai = 0; ai < 2; ++ai)
#pragma unroll
            for (int m = 0; m < 4; ++m) { bf16_t* rowp = O + (size_t)(row0 + ai * HALF + m * 16) * ldc + col0;
#pragma unroll
                for (int bj = 0; bj < 2; ++bj) { const f32x4 v0 = acc[ai][bj][m][0], v1 = acc[ai][bj][m][1];
                    u32x4 w; w.x = cvt_pk_bf16(v0[0], v0[1]); w.y = cvt_pk_bf16(v0[2], v0[3]); w.z = cvt_pk_bf16(v1[0], v1[1]); w.w = cvt_pk_bf16(v1[2], v1[3]);
                    *(u32x4*)(rowp + bj * HALF) = w; } }
    }
};

template <class Epi>
__device__ __forceinline__ void run_gemm(LAS unsigned char* lds, const bf16_t* A, const bf16_t* Bt, int M, int N, int K, const Epi& E, int rot) {
    Gemm g; g.A = A; g.Bt = Bt; g.M = M; g.N = N; g.K = K;
    StaticOrder S; const int G = gridDim.x; S.init(M, N, G, (int)((blockIdx.x + rot) % G));
    gemm_phase<Epi, StaticOrder, false>(lds, g, S, E, nullptr);
    __syncthreads();
}

__device__ __forceinline__ void rope_cs(int i, int t, bool latent, float& cs, float& sn) {
    if (!latent) { cs = 1.f; sn = 0.f; return; }
    const float inv = exp2f(-(float)(i & 15) * (13.287712379549449f / 16.f));
    const float pos = (float)((i < 16) ? (t >> 6) : (t & 63));
    sincosf(pos * inv, &sn, &cs);
}

__device__ void phase_prep(const Args& a, int l) {
    const int lane = threadIdx.x & 63, gw = blockIdx.x * 8 + (threadIdx.x >> 6), nw = gridDim.x * 8;
    const float* P = (const float*)(a.ws + WS_P);
    float* QR = (float*)(a.ws + WS_QR); float* KR = (float*)(a.ws + WS_KR);
    bf16_t* CQN = (bf16_t*)(a.ws + WS_CQN); bf16_t* CKVN = (bf16_t*)(a.ws + WS_CKVN); bf16_t* KB = (bf16_t*)(a.ws + WS_KB);
    const float* qn = a.in[19] + l * 512; const float* kvn = a.in[21] + l * 256;
    for (int row = gw; row < MR; row += nw) {
        const bool latent = row < MLAT;
        const int b = latent ? (row >> 11) : ((row - MLAT) >> 8), t = latent ? (row & 2047) : ((row - MLAT) & 255), ki = latent ? 256 + t : t;
        const float* pr = P + (size_t)row * INWP;
        const int i = lane & 31; float cs, sn; rope_cs(i, t, latent, cs, sn);
#pragma unroll
        for (int j = 0; j < 3; ++j) { const int hh = (lane >> 5) + 2 * j;
            { const float x1 = pr[OFF_RQ + hh * 64 + i], x2 = pr[OFF_RQ + hh * 64 + 32 + i];
              QR[(size_t)row * 384 + hh * 64 + i] = x1 * cs - x2 * sn; QR[(size_t)row * 384 + hh * 64 + 32 + i] = x1 * sn + x2 * cs; }
            { const float x1 = pr[OFF_RK + hh * 64 + i], x2 = pr[OFF_RK + hh * 64 + 32 + i];
              KR[(size_t)row * 384 + hh * 64 + i] = (x1 * cs - x2 * sn) * 0.125f; KR[(size_t)row * 384 + hh * 64 + 32 + i] = (x1 * sn + x2 * cs) * 0.125f; } }
        { f32x4 v0 = *(const f32x4*)(pr + OFF_CQ + lane * 4), v1 = *(const f32x4*)(pr + OFF_CQ + 256 + lane * 4);
          float ss = (v0[0] * v0[0] + v0[1] * v0[1]) + (v0[2] * v0[2] + v0[3] * v0[3]) + (v1[0] * v1[0] + v1[1] * v1[1]) + (v1[2] * v1[2] + v1[3] * v1[3]);
          ss = wave_sum(ss); const float r = rsqrtf(ss * (1.f / 512.f) + EPS);
          const f32x4 g0 = *(const f32x4*)(qn + lane * 4), g1 = *(const f32x4*)(qn + 256 + lane * 4);
          v0 = v0 * r * g0; v1 = v1 * r * g1;
          u32x2 w; w.x = cvt_pk_bf16(v0[0], v0[1]); w.y = cvt_pk_bf16(v0[2], v0[3]); *(u32x2*)(CQN + (size_t)row * 512 + lane * 4) = w;
          w.x = cvt_pk_bf16(v1[0], v1[1]); w.y = cvt_pk_bf16(v1[2], v1[3]); *(u32x2*)(CQN + (size_t)row * 512 + 256 + lane * 4) = w; }
        { f32x4 v0 = *(const f32x4*)(pr + OFF_CKV + lane * 4);
          float ss = (v0[0] * v0[0] + v0[1] * v0[1]) + (v0[2] * v0[2] + v0[3] * v0[3]);
          ss = wave_sum(ss); const float r = rsqrtf(ss * (1.f / 256.f) + EPS);
          const f32x4 g0 = *(const f32x4*)(kvn + lane * 4);
          v0 = v0 * r * g0;
          u32x2 w; w.x = cvt_pk_bf16(v0[0], v0[1]); w.y = cvt_pk_bf16(v0[2], v0[3]); *(u32x2*)(CKVN + (size_t)row * 256 + lane * 4) = w; }
        { const float x1 = pr[OFF_KR + i], x2 = pr[OFF_KR + 32 + i];
          const bf16_t o1 = f2bf(x1 * cs - x2 * sn), o2 = f2bf(x1 * sn + x2 * cs);
          const int h0 = (lane >> 5) * 3;
#pragma unroll
          for (int hh = 0; hh < 3; ++hh) { bf16_t* kp = KB + ((size_t)(b * 6 + h0 + hh) * NKEY + ki) * 192; kp[128 + i] = o1; kp[160 + i] = o2; } }
    }
}

__device__ void phase_conv(const Args& a, int l, LAS unsigned char* lds) {
    const int tid = threadIdx.x, lane = tid & 63, wid = tid >> 6;
    const float* P = (const float*)(a.ws + WS_P); bf16_t* CVN = (bf16_t*)(a.ws + WS_CVN);
    LAS float* red = (LAS float*)lds;
    LAS float* fin = (LAS float*)(lds + 1024);
    float dwc[31];
#pragma unroll
    for (int w = 0; w < 31; ++w) dwc[w] = a.in[14][(size_t)(l * 31 + w) * 512 + tid];
    const float bias = a.in[15][l * 512 + tid], lg = a.in[16][l * 512 + tid], lb = a.in[17][l * 512 + tid];
    for (int it = blockIdx.x; it < MR / 16; it += gridDim.x) {
        const int row0 = it * 16;
        int s0, s1; if (row0 < MLAT) { s0 = (row0 >> 11) << 11; s1 = s0 + 2048; } else { s0 = MLAT + (((row0 - MLAT) >> 8) << 8); s1 = s0 + 256; }
        float acc[16];
#pragma unroll
        for (int j = 0; j < 16; ++j) acc[j] = bias;
#pragma unroll
        for (int i = 0; i < 46; ++i) { const int r = row0 - 15 + i; float u = 0.f;
            if (r >= s0 && r < s1) { const float av = P[(size_t)r * INWP + OFF_GLU + tid], gv = P[(size_t)r * INWP + OFF_GLU + 512 + tid]; u = av * sigmf(gv); }
#pragma unroll
            for (int j = 0; j < 16; ++j) { const int w = i - j; if (w >= 0 && w <= 30) acc[j] += u * dwc[w]; } }
#pragma unroll
        for (int j = 0; j < 16; ++j) { const float s = wave_sum(acc[j]), q = wave_sum(acc[j] * acc[j]); if (lane == 0) { red[wid * 32 + 2 * j] = s; red[wid * 32 + 2 * j + 1] = q; } }
        __syncthreads();
        if (tid < 32) { float s = 0.f;
#pragma unroll
            for (int w = 0; w < 8; ++w) s += red[w * 32 + tid];
            fin[tid] = s; }
        __syncthreads();
#pragma unroll
        for (int j = 0; j < 16; ++j) { const float mean = fin[2 * j] * (1.f / 512.f), var = fin[2 * j + 1] * (1.f / 512.f) - mean * mean;
            const float y = (acc[j] - mean) * rsqrtf(fmaxf(var, 0.f) + EPS) * lg + lb;
            CVN[(size_t)(row0 + j) * 512 + tid] = f2bf(siluf(y)); }
        __syncthreads();
    }
}

__device__ void phase_ret_scan(const Args& a, int item) {
    const int tid = threadIdx.x, d = tid & 63, g = tid >> 6;
    const int s = item & 3, dir = (item >> 2) & 1, bh = item >> 3, b = bh / 6, h = bh % 6, dv0 = s * 32 + g * 4;
    const float* P = (const float*)(a.ws + WS_P); const float* KR = (const float*)(a.ws + WS_KR);
    float* ST = (float*)(a.ws + (dir ? WS_SB : WS_SF));
    const float gam = 1.f - exp2f(-5.f - (float)h);
    f32x4 S = {0.f, 0.f, 0.f, 0.f};
    for (int step = 0; step < NCH; ++step) {
        const int cidx = dir == 0 ? step : (step < 2 ? 1 - step : 19 - step);
        const int rowbase = cidx < 2 ? MLAT + b * 256 + cidx * 128 : b * 2048 + (cidx - 2) * 128;
        *(f32x4*)(ST + ((size_t)bh * NCH + cidx) * 8192 + d * 128 + dv0) = S;
#pragma unroll 8
        for (int tt = 0; tt < 128; ++tt) { const int row = rowbase + (dir == 0 ? tt : 127 - tt);
            const float k = KR[(size_t)row * 384 + h * 64 + d];
            const f32x4 v = *(const f32x4*)(P + (size_t)row * INWP + OFF_RV + h * 128 + dv0);
            S = S * gam + v * k; }
    }
}

__device__ void phase_ret_out(const Args& a, int l, LAS unsigned char* lds) {
    const int tid = threadIdx.x;
    const float* P = (const float*)(a.ws + WS_P); const float* QR = (const float*)(a.ws + WS_QR); const float* KR = (const float*)(a.ws + WS_KR);
    const float* SF = (const float*)(a.ws + WS_SF); const float* SB = (const float*)(a.ws + WS_SB); bf16_t* CAT = (bf16_t*)(a.ws + WS_CAT);
    LAS float* qT = (LAS float*)lds;
    LAS float* ks = qT + 64 * 68;
    LAS float* AT = ks + 128 * 65;
    LAS float* vs = AT + 128 * 68;
    const int nch = (l == 0) ? 18 : 16, nitem = 24 * nch * 2;
    for (int it = blockIdx.x; it < nitem; it += gridDim.x) {
        const int half = it & 1, c = (it >> 1) % nch, bh = (it >> 1) / nch, cidx = c + (18 - nch), b = bh / 6, h = bh % 6;
        const int rowbase = cidx < 2 ? MLAT + b * 256 + cidx * 128 : b * 2048 + (cidx - 2) * 128;
        const float l2g = log2f(1.f - exp2f(-5.f - (float)h));
        { const int d = tid & 63, i0 = tid >> 6;
#pragma unroll
          for (int ii = 0; ii < 8; ++ii) { const int i = i0 + 8 * ii; qT[d * 68 + i] = QR[(size_t)(rowbase + half * 64 + i) * 384 + h * 64 + d]; }
#pragma unroll
          for (int jj = 0; jj < 16; ++jj) { const int j = i0 + 8 * jj; ks[j * 65 + d] = KR[(size_t)(rowbase + j) * 384 + h * 64 + d]; }
#pragma unroll
          for (int ii = 0; ii < 8; ++ii) { const int idx = tid + 512 * ii, j = idx >> 5, c4 = idx & 31;
              *(LAS f32x4*)(vs + j * 128 + c4 * 4) = *(const f32x4*)(P + (size_t)(rowbase + j) * INWP + OFF_RV + h * 128 + c4 * 4); } }
        __syncthreads();
        { const int j = tid & 127, ig = tid >> 7; float acc[16];
#pragma unroll
          for (int r = 0; r < 16; ++r) acc[r] = 0.f;
          for (int d = 0; d < 64; ++d) { const float kd = ks[j * 65 + d];
#pragma unroll
              for (int qq = 0; qq < 4; ++qq) { const f32x4 q4 = *(const LAS f32x4*)(qT + d * 68 + ig * 16 + 4 * qq);
#pragma unroll
                  for (int e = 0; e < 4; ++e) acc[4 * qq + e] += kd * q4[e]; } }
#pragma unroll
          for (int qq = 0; qq < 4; ++qq) { f32x4 o;
#pragma unroll
              for (int e = 0; e < 4; ++e) { const int ia = half * 64 + ig * 16 + 4 * qq + e; const int dist = ia > j ? ia - j : j - ia; o[e] = acc[4 * qq + e] * exp2f(l2g * (float)dist); }
              *(LAS f32x4*)(AT + j * 68 + ig * 16 + 4 * qq) = o; } }
        __syncthreads();
        { const int c4 = tid & 31, ig = tid >> 5; f32x4 o[4];
#pragma unroll
          for (int r = 0; r < 4; ++r) o[r] = (f32x4){0.f, 0.f, 0.f, 0.f};
          for (int j = 0; j < 128; ++j) { const f32x4 v4 = *(const LAS f32x4*)(vs + j * 128 + c4 * 4), a4 = *(const LAS f32x4*)(AT + j * 68 + ig * 4);
#pragma unroll
              for (int r = 0; r < 4; ++r) o[r] += v4 * a4[r]; }
          float wf[4], wb[4];
#pragma unroll
          for (int r = 0; r < 4; ++r) { const int il = half * 64 + ig * 4 + r; wf[r] = exp2f(l2g * (float)(il + 1)); wb[r] = exp2f(l2g * (float)(128 - il)); }
          const float* sf = SF + ((size_t)bh * NCH + cidx) * 8192 + c4 * 4; const float* sb = SB + ((size_t)bh * NCH + cidx) * 8192 + c4 * 4;
#pragma unroll 4
          for (int d = 0; d < 64; ++d) { const f32x4 q4 = *(const LAS f32x4*)(qT + d * 68 + ig * 4); const f32x4 f4 = *(const f32x4*)(sf + d * 128), b4 = *(const f32x4*)(sb + d * 128);
#pragma unroll
              for (int r = 0; r < 4; ++r) o[r] += f4 * (q4[r] * wf[r]) + b4 * (q4[r] * wb[r]); }
          const f32x4 gn4 = *(const f32x4*)(a.in[13] + l * 768 + h * 128 + c4 * 4);
#pragma unroll
          for (int r = 0; r < 4; ++r) { const int row = rowbase + half * 64 + ig * 4 + r;
              float s = (o[r][0] + o[r][1]) + (o[r][2] + o[r][3]);
#pragma unroll
              for (int m = 1; m < 32; m <<= 1) s += __shfl_xor(s, m);
              const float mu = s * (1.f / 128.f); const f32x4 dv = o[r] - mu;
              float q = (dv[0] * dv[0] + dv[1] * dv[1]) + (dv[2] * dv[2] + dv[3] * dv[3]);
#pragma unroll
              for (int m = 1; m < 32; m <<= 1) q += __shfl_xor(q, m);
              const float rstd = rsqrtf(q * (1.f / 128.f) + EPS);
              const f32x4 rg = *(const f32x4*)(P + (size_t)row * INWP + OFF_RG + h * 128 + c4 * 4);
              float v[4];
#pragma unroll
              for (int e = 0; e < 4; ++e) v[e] = siluf(rg[e]) * (dv[e] * rstd * gn4[e]);
              u32x2 w; w.x = cvt_pk_bf16(v[0], v[1]); w.y = cvt_pk_bf16(v[2], v[3]);
              *(u32x2*)(CAT + (size_t)row * D + h * 128 + c4 * 4) = w; } }
        __syncthreads();
    }
}

__device__ void phase_post(const Args& a) {
    const int lane = threadIdx.x & 63, gw = blockIdx.x * 8 + (threadIdx.x >> 6), nw = gridDim.x * 8;
    const float* QF = (const float*)(a.ws + WS_QF); const float* KVF = (const float*)(a.ws + WS_KVF);
    bf16_t* QB = (bf16_t*)(a.ws + WS_QB); bf16_t* KB = (bf16_t*)(a.ws + WS_KB); bf16_t* VT = (bf16_t*)(a.ws + WS_VT);
    const float qscale = 0.07216878364870322f * 1.4426950408889634f;
    for (int wi = gw; wi < MR / 8; wi += nw) {
        const int r0 = wi * 8; const bool latent = r0 < MLAT;
        const int b = latent ? (r0 >> 11) : ((r0 - MLAT) >> 8), t0 = latent ? (r0 & 2047) : ((r0 - MLAT) & 255), ki0 = latent ? 256 + t0 : t0;
        for (int rr = 0; rr < 8; ++rr) { const int row = r0 + rr, ki = ki0 + rr, t = t0 + rr;
            const int i = lane & 31; float cs, sn; rope_cs(i, t, latent, cs, sn);
#pragma unroll
            for (int ii = 0; ii < 3; ++ii) { const int idx = lane * 4 + ii * 256, hh = idx >> 7, dd = idx & 127;
                const f32x4 q4 = *(const f32x4*)(QF + (size_t)row * 1280 + hh * 192 + dd) * qscale;
                u32x2 w; w.x = cvt_pk_bf16(q4[0], q4[1]); w.y = cvt_pk_bf16(q4[2], q4[3]);
                *(u32x2*)(QB + ((size_t)(b * 6 + hh) * NKEY + ki) * 192 + dd) = w;
                const f32x4 k4 = *(const f32x4*)(KVF + (size_t)row * 1536 + hh * 256 + dd);
                w.x = cvt_pk_bf16(k4[0], k4[1]); w.y = cvt_pk_bf16(k4[2], k4[3]);
                *(u32x2*)(KB + ((size_t)(b * 6 + hh) * NKEY + ki) * 192 + dd) = w; }
#pragma unroll
            for (int j = 0; j < 3; ++j) { const int hh = (lane >> 5) + 2 * j;
                const float x1 = QF[(size_t)row * 1280 + hh * 192 + 128 + i], x2 = QF[(size_t)row * 1280 + hh * 192 + 160 + i];
                bf16_t* qp = QB + ((size_t)(b * 6 + hh) * NKEY + ki) * 192;
                qp[128 + i] = f2bf((x1 * cs - x2 * sn) * qscale); qp[160 + i] = f2bf((x1 * sn + x2 * cs) * qscale); } }
#pragma unroll 2
        for (int ii = 0; ii < 12; ++ii) { const int hd = lane + 64 * ii, hh = hd >> 7, dv = hd & 127; float v[8];
#pragma unroll
            for (int rr = 0; rr < 8; ++rr) v[rr] = KVF[(size_t)(r0 + rr) * 1536 + hh * 256 + 128 + dv];
            u32x4 w; w.x = cvt_pk_bf16(v[0], v[1]); w.y = cvt_pk_bf16(v[2], v[3]); w.z = cvt_pk_bf16(v[4], v[5]); w.w = cvt_pk_bf16(v[6], v[7]);
            *(u32x4*)(VT + (((size_t)(b * 6 + hh) * 36 + (ki0 >> 6)) * 128 + dv) * 64 + (ki0 & 63)) = w; }
    }
}

constexpr int KS_STRIDE = 400, VS_STRIDE = 144, KS_BYTES = 64 * KS_STRIDE, VS_BYTES = 128 * VS_STRIDE, ATT_BUF = KS_BYTES + VS_BYTES;
__device__ void phase_attn(const Args& a, int l, LAS unsigned char* lds) {
    const int tid = threadIdx.x, lane = tid & 63, wid = tid >> 6, fr = lane & 15, fq = lane >> 4;
    const bf16_t* QB = (const bf16_t*)(a.ws + WS_QB); const bf16_t* KB = (const bf16_t*)(a.ws + WS_KB); const bf16_t* VT = (const bf16_t*)(a.ws + WS_VT);
    bf16_t* CAT = (bf16_t*)(a.ws + WS_CAT);
    const int nqt = (l == 0) ? 9 : 8, nitem = 24 * nqt;
    for (int it = blockIdx.x; it < nitem; it += gridDim.x) {
        const int bh = it % 24, qi = it / 24, qt = (l == 0) ? (qi == 8 ? 0 : qi + 1) : qi + 1, b = bh / 6, h = bh % 6;
        const int nk = (qt == 0) ? 256 : NKEY, ntile = nk / 64;
        const bf16_t* kbase = KB + (size_t)bh * NKEY * 192; const bf16_t* vbase = VT + (size_t)bh * 128 * NKEY; const bf16_t* qbase = QB + (size_t)bh * NKEY * 192;
        const int q0 = qt * 256 + wid * 32;
        bf16x8 qf[2][6];
#pragma unroll
        for (int g = 0; g < 2; ++g)
#pragma unroll
            for (int ks = 0; ks < 6; ++ks) qf[g][ks] = *(const bf16x8*)(qbase + (size_t)(q0 + g * 16 + fr) * 192 + ks * 32 + fq * 8);
        f32x4 o[8][2];
#pragma unroll
        for (int db = 0; db < 8; ++db) { o[db][0] = (f32x4){0.f, 0.f, 0.f, 0.f}; o[db][1] = (f32x4){0.f, 0.f, 0.f, 0.f}; }
        float mrun[2] = {-1e30f, -1e30f}, lrun[2] = {0.f, 0.f};
        u32x4 stg[5];
        auto gload = [&](int tile) {
            const bf16_t* kp = kbase + (size_t)tile * (64 * 192) + tid * 8; const bf16_t* vp = vbase + (size_t)tile * (128 * 64) + tid * 8;
#pragma unroll
            for (int i = 0; i < 3; ++i) stg[i] = *(const u32x4*)(kp + i * 4096);
#pragma unroll
            for (int i = 0; i < 2; ++i) stg[3 + i] = *(const u32x4*)(vp + i * 4096);
        };
        auto lstore = [&](int buf) {
            LAS unsigned char* kb = lds + buf * ATT_BUF; LAS unsigned char* vb = kb + KS_BYTES;
#pragma unroll
            for (int i = 0; i < 3; ++i) { const int c = tid + 512 * i, r = c / 24, cc = c % 24; *(LAS u32x4*)(kb + r * KS_STRIDE + cc * 16) = stg[i]; }
#pragma unroll
            for (int i = 0; i < 2; ++i) { const int c = tid + 512 * i, r = c >> 3, cc = c & 7; *(LAS u32x4*)(vb + r * VS_STRIDE + cc * 16) = stg[3 + i]; }
        };
        gload(0); lstore(0);
        __syncthreads();
        for (int tile = 0; tile < ntile; ++tile) {
            const int buf = tile & 1;
            if (tile + 1 < ntile) gload(tile + 1);
            LAS unsigned char* kb = lds + buf * ATT_BUF; LAS unsigned char* vb = kb + KS_BYTES;
            f32x4 s[4][2];
#pragma unroll
            for (int kbk = 0; kbk < 4; ++kbk) { s[kbk][0] = (f32x4){0.f, 0.f, 0.f, 0.f}; s[kbk][1] = (f32x4){0.f, 0.f, 0.f, 0.f};
                const int krow = (kbk >> 1) * 32 + (fr >> 2) * 8 + (kbk & 1) * 4 + (fr & 3);
#pragma unroll
                for (int ks = 0; ks < 6; ++ks) { const bf16x8 kf = *(const LAS bf16x8*)(kb + krow * KS_STRIDE + ks * 64 + fq * 16);
                    s[kbk][0] = __builtin_amdgcn_mfma_f32_16x16x32_bf16(kf, qf[0][ks], s[kbk][0], 0, 0, 0);
                    s[kbk][1] = __builtin_amdgcn_mfma_f32_16x16x32_bf16(kf, qf[1][ks], s[kbk][1], 0, 0, 0); } }
            bf16x8 pf[2][2];
#pragma unroll
            for (int g = 0; g < 2; ++g) {
                float mx = s[0][g][0];
#pragma unroll
                for (int kbk = 0; kbk < 4; ++kbk)
#pragma unroll
                    for (int j = 0; j < 4; ++j) mx = fmaxf(mx, s[kbk][g][j]);
                mx = fmaxf(mx, __shfl_xor(mx, 16)); mx = fmaxf(mx, __shfl_xor(mx, 32));
                const float mnew = fmaxf(mrun[g], mx), alpha = exp2f(mrun[g] - mnew); mrun[g] = mnew;
                float ps = 0.f;
#pragma unroll
                for (int kbk = 0; kbk < 4; ++kbk)
#pragma unroll
                    for (int j = 0; j < 4; ++j) { const float p = exp2f(s[kbk][g][j] - mnew); s[kbk][g][j] = p; ps += p; }
                lrun[g] = lrun[g] * alpha + ps;
#pragma unroll
                for (int db = 0; db < 8; ++db) o[db][g] *= alpha;
#pragma unroll
                for (int p = 0; p < 2; ++p) { u32x4 w; w.x = cvt_pk_bf16(s[2 * p][g][0], s[2 * p][g][1]); w.y = cvt_pk_bf16(s[2 * p][g][2], s[2 * p][g][3]);
                    w.z = cvt_pk_bf16(s[2 * p + 1][g][0], s[2 * p + 1][g][1]); w.w = cvt_pk_bf16(s[2 * p + 1][g][2], s[2 * p + 1][g][3]);
                    pf[g][p] = __builtin_bit_cast(bf16x8, w); }
            }
#pragma unroll
            for (int p = 0; p < 2; ++p)
#pragma unroll
                for (int db = 0; db < 8; ++db) { const bf16x8 vf = *(const LAS bf16x8*)(vb + (db * 16 + fr) * VS_STRIDE + p * 64 + fq * 16);
                    o[db][0] = __builtin_amdgcn_mfma_f32_16x16x32_bf16(vf, pf[0][p], o[db][0], 0, 0, 0);
                    o[db][1] = __builtin_amdgcn_mfma_f32_16x16x32_bf16(vf, pf[1][p], o[db][1], 0, 0, 0); }
            if (tile + 1 < ntile) lstore(buf ^ 1);
            __syncthreads();
        }
#pragma unroll
        for (int g = 0; g < 2; ++g) { float lt = lrun[g]; lt += __shfl_xor(lt, 16); lt += __shfl_xor(lt, 32); const float inv = 1.f / lt;
            const int q = q0 + g * 16 + fr; const int row = q < 256 ? MLAT + b * 256 + q : b * 2048 + (q - 256);
#pragma unroll
            for (int db = 0; db < 8; ++db) { const f32x4 v = o[db][g] * inv; u32x2 w; w.x = cvt_pk_bf16(v[0], v[1]); w.y = cvt_pk_bf16(v[2], v[3]);
                *(u32x2*)(CAT + (size_t)row * D + 1280 + h * 128 + db * 16 + fq * 4) = w; } }
        __syncthreads();
    }
}

constexpr int PH_PER_LAYER = 13, NPHASE = 2 + 2 * PH_PER_LAYER;

template <int LP>
__device__ __forceinline__ void layer_phase(const Args& a, const int l, LAS unsigned char* lds) {
    unsigned char* ws = a.ws; const bool last = (l == 1); const int Mlate = last ? MLAT : MR;
    bf16_t* H = (bf16_t*)(ws + WS_H); bf16_t* ACT = (bf16_t*)(ws + WS_P); float* Y = (float*)(ws + WS_Y); float* Pp = (float*)(ws + WS_P); bf16_t* CAT = (bf16_t*)(ws + WS_CAT);
    if constexpr (LP == 0) { EpiSwiGLU E; E.O = ACT; E.ldc = DFF; run_gemm(lds, H, (const bf16_t*)(ws + WS_WFFIN + (size_t)(l * 2) * SZ_WFFIN), MR, 2 * DFF, D, E, 0); }
    if constexpr (LP == 1) { EpiF32 E; E.C = Y; E.ldc = D; run_gemm(lds, ACT, (const bf16_t*)(ws + WS_WFFOUT + (size_t)(l * 2) * SZ_WFFOUT), MR, D, DFF, E, 0); }
    if constexpr (LP == 2) phase_resnorm(a, l, 1, 2, 0.5f, true, l, 2, 3, 4, false, MR);
    if constexpr (LP == 3) { EpiF32 E; E.C = Pp; E.ldc = INWP; run_gemm(lds, H, (const bf16_t*)(ws + WS_WIN + (size_t)l * SZ_WIN), MR, INWP, D, E, 0); }
    if constexpr (LP == 4) { phase_prep(a, l); phase_conv(a, l, lds); }
    if constexpr (LP == 5) {
        { EpiF32 E; E.C = (float*)(ws + WS_QF); E.ldc = 1280; run_gemm(lds, (const bf16_t*)(ws + WS_CQN), (const bf16_t*)(ws + WS_WUQ + (size_t)l * SZ_WUQ), MR, 1280, 512, E, 0); }
        { EpiF32 E; E.C = (float*)(ws + WS_KVF); E.ldc = 1536; run_gemm(lds, (const bf16_t*)(ws + WS_CKVN), (const bf16_t*)(ws + WS_WUKV + (size_t)l * SZ_WUKV), MR, 1536, 256, E, 76); }
        { EpiBf16 E; E.O = CAT + 768; E.ldc = D; run_gemm(lds, (const bf16_t*)(ws + WS_CVN), (const bf16_t*)(ws + WS_WPW + (size_t)l * SZ_WPW), MR, 512, 512, E, 40); }
        const int G = gridDim.x; for (int it = G - 1 - (int)blockIdx.x; it < 192; it += G) phase_ret_scan(a, it);
    }
    if constexpr (LP == 6) { phase_post(a); phase_ret_out(a, l, lds); }
    if constexpr (LP == 7) phase_attn(a, l, lds);
    if constexpr (LP == 8) { EpiF32 E; E.C = Y; E.ldc = D; run_gemm(lds, CAT, (const bf16_t*)(ws + WS_WOUT + (size_t)l * SZ_WOUT), Mlate, D, D, E, 0); }
    if constexpr (LP == 9) phase_resnorm(a, l, 3, 5, 1.0f, true, l, 4, 6, 7, false, Mlate);
    if constexpr (LP == 10) { EpiSwiGLU E; E.O = ACT; E.ldc = DFF; run_gemm(lds, H, (const bf16_t*)(ws + WS_WFFIN + (size_t)(l * 2 + 1) * SZ_WFFIN), Mlate, 2 * DFF, D, E, 0); }
    if constexpr (LP == 11) { EpiF32 E; E.C = Y; E.ldc = D; run_gemm(lds, ACT, (const bf16_t*)(ws + WS_WFFOUT + (size_t)(l * 2 + 1) * SZ_WFFOUT), Mlate, D, DFF, E, 0); }
    if constexpr (LP == 12) phase_resnorm(a, l, 5, 8, 0.5f, !last, l + 1, 0, 0, 1, last, Mlate);
}

__global__ void __launch_bounds__(NTHR, 2) hybrid_fwd(Args a) {
    extern __shared__ __attribute__((aligned(16))) unsigned char lds_raw[];
    LAS unsigned char* lds = (LAS unsigned char*)lds_raw;
    cg::grid_group grid = cg::this_grid();
#define RUN_PH(ph, stmt) if (a.ph_lo <= (ph) && (ph) < a.ph_hi) { if ((ph) > a.ph_lo) grid.sync(); stmt; }
    RUN_PH(0, phase_prologue(a, lds))
    RUN_PH(1, phase_norm0(a))
#define RUN_LAYER(l) \
    RUN_PH(2 + (l) * 13 + 0, layer_phase<0>(a, l, lds)) RUN_PH(2 + (l) * 13 + 1, layer_phase<1>(a, l, lds)) RUN_PH(2 + (l) * 13 + 2, layer_phase<2>(a, l, lds)) \
    RUN_PH(2 + (l) * 13 + 3, layer_phase<3>(a, l, lds)) RUN_PH(2 + (l) * 13 + 4, layer_phase<4>(a, l, lds)) RUN_PH(2 + (l) * 13 + 5, layer_phase<5>(a, l, lds)) \
    RUN_PH(2 + (l) * 13 + 6, layer_phase<6>(a, l, lds)) RUN_PH(2 + (l) * 13 + 7, layer_phase<7>(a, l, lds)) RUN_PH(2 + (l) * 13 + 8, layer_phase<8>(a, l, lds)) \
    RUN_PH(2 + (l) * 13 + 9, layer_phase<9>(a, l, lds)) RUN_PH(2 + (l) * 13 + 10, layer_phase<10>(a, l, lds)) RUN_PH(2 + (l) * 13 + 11, layer_phase<11>(a, l, lds)) \
    RUN_PH(2 + (l) * 13 + 12, layer_phase<12>(a, l, lds))
    RUN_LAYER(0)
    RUN_LAYER(1)
}

#ifndef ONE_LAUNCH
#define ONE_LAUNCH 0
#endif

extern "C" void kernel_launch(void* const* d_in, const int* in_sizes, int n_in, void* d_out, int out_size, void* d_ws, size_t ws_size, hipStream_t stream) {
    static int grid = 0;
    if (grid == 0) {
        if (n_in != 23 || ws_size < WS_END) { fprintf(stderr, "kernel_launch: need 23 inputs and %zu bytes of workspace; got %d, %zu\n", (size_t)WS_END, n_in, ws_size); grid = -1; return; }
        int dev = 0, cus = 0, per_cu = 0;
        hipGetDevice(&dev); hipDeviceGetAttribute(&cus, hipDeviceAttributeMultiprocessorCount, dev);
        if (hipFuncSetAttribute((const void*)hybrid_fwd, hipFuncAttributeMaxDynamicSharedMemorySize, LDS_BYTES) != hipSuccess) { fprintf(stderr, "kernel_launch: hipFuncSetAttribute failed\n"); grid = -1; return; }
        if (hipOccupancyMaxActiveBlocksPerMultiprocessor(&per_cu, (const void*)hybrid_fwd, NTHR, LDS_BYTES) != hipSuccess || per_cu < 1) { fprintf(stderr, "kernel_launch: occupancy query gave %d\n", per_cu); per_cu = 1; }
        (void)hipGetLastError();
        grid = cus * 1;
        fprintf(stderr, "kernel_launch: grid %d (per_cu %d)\n", grid, per_cu);
    }
    if (grid < 0) return;
    Args a{};
    for (int i = 0; i < 23; ++i) a.in[i] = (const float*)d_in[i];
    a.out = (float*)d_out; a.ws = (unsigned char*)d_ws;
#if ONE_LAUNCH
    a.ph_lo = 0; a.ph_hi = NPHASE;
    { void* args[] = {&a}; hipError_t e = hipLaunchCooperativeKernel((const void*)hybrid_fwd, dim3(grid), dim3(NTHR), args, LDS_BYTES, stream);
      if (e != hipSuccess) fprintf(stderr, "cooperative launch failed: %s\n", hipGetErrorString(e)); }
#else
    for (int ph = 0; ph < NPHASE; ++ph) {
        a.ph_lo = ph; a.ph_hi = ph + 1;
        void* args[] = {&a}; hipError_t e = hipLaunchCooperativeKernel((const void*)hybrid_fwd, dim3(grid), dim3(NTHR), args, LDS_BYTES, stream);
        if (e != hipSuccess) { fprintf(stderr, "launch %d failed: %s\n", ph, hipGetErrorString(e)); break; }
    }
#endif
}
```

```cpp
#include <hip/hip_runtime.h>
#include <hip/hip_cooperative_groups.h>
#include <cstdio>
namespace cg = cooperative_groups;

#define ONE_LAUNCH 1
#define EXTRA_SUB ~0ull
namespace pg8 {
#define PG8_LAS __attribute__((address_space(3)))
typedef unsigned short bf16_t;
typedef short bf16x8 __attribute__((ext_vector_type(8)));
typedef float f32x4 __attribute__((ext_vector_type(4)));
typedef unsigned u32x4 __attribute__((ext_vector_type(4)));
constexpr int BM = 256, BK = 64, HALF = 128, HTB = HALF * BK * 2  , STAGE_BYTES = 8 * HTB, NXCD = 8, WGM = 8;

__host__ __device__ __forceinline__ int lds_byte(int r, int c) { const int st = (r >> 4) * 2 + (c >> 5), rr = r & 15, cc = c & 31, ob = rr * 64 + cc * 2; return st * 1024 + (ob ^ (((ob >> 9) & 1) << 5)); }
__host__ __device__ __forceinline__ void stage_rc(int b, int& R, int& C) { const int st = b / 1024, sb = b % 1024, swz = sb ^ (((sb >> 9) & 1) << 5); R = (st >> 1) * 16 + swz / 64; C = (st & 1) * 32 + (swz % 64) / 2; }
__host__ __device__ __forceinline__ int perm32(int rho) { const int n = rho >> 4, i = rho & 15; return 8 * (i >> 2) + 4 * n + (i & 3); }

struct Unit { int pm, pn; };
struct Gemm { const bf16_t* A; const bf16_t* Bt; int M, N, K, ld, msplit; };

struct StaticOrder {
    int nM, nN, nwg, G, c;
    __host__ __device__ void init(int M, int N, int G_, int c_) { nM = M / BM; nN = N / BM; nwg = nM * nN; G = G_; c = c_; }
    __host__ __device__ bool next(int i, Unit& u) const {
        const long L = (long)i * G + c; if (L >= nwg) return false;
        int wgid = (int)L; { const int q = nwg / NXCD, r = nwg % NXCD, xcd = wgid % NXCD, off = wgid / NXCD; wgid = (xcd < r ? xcd * (q + 1) : r * (q + 1) + (xcd - r) * q) + off; }
        const int nig = WGM * nN, gid = wgid / nig, fm = gid * WGM, gsz = (nM - fm) < WGM ? (nM - fm) : WGM;
        u.pm = fm + ((wgid % nig) % gsz); u.pn = (wgid % nig) / gsz; return true;
    }
    __device__ __forceinline__ void a_ready(const Unit&) const {}
    __device__ __forceinline__ void done(const Unit&) const {}
};
__device__ __forceinline__ unsigned cvt_pk_bf16(float lo, float hi) { unsigned r; asm volatile("v_cvt_pk_bf16_f32 %0, %1, %2" : "=v"(r) : "v"(lo), "v"(hi)); return r; }
typedef float f32x2 __attribute__((ext_vector_type(2)));

template <class Epi, class Sched, bool STAMP = false>
__device__ __forceinline__ void gemm_phase(PG8_LAS unsigned char* lds, const Gemm g, const Sched& S, const Epi& E, unsigned long long* stamps) {
    const int tid = threadIdx.x, wid = __builtin_amdgcn_readfirstlane(tid >> 6), lane = tid & 63, wr = wid >> 2, wc = wid & 3, fr = lane & 15, fq = lane >> 4;
    const int K = g.K, nt = K / BK, LD = g.ld, MSPL = g.msplit;
    int ts_lo = 0, ts_hi = 0, nts = 0; const unsigned long long rt_entry = STAMP ? (unsigned long long)wall_clock64() : 0ull;
#define PG8_STAMP() do { if (STAMP && wid == 0 && nts < 64) { const unsigned long long _c = (unsigned long long)clock64(); \
        ts_lo = (lane == nts) ? (int)(unsigned)_c : ts_lo; ts_hi = (lane == nts) ? (int)(unsigned)(_c >> 32) : ts_hi; ++nts; } } while (0)
    PG8_STAMP();
    unsigned voffA[2], voffB[2];
#pragma unroll
    for (int i = 0; i < 2; ++i) { int R, C; stage_rc(tid * 16 + i * 8192, R, C); const int Rb = Epi::PERM ? ((R & ~31) + perm32(R & 31)) : R;
        voffA[i] = (unsigned)(R * LD + C) * 2u; voffB[i] = (unsigned)(Rb * LD + C) * 2u; }
    const size_t kstep = (size_t)(BK * 2);
    const size_t hstep = (size_t)HALF * LD * 2;
    const size_t tstep = 2 * hstep;
    const unsigned ldsw = (unsigned)wid * 1024u;
    const int aoff = lds_byte(wr * 64 + fr, fq * 8), boff = lds_byte(wc * 32 + fr, fq * 8);
#define PG8_SA(b, h) (((b) * 2 + (h)) * HTB)
#define PG8_SB(b, h) ((4 + (b) * 2 + (h)) * HTB)
#define PG8_STAGE(bufoff, gbase, voff) do { _Pragma("unroll") for (int _i = 0; _i < 2; ++_i) \
        __builtin_amdgcn_global_load_lds((const unsigned*)((const char*)(gbase) + (voff)[_i]), (PG8_LAS unsigned*)(lds + (bufoff) + ldsw + _i * 8192), 16, 0, 0); } while (0)
#define PG8_LDA(dst, b, h) do { _Pragma("unroll") for (int m = 0; m < 4; ++m) _Pragma("unroll") for (int k = 0; k < 2; ++k) dst[m][k] = *(const PG8_LAS bf16x8*)(lds + PG8_SA(b, h) + aoff + m * 2048 + k * 1024); } while (0)
#define PG8_LDB(dst, b, h) do { _Pragma("unroll") for (int n = 0; n < 2; ++n) _Pragma("unroll") for (int k = 0; k < 2; ++k) dst[n][k] = *(const PG8_LAS bf16x8*)(lds + PG8_SB(b, h) + boff + n * 2048 + k * 1024); } while (0)
#define PG8_MMA(ai, bj, At, Bt) do { __builtin_amdgcn_s_setprio(1); _Pragma("unroll") for (int m = 0; m < 4; ++m) _Pragma("unroll") for (int n = 0; n < 2; ++n) _Pragma("unroll") for (int k = 0; k < 2; ++k) \
        acc[ai][bj][m][n] = __builtin_amdgcn_mfma_f32_16x16x32_bf16(Bt[n][k], At[m][k], acc[ai][bj][m][n], 0, 0, 0); __builtin_amdgcn_s_setprio(0); } while (0)
#define PG8_WAIT_V(n) asm volatile("s_waitcnt vmcnt(" #n ")" ::: "memory")
#define PG8_WAIT_L(n) asm volatile("s_waitcnt lgkmcnt(" #n ")" ::: "memory")
#define PG8_BAR __builtin_amdgcn_s_barrier()
#define PG8_SCHED __builtin_amdgcn_sched_barrier(0)
    Unit cur, nxt; int ui = 0;
    if (!S.next(0, cur)) return;
    f32x4 acc[2][2][4][2];
#pragma unroll
    for (int a = 0; a < 2; ++a)
#pragma unroll
        for (int b = 0; b < 2; ++b)
#pragma unroll
            for (int m = 0; m < 4; ++m)
#pragma unroll
                for (int n = 0; n < 2; ++n) acc[a][b][m][n] = (f32x4){0.f, 0.f, 0.f, 0.f};
    bf16x8 At[4][2], B0[2][2], B1[2][2];
#define PG8_OFFA(u) (MSPL ? (size_t)((u).pm % MSPL) * tstep + (size_t)((u).pm / MSPL) * ((size_t)K * 2) : (size_t)(u).pm * tstep)
#define PG8_OFFB(u) ((size_t)(u).pn * tstep + (MSPL ? (size_t)((u).pm / MSPL) * ((size_t)K * 2) : (size_t)0))
    const char* cA = (const char*)g.A + PG8_OFFA(cur); const char* cB = (const char*)g.Bt + PG8_OFFB(cur);
    S.a_ready(cur);
    PG8_STAGE(PG8_SB(0, 0), cB, voffB); PG8_STAGE(PG8_SA(0, 0), cA, voffA); PG8_STAGE(PG8_SB(0, 1), cB + hstep, voffB); PG8_STAGE(PG8_SA(0, 1), cA + hstep, voffA);
    if (wr == 1) PG8_BAR;
    PG8_WAIT_V(4); PG8_BAR;
    PG8_STAGE(PG8_SB(1, 0), cB + kstep, voffB); PG8_STAGE(PG8_SA(1, 0), cA + kstep, voffA); PG8_STAGE(PG8_SB(1, 1), cB + hstep + kstep, voffB);
    PG8_WAIT_V(6); PG8_BAR;
    PG8_STAMP();
    for (;;) {
        const bool has_next = S.next(ui + 1, nxt);
        const char* nA = has_next ? (const char*)g.A + PG8_OFFA(nxt) : cA; const char* nB = has_next ? (const char*)g.Bt + PG8_OFFB(nxt) : cB;
        for (int t = 0; t < nt; t += 2) {
            const bool last = (t == nt - 2);
            const char* a1 = cA + (size_t)(t + 1) * kstep;
            const char* a2 = last ? nA : cA + (size_t)(t + 2) * kstep; const char* b2 = last ? nB : cB + (size_t)(t + 2) * kstep;
            const char* a3 = a2 + kstep; const char* b3 = b2 + kstep;
            if (last && has_next) S.a_ready(nxt);
            PG8_LDB(B0, 0, 0); PG8_SCHED; PG8_LDA(At, 0, 0); PG8_STAGE(PG8_SA(1, 1), a1 + hstep, voffA);
            PG8_WAIT_L(8); PG8_BAR; PG8_WAIT_L(0); PG8_MMA(0, 0, At, B0); PG8_BAR; PG8_SCHED;
            PG8_LDB(B1, 0, 1); PG8_STAGE(PG8_SB(0, 0), b2, voffB);
            PG8_BAR; PG8_WAIT_L(0); PG8_MMA(0, 1, At, B1); PG8_BAR;
            PG8_LDA(At, 0, 1); PG8_STAGE(PG8_SA(0, 0), a2, voffA);
            PG8_BAR; PG8_WAIT_L(0); PG8_MMA(1, 0, At, B0); PG8_BAR; PG8_SCHED;
            PG8_STAGE(PG8_SB(0, 1), b2 + hstep, voffB);
            PG8_WAIT_V(6); PG8_BAR; PG8_MMA(1, 1, At, B1); PG8_BAR;
            PG8_LDB(B0, 1, 0); PG8_SCHED; PG8_LDA(At, 1, 0); PG8_STAGE(PG8_SA(0, 1), a2 + hstep, voffA);
            PG8_WAIT_L(8); PG8_BAR; PG8_WAIT_L(0); PG8_MMA(0, 0, At, B0); PG8_BAR; PG8_SCHED;
            PG8_LDB(B1, 1, 1); PG8_STAGE(PG8_SB(1, 0), b3, voffB);
            PG8_BAR; PG8_WAIT_L(0); PG8_MMA(0, 1, At, B1); PG8_BAR;
            PG8_LDA(At, 1, 1); PG8_STAGE(PG8_SA(1, 0), a3, voffA);
            PG8_BAR; PG8_WAIT_L(0); PG8_MMA(1, 0, At, B0); PG8_BAR; PG8_SCHED;
            PG8_STAGE(PG8_SB(1, 1), b3 + hstep, voffB);
            PG8_WAIT_V(6); PG8_BAR; PG8_MMA(1, 1, At, B1); PG8_BAR;
        }
        PG8_STAMP();
        if constexpr (!Epi::AFTER_DRAIN) { E(acc, cur, wr, wc, fr, fq); S.done(cur); }
        PG8_STAMP();
        if (!has_next) break;
#pragma unroll
        for (int a = 0; a < 2; ++a)
#pragma unroll
            for (int b = 0; b < 2; ++b)
#pragma unroll
                for (int m = 0; m < 4; ++m)
#pragma unroll
                    for (int n = 0; n < 2; ++n) acc[a][b][m][n] = (f32x4){0.f, 0.f, 0.f, 0.f};
        cur = nxt; cA = nA; cB = nB; ++ui;
    }
    PG8_WAIT_V(0);
    if (wr == 0) PG8_BAR;
    PG8_BAR;
    if constexpr (Epi::AFTER_DRAIN) { E.fused(acc, cur, wr, wc, fr, fq, lds, wid, lane); S.done(cur); }
    PG8_STAMP();
    if (STAMP && wid == 0) { stamps[lane] = lane < nts ? (((unsigned long long)(unsigned)ts_hi << 32) | (unsigned)ts_lo) : 0ull;
        if (lane == 62) stamps[62] = rt_entry; if (lane == 63) stamps[63] = (unsigned long long)wall_clock64(); }
#undef PG8_STAMP
#undef PG8_SA
#undef PG8_SB
#undef PG8_STAGE
#undef PG8_LDA
#undef PG8_LDB
#undef PG8_MMA
#undef PG8_WAIT_V
#undef PG8_WAIT_L
#undef PG8_BAR
#undef PG8_SCHED
}
}
#ifndef LAS
#define LAS __attribute__((address_space(3)))
#endif
#define XB_TMO      128
#define XB_XCNT(j)  (256  + 64 * (j))
#define XB_XSUB(j)  (1280 + 64 * (j))
#define XB_XGEN(j)  (2304 + 64 * (j))
#define XB_TOP      3328
#define XB_TOPGEN   3392
#define XCD_BAR_WORDS 3456
#define XB_SPIN_CAP (1u << 18)

__device__ __forceinline__ unsigned xb_ld(unsigned* p)              { return __hip_atomic_load(p, __ATOMIC_RELAXED, __HIP_MEMORY_SCOPE_AGENT); }
__device__ __forceinline__ unsigned xb_add(unsigned* p, unsigned v) { return __hip_atomic_fetch_add(p, v, __ATOMIC_RELAXED, __HIP_MEMORY_SCOPE_AGENT); }
__device__ __forceinline__ unsigned xb_xcc_id() { return (unsigned)__builtin_amdgcn_s_getreg((3 << 11) | 20) & 0xFu; }
#define XB_SPIN(cond, bar) do { unsigned _sp = 0; while (cond) { __builtin_amdgcn_s_sleep(1); \
    if ((++_sp & 255u) == 0u) { if (xb_ld(&(bar)[XB_TMO])) break; if (_sp > XB_SPIN_CAP) { atomicAdd(&(bar)[XB_TMO], 1u); break; } } } } while (0)

struct XcdBarrier {
    unsigned* bar; unsigned x;
    volatile LAS unsigned* st;
};

__device__ __forceinline__ XcdBarrier xcd_barrier_post(unsigned* bar, volatile LAS unsigned* st) {
    XcdBarrier b; b.bar = bar; b.x = xb_xcc_id(); b.st = st;
    if (threadIdx.x == 0) (void)xb_add(&bar[XB_XCNT(b.x)], 1u);
    return b;
}
__device__ __forceinline__ void xcd_barrier_complete(unsigned* bar, unsigned x, unsigned& nloc, unsigned& nx) {
    const unsigned G = gridDim.x * gridDim.y * gridDim.z;
    unsigned sum, cnt, mine, sp = 0u;
    for (;;) {
        sum = 0u; cnt = 0u; mine = 0u;
#pragma unroll
        for (unsigned j = 0; j < 16; ++j) { const unsigned c = xb_ld(&bar[XB_XCNT(j)]); sum += c; cnt += (c > 0u) ? 1u : 0u; mine = (j == x) ? c : mine; }
        if (sum == G) break;
        __builtin_amdgcn_s_sleep(1);
        if ((++sp & 255u) == 0u) { if (xb_ld(&bar[XB_TMO])) break; if (sp > XB_SPIN_CAP) { atomicAdd(&bar[XB_TMO], 1u); break; } }
    }
    nloc = mine > 0u ? mine : 1u; nx = cnt > 0u ? cnt : 1u;
}

__device__ __forceinline__ void xcd_barrier(const XcdBarrier& b) {
    asm volatile("s_waitcnt vmcnt(0)" ::: "memory");
    __syncthreads();
    if (threadIdx.x == 0) {
        unsigned* bar = b.bar;
        __builtin_amdgcn_s_waitcnt(0);
        unsigned nloc = b.st[0], nx = b.st[1];
        if (nloc == 0u) { xcd_barrier_complete(bar, b.x, nloc, nx); b.st[0] = nloc; b.st[1] = nx; }
        const unsigned old = xb_add(&bar[XB_XSUB(b.x)], 1u);
        const unsigned gen = old / nloc;
        if (old + 1u == (gen + 1u) * nloc) {
            __builtin_amdgcn_fence(__ATOMIC_RELEASE, "agent");
            asm volatile("s_waitcnt vmcnt(0)" ::: "memory");
            const unsigned og = xb_add(&bar[XB_TOP], 1u);
            const unsigned tg = og / nx;
            if (og + 1u == (tg + 1u) * nx) xb_add(&bar[XB_TOPGEN], 1u);
            else XB_SPIN(xb_ld(&bar[XB_TOPGEN]) == tg, bar);
            __builtin_amdgcn_fence(__ATOMIC_ACQUIRE, "agent");
            xb_add(&bar[XB_XGEN(b.x)], 1u);
            asm volatile("s_waitcnt vmcnt(0)" ::: "memory");
        } else {
            XB_SPIN(xb_ld(&bar[XB_XGEN(b.x)]) == gen, bar);
            __builtin_amdgcn_fence(__ATOMIC_ACQUIRE, "agent");
            asm volatile("s_waitcnt vmcnt(0)" ::: "memory");
        }
    }
    __syncthreads();
}


using namespace pg8;
#undef LAS
#define LAS PG8_LAS
typedef unsigned u32x2 __attribute__((ext_vector_type(2)));

constexpr int D = 2048, NBATCH = 4, SEQ = 2048, CTXL = 256, DFF = 5632;
constexpr int MLAT = NBATCH * SEQ, MCTX = NBATCH * CTXL, MR = MLAT + MCTX;
constexpr int INW = 4160, INWP = 3328, GLUW = 1024;
constexpr int OFF_RQ = 0, OFF_RK = 384, OFF_RV = 768, OFF_RG = 1536, OFF_CQ = 2304, OFF_CKV = 2816, OFF_KR = 3072;
constexpr int NKEY = CTXL + SEQ;
constexpr int NCH = 18;
constexpr float EPS = 1e-6f;
constexpr int NTHR = 512;
constexpr int DEFER_GRID = 256;
constexpr int LDS_BYTES = 151552;

constexpr size_t SZ_WFFIN = (size_t)2 * DFF * D * 2;
constexpr size_t SZ_WFFOUT = (size_t)D * DFF * 2;
constexpr size_t SZ_WIN = (size_t)INWP * D * 2;
constexpr size_t SZ_WOUT = (size_t)D * D * 2;
constexpr size_t SZ_WUQ = (size_t)1280 * 512 * 2;
constexpr size_t SZ_WUKV = (size_t)1536 * 256 * 2;
constexpr size_t SZ_WPW = (size_t)512 * 512 * 2;
constexpr size_t WS_WFFIN = 0;
constexpr size_t WS_WFFOUT = WS_WFFIN + 4 * SZ_WFFIN;
constexpr size_t WS_WIN = WS_WFFOUT + 4 * SZ_WFFOUT;
constexpr size_t WS_WOUT = WS_WIN + 2 * SZ_WIN;
constexpr size_t WS_WUQ = WS_WOUT + 2 * SZ_WOUT;
constexpr size_t WS_WUKV = WS_WUQ + 2 * SZ_WUQ;
constexpr size_t WS_WPW = WS_WUKV + 2 * SZ_WUKV;
constexpr size_t WS_MOD = WS_WPW + 2 * SZ_WPW;
constexpr size_t WS_X = WS_MOD + (size_t)2 * 5 * 18432 * 4;
constexpr size_t WS_H = WS_X + (size_t)MR * D * 4;
constexpr size_t WS_Y = WS_H + (size_t)MR * D * 2;
constexpr size_t WS_P = WS_Y + (size_t)MR * D * 4;
constexpr size_t WS_QR = WS_P + (size_t)MR * INWP * 4;
constexpr size_t WS_KR = WS_QR + (size_t)MR * 384 * 4;
constexpr size_t WS_CQN = WS_KR + (size_t)MR * 384 * 4;
constexpr size_t WS_CKVN = WS_CQN + (size_t)MR * 512 * 2;
constexpr size_t WS_CVN = WS_CKVN + (size_t)MR * 256 * 2;
constexpr size_t WS_QF = WS_CVN + (size_t)MR * 512 * 2;
constexpr size_t WS_KVF = WS_QF + (size_t)MR * 1280 * 4;
constexpr size_t WS_QB = WS_KVF + (size_t)MR * 1536 * 4;
constexpr size_t WS_KB = WS_QB + (size_t)NBATCH * 6 * NKEY * 192 * 2;
constexpr size_t WS_VT = WS_KB + (size_t)NBATCH * 6 * NKEY * 192 * 2;
constexpr size_t WS_CAT = WS_VT + (size_t)NBATCH * 6 * 128 * NKEY * 2;
constexpr size_t WS_SF = WS_CAT + (size_t)MR * D * 2;
constexpr size_t WS_SB = WS_SF + (size_t)NBATCH * 6 * NCH * 8192 * 4;
constexpr size_t WS_TAB = WS_SB + (size_t)NBATCH * 6 * NCH * 8192 * 4;
constexpr size_t WS_YP = WS_TAB + (size_t)2048 * 32 * 8;
constexpr size_t WS_BAR = WS_YP + (size_t)4 * MCTX * D * 4;
constexpr size_t WS_RKB = WS_BAR + 16384;
constexpr size_t WS_RVT = WS_RKB + (size_t)24 * NCH * 128 * 64 * 2;
constexpr size_t SZ_WGLU = (size_t)GLUW * D * 2;
constexpr size_t WS_WGLU = WS_RVT + (size_t)24 * NCH * 128 * 128 * 2;
constexpr size_t WS_PG = WS_WGLU + 2 * SZ_WGLU;
constexpr size_t WS_END = WS_PG + (size_t)MR * GLUW * 2;

#ifndef REPMASK
#define REPMASK 0ull
#endif
struct Args { const float* in[23]; float* out; unsigned char* ws; unsigned long long sub; int ph_lo, ph_hi; };

__device__ __forceinline__ float wave_sum(float v) {
#pragma unroll
    for (int o = 32; o; o >>= 1) v += __shfl_xor(v, o);
    return v;
}
__device__ __forceinline__ float siluf(float a) { return a * __builtin_amdgcn_rcpf(1.f + __expf(-a)); }
__device__ __forceinline__ float sigmf(float a) { return __builtin_amdgcn_rcpf(1.f + __expf(-a)); }
__device__ __forceinline__ bf16_t f2bf(float f) { unsigned u = __float_as_uint(f); u += 0x7FFFu + ((u >> 16) & 1u); return (bf16_t)(u >> 16); }
__device__ __forceinline__ float bf2f(bf16_t v) { return __uint_as_float((unsigned)v << 16); }
__device__ __forceinline__ f32x4 ld_bf4(const bf16_t* p) { const u32x2 w = *(const u32x2*)p; return (f32x4){__uint_as_float(w.x << 16), __uint_as_float(w.x & 0xffff0000u), __uint_as_float(w.y << 16), __uint_as_float(w.y & 0xffff0000u)}; }
__device__ __forceinline__ int mod_of_row(int row) { return row < MLAT ? (row >> 11) : 4; }

__device__ __forceinline__ void rope_compute(int i, int t, float& cs, float& sn) {
    const float inv = exp2f(-(float)(i & 15) * (13.287712379549449f / 16.f));
    const float pos = (float)((i < 16) ? (t >> 6) : (t & 63));
    sincosf(pos * inv, &sn, &cs);
}
__device__ __forceinline__ void rope_cs(const f32x2* tab, int i, int t, bool latent, float& cs, float& sn) {
    const f32x2 v = tab[(latent ? t : 0) * 32 + i]; cs = latent ? v.x : 1.f; sn = latent ? v.y : 0.f;
}

__device__ __forceinline__ int map_col(int mode, int n) {
    if (mode == 1) { const int g = n >> 8, r = n & 255; return (r < 128) ? g * 128 + r : DFF + g * 128 + (r - 128); }
    if (mode == 2) return n < 2304 ? n : n + GLUW;
    if (mode == 3) return n + 2304;
    return n;
}
template <int MODE>
__device__ __forceinline__ void transpose_job(const float* src, bf16_t* dst, const int K, const int Nsrc, const int Ndst, const int goff, LAS float* tl) {
    const int tid = threadIdx.x, G = gridDim.x;
    const int ntn = Ndst >> 7, ntile = (K >> 7) * ntn;
    int t = ((int)blockIdx.x - goff % G + G) % G;
    const int n4 = (tid & 31) * 4, kr = tid >> 5;
    f32x4 v[8];
#define TJ_ISSUE(tt) do { const int tk_ = (tt) / ntn, tn_ = (tt) % ntn, k0_ = tk_ * 128, n_ = tn_ * 128 + n4; \
        const int scol_ = map_col(MODE, n_); \
        const bool valid_ = scol_ < Nsrc; const float* p_ = src + (size_t)(k0_ + kr) * Nsrc + scol_; \
        _Pragma("unroll") for (int i = 0; i < 8; ++i) v[i] = valid_ ? *(const f32x4*)(p_ + (size_t)(16 * i) * Nsrc) : (f32x4){0.f, 0.f, 0.f, 0.f}; } while (0)
    if (t < ntile) TJ_ISSUE(t);
    for (; t < ntile; t += G) {
        const int tk = t / ntn, tn = t % ntn, k0 = tk * 128, n0 = tn * 128;
#pragma unroll
        for (int i = 0; i < 8; ++i) { LAS float* q = tl + (kr + 16 * i) * 129 + n4; q[0] = v[i][0]; q[1] = v[i][1]; q[2] = v[i][2]; q[3] = v[i][3]; }
        __syncthreads();
        if (t + G < ntile) TJ_ISSUE(t + G);
#pragma unroll
        for (int i = 0; i < 4; ++i) { const int idx = tid + 512 * i, k8 = (idx & 15) * 8, n = idx >> 4; float x[8];
#pragma unroll
            for (int j = 0; j < 8; ++j) x[j] = tl[(k8 + j) * 129 + n];
            u32x4 w; w.x = cvt_pk_bf16(x[0], x[1]); w.y = cvt_pk_bf16(x[2], x[3]); w.z = cvt_pk_bf16(x[4], x[5]); w.w = cvt_pk_bf16(x[6], x[7]);
            *(u32x4*)(dst + (size_t)(n0 + n) * K + k0 + k8) = w; }
        __syncthreads();
    }
}

__device__ __forceinline__ void phase_prologue(const Args& a, LAS unsigned char* lds) {
    const int tid = threadIdx.x, G = gridDim.x, bid = blockIdx.x;
    LAS float* sl = (LAS float*)lds;
    LAS float* red = (LAS float*)(lds + 40960);
    LAS float* tl = (LAS float*)lds;
    for (int i = tid; i < 5 * 2048; i += NTHR) { const int m = i >> 11, k = i & 2047; const float c = m < 4 ? a.in[1][m * 2048 + k] : a.in[3][k]; sl[i] = siluf(c); }
    __syncthreads();
    float* MOD = (float*)(a.ws + WS_MOD);
    for (int it = bid; it < 256; it += G) {
        const int l = it >> 7, n0 = (it & 127) * 144, c4 = tid % 36, sl_i = tid / 36;
        f32x4 acc[5];
#pragma unroll
        for (int m = 0; m < 5; ++m) acc[m] = (f32x4){0.f, 0.f, 0.f, 0.f};
        if (sl_i < 14) {
            const float* w = a.in[4] + (size_t)l * 2048 * 18432 + n0 + c4 * 4;
#pragma unroll 8
            for (int k = sl_i; k < 2048; k += 14) { const f32x4 wv = *(const f32x4*)(w + (size_t)k * 18432);
#pragma unroll
                for (int m = 0; m < 5; ++m) acc[m] += wv * sl[m * 2048 + k]; }
#pragma unroll
            for (int m = 0; m < 5; ++m) { LAS float* q = red + (sl_i * 5 + m) * 144 + c4 * 4; q[0] = acc[m][0]; q[1] = acc[m][1]; q[2] = acc[m][2]; q[3] = acc[m][3]; }
        }
        __syncthreads();
        for (int o = tid; o < 5 * 144; o += NTHR) { const int m = o / 144, c = o % 144; float s = 0.f;
#pragma unroll
            for (int q = 0; q < 14; ++q) s += red[(q * 5 + m) * 144 + c];
            MOD[((size_t)l * 5 + m) * 18432 + n0 + c] = s + a.in[5][l * 18432 + n0 + c]; }
        __syncthreads();
    }
    { f32x2* tab = (f32x2*)(a.ws + WS_TAB);
      for (int e = bid * NTHR + tid; e < 2048 * 32; e += G * NTHR) { float cs, sn; rope_compute(e & 31, e >> 5, cs, sn); tab[e] = (f32x2){cs, sn}; } }
    unsigned char* ws = a.ws; int goff = 0;
    const bool defer = (G == DEFER_GRID);
#pragma unroll 1
    for (int l = 0; l < 2; ++l) {
        if (defer && l == 1) break;
        transpose_job<1>(a.in[7] + (size_t)l * D * 2 * DFF, (bf16_t*)(ws + WS_WFFIN + (size_t)(l * 2 + 0) * SZ_WFFIN), D, 2 * DFF, 2 * DFF, goff, tl); goff += 16 * 88;
        transpose_job<0>(a.in[8] + (size_t)l * DFF * D, (bf16_t*)(ws + WS_WFFOUT + (size_t)(l * 2 + 0) * SZ_WFFOUT), DFF, D, D, goff, tl); goff += 44 * 16;
        transpose_job<2>(a.in[11] + (size_t)l * D * INW, (bf16_t*)(ws + WS_WIN + (size_t)l * SZ_WIN), D, INW, INWP, goff, tl); goff += 16 * 26;
        transpose_job<3>(a.in[11] + (size_t)l * D * INW, (bf16_t*)(ws + WS_WGLU + (size_t)l * SZ_WGLU), D, INW, GLUW, goff, tl); goff += 16 * 8;
        transpose_job<0>(a.in[20] + (size_t)l * 512 * 1152, (bf16_t*)(ws + WS_WUQ + (size_t)l * SZ_WUQ), 512, 1152, 1280, goff, tl); goff += 4 * 10;
        transpose_job<0>(a.in[22] + (size_t)l * 256 * 1536, (bf16_t*)(ws + WS_WUKV + (size_t)l * SZ_WUKV), 256, 1536, 1536, goff, tl); goff += 2 * 12;
        transpose_job<0>(a.in[18] + (size_t)l * 512 * 512, (bf16_t*)(ws + WS_WPW + (size_t)l * SZ_WPW), 512, 512, 512, goff, tl); goff += 4 * 4;
        if (defer) break;
        transpose_job<0>(a.in[12] + (size_t)l * D * D, (bf16_t*)(ws + WS_WOUT + (size_t)l * SZ_WOUT), D, D, D, goff, tl); goff += 16 * 16;
        transpose_job<1>(a.in[9] + (size_t)l * D * 2 * DFF, (bf16_t*)(ws + WS_WFFIN + (size_t)(l * 2 + 1) * SZ_WFFIN), D, 2 * DFF, 2 * DFF, goff, tl); goff += 16 * 88;
        transpose_job<0>(a.in[10] + (size_t)l * DFF * D, (bf16_t*)(ws + WS_WFFOUT + (size_t)(l * 2 + 1) * SZ_WFFOUT), DFF, D, D, goff, tl); goff += 44 * 16;
    }
}

constexpr int DJ_N[12] = {256, 1408, 704,   1408, 704, 544, 40, 24, 16, 256, 1408, 704};
constexpr int NDEF = 256 + 1408 + 704 + 1408 + 704 + 544 + 40 + 24 + 16 + 256 + 1408 + 704;
__device__ __forceinline__ void dj_decode(const Args& a, int d, const float*& src, bf16_t*& dst, int& K, int& Nsrc, int& Ndst, int& mode, int& t) {
    unsigned char* ws = a.ws; mode = 0; t = d;
    if (t < 256)  { src = a.in[12];                        dst = (bf16_t*)(ws + WS_WOUT);                  K = D;   Nsrc = D;       Ndst = D;       return; } t -= 256;
    if (t < 1408) { src = a.in[9];                         dst = (bf16_t*)(ws + WS_WFFIN + 1 * SZ_WFFIN);  K = D;   Nsrc = 2 * DFF; Ndst = 2 * DFF; mode = 1; return; } t -= 1408;
    if (t < 704)  { src = a.in[10];                        dst = (bf16_t*)(ws + WS_WFFOUT + 1 * SZ_WFFOUT); K = DFF; Nsrc = D;      Ndst = D;       return; } t -= 704;
    if (t < 1408) { src = a.in[7] + (size_t)D * 2 * DFF;   dst = (bf16_t*)(ws + WS_WFFIN + 2 * SZ_WFFIN);  K = D;   Nsrc = 2 * DFF; Ndst = 2 * DFF; mode = 1; return; } t -= 1408;
    if (t < 704)  { src = a.in[8] + (size_t)DFF * D;       dst = (bf16_t*)(ws + WS_WFFOUT + 2 * SZ_WFFOUT); K = DFF; Nsrc = D;      Ndst = D;       return; } t -= 704;
    if (t < 416)  { src = a.in[11] + (size_t)D * INW;      dst = (bf16_t*)(ws + WS_WIN + SZ_WIN);          K = D;   Nsrc = INW;     Ndst = INWP;    mode = 2; return; } t -= 416;
    if (t < 128)  { src = a.in[11] + (size_t)D * INW;      dst = (bf16_t*)(ws + WS_WGLU + SZ_WGLU);        K = D;   Nsrc = INW;     Ndst = GLUW;    mode = 3; return; } t -= 128;
    if (t < 40)   { src = a.in[20] + (size_t)512 * 1152;   dst = (bf16_t*)(ws + WS_WUQ + SZ_WUQ);          K = 512; Nsrc = 1152;    Ndst = 1280;    return; } t -= 40;
    if (t < 24)   { src = a.in[22] + (size_t)256 * 1536;   dst = (bf16_t*)(ws + WS_WUKV + SZ_WUKV);        K = 256; Nsrc = 1536;    Ndst = 1536;    return; } t -= 24;
    if (t < 16)   { src = a.in[18] + (size_t)512 * 512;    dst = (bf16_t*)(ws + WS_WPW + SZ_WPW);          K = 512; Nsrc = 512;     Ndst = 512;     return; } t -= 16;
    if (t < 256)  { src = a.in[12] + (size_t)D * D;        dst = (bf16_t*)(ws + WS_WOUT + SZ_WOUT);        K = D;   Nsrc = D;       Ndst = D;       return; } t -= 256;
    if (t < 1408) { src = a.in[9] + (size_t)D * 2 * DFF;   dst = (bf16_t*)(ws + WS_WFFIN + 3 * SZ_WFFIN);  K = D;   Nsrc = 2 * DFF; Ndst = 2 * DFF; mode = 1; return; } t -= 1408;
    src = a.in[10] + (size_t)DFF * D; dst = (bf16_t*)(ws + WS_WFFOUT + 3 * SZ_WFFOUT); K = DFF; Nsrc = D; Ndst = D;
}
__device__ __forceinline__ void deferred_convert(const Args& a, int first, int stride, int count, LAS float* tl) {
    const int tid = threadIdx.x, n4 = (tid & 31) * 4, kr = tid >> 5;
    f32x4 v[8];
#define DJ_ISSUE(dd) do { const float* src_; bf16_t* dst_; int K_, Ns_, Nd_, md_, t_; dj_decode(a, (dd), src_, dst_, K_, Ns_, Nd_, md_, t_); \
        const int ntn_ = Nd_ >> 7, tk_ = t_ / ntn_, tn_ = t_ % ntn_, k0_ = tk_ * 128, n_ = tn_ * 128 + n4; \
        const int scol_ = map_col(md_, n_); \
        const bool valid_ = scol_ < Ns_; const float* p_ = src_ + (size_t)(k0_ + kr) * Ns_ + scol_; \
        _Pragma("unroll") for (int i = 0; i < 8; ++i) v[i] = valid_ ? *(const f32x4*)(p_ + (size_t)(16 * i) * Ns_) : (f32x4){0.f, 0.f, 0.f, 0.f}; } while (0)
    int d = first;
    if (count > 0 && d < NDEF) DJ_ISSUE(d);
    for (int k = 0; k < count && d < NDEF; ++k, d += stride) {
        const float* src; bf16_t* dst; int K, Nsrc, Ndst, mode, t; dj_decode(a, d, src, dst, K, Nsrc, Ndst, mode, t);
        const int ntn = Ndst >> 7, tk = t / ntn, tn = t % ntn, k0 = tk * 128, n0 = tn * 128;
#pragma unroll
        for (int i = 0; i < 8; ++i) { LAS float* q = tl + (kr + 16 * i) * 129 + n4; q[0] = v[i][0]; q[1] = v[i][1]; q[2] = v[i][2]; q[3] = v[i][3]; }
        __syncthreads();
        if (k + 1 < count && d + stride < NDEF) DJ_ISSUE(d + stride);
#pragma unroll
        for (int i = 0; i < 4; ++i) { const int idx = tid + 512 * i, k8 = (idx & 15) * 8, n = idx >> 4; float x[8];
#pragma unroll
            for (int j = 0; j < 8; ++j) x[j] = tl[(k8 + j) * 129 + n];
            u32x4 w; w.x = cvt_pk_bf16(x[0], x[1]); w.y = cvt_pk_bf16(x[2], x[3]); w.z = cvt_pk_bf16(x[4], x[5]); w.w = cvt_pk_bf16(x[6], x[7]);
            *(u32x4*)(dst + (size_t)(n0 + n) * K + k0 + k8) = w; }
        __syncthreads();
    }
#undef DJ_ISSUE
}
constexpr int DW_START2 = 0,    DW_IDLE2 = 48,   DW_Q2 = 10;
constexpr int DW_START3 = DW_START2 + (256 - DW_IDLE2) * DW_Q2,   DW_IDLE3 = 128,  DW_Q3 = 6;
constexpr int DW_START5 = DW_START3 + (256 - DW_IDLE3) * DW_Q3,   DW_IDLE5 = 212,  DW_Q5 = 12;
constexpr int DW_START9 = DW_START5 + (256 - DW_IDLE5) * DW_Q5,   DW_IDLE9 = 216,  DW_Q9 = 22;
constexpr int DW_START10 = DW_START9 + (256 - DW_IDLE9) * DW_Q9,  DW_IDLE10 = 128, DW_Q10 = 2;
constexpr int DW_START12 = DW_START10 + (256 - DW_IDLE10) * DW_Q10, DW_IDLE12 = 48, DW_Q12 = 10;
constexpr int DW_START13 = DW_START12 + (256 - DW_IDLE12) * DW_Q12, DW_IDLE13 = 128, DW_Q13 = 8;
constexpr int DW_END = DW_START13 + (256 - DW_IDLE13) * DW_Q13;
static_assert(DW_START3 >= 256, "W_out(0) must be converted before phase 10");
static_assert(DW_START3 >= 256 + 1408, "FFN-b in (0) must be converted before phase 12");
static_assert(DW_START5 >= 256 + 1408 + 704, "FFN-b out (0) must be converted before phase 13");
static_assert(DW_END >= NDEF, "every deferred tile must be converted before layer 1 starts");
__device__ __forceinline__ void deferred_window(const Args& a, int l, int idle0, int start, int quota, LAS unsigned char* lds) {
    if (l != 0 || gridDim.x != DEFER_GRID || (int)blockIdx.x < idle0) return;
    deferred_convert(a, start + ((int)blockIdx.x - idle0), DEFER_GRID - idle0, quota, (LAS float*)lds);
}

__device__ __forceinline__ void norm_mod_store(const f32x4 (&x)[8], const float* g, const float* shift, const float* scale, bf16_t* hrow, int lane) {
    float ss = 0.f;
#pragma unroll
    for (int i = 0; i < 8; ++i) ss += (x[i][0] * x[i][0] + x[i][1] * x[i][1]) + (x[i][2] * x[i][2] + x[i][3] * x[i][3]);
    ss = wave_sum(ss);
    const float r = rsqrtf(ss * (1.f / 2048.f) + EPS);
#pragma unroll
    for (int i = 0; i < 8; ++i) { const int c = lane * 4 + i * 256;
        const f32x4 gv = *(const f32x4*)(g + c), sh = *(const f32x4*)(shift + c), sc = *(const f32x4*)(scale + c);
        const f32x4 h = (x[i] * r * gv) * (sc + 1.f) + sh;
        u32x2 w; w.x = cvt_pk_bf16(h[0], h[1]); w.y = cvt_pk_bf16(h[2], h[3]);
        *(u32x2*)(hrow + c) = w; }
}

__device__ __forceinline__ void phase_norm0(const Args& a, LAS unsigned char* lds) {
    const int tid = threadIdx.x, lane = tid & 63, wid = tid >> 6, G = gridDim.x;
    float* X = (float*)(a.ws + WS_X); bf16_t* H = (bf16_t*)(a.ws + WS_H); const float* MOD = (const float*)(a.ws + WS_MOD);
    const float* gpre = a.in[6];
    LAS float* G2 = (LAS float*)lds; LAS float* SH = G2 + D;
    const int per = (MR + G - 1) / G, r0 = (int)blockIdx.x * per, r1 = (r0 + per < MR) ? r0 + per : MR;
    if (r0 >= MR) return;
    const int m0 = mod_of_row(r0);
    { const float* md = MOD + (size_t)m0 * 18432; const int c = tid * 4;
      *(LAS f32x4*)(G2 + c) = *(const f32x4*)(gpre + c) * (*(const f32x4*)(md + D + c) + 1.f); *(LAS f32x4*)(SH + c) = *(const f32x4*)(md + c); }
    __syncthreads();
#define RC(k) (lane * 8 + ((k) >> 1) * 512 + ((k) & 1) * 4)
#define N0_LOAD(xx, rw) do { const float* src_ = (rw) < MLAT ? a.in[0] + (size_t)(rw) * D : a.in[2] + (size_t)((rw) - MLAT) * D; \
        _Pragma("unroll") for (int k = 0; k < 8; ++k) xx[k] = *(const f32x4*)(src_ + RC(k)); } while (0)
    f32x4 x[8], xn[8];
    if (r0 + wid < r1) N0_LOAD(x, r0 + wid);
    for (int row = r0 + wid; row < r1; row += 8) {
        const int m = mod_of_row(row); const bool fast = (m == m0); const bool more = row + 8 < r1;
        if (more) N0_LOAD(xn, row + 8);
        const float* md = MOD + (size_t)m * 18432;
        float s2 = 0.f;
#pragma unroll
        for (int k = 0; k < 8; ++k) { *(f32x4*)(X + (size_t)row * D + RC(k)) = x[k]; s2 += (x[k][0] * x[k][0] + x[k][1] * x[k][1]) + (x[k][2] * x[k][2] + x[k][3] * x[k][3]); }
        s2 = wave_sum(s2);
        const float r2 = rsqrtf(s2 * (1.f / 2048.f) + EPS);
#pragma unroll
        for (int i = 0; i < 4; ++i) { f32x4 h[2];
#pragma unroll
            for (int hh = 0; hh < 2; ++hh) { const int k = 2 * i + hh, c = RC(k);
                const f32x4 g2 = fast ? *(const LAS f32x4*)(G2 + c) : *(const f32x4*)(gpre + c) * (*(const f32x4*)(md + D + c) + 1.f);
                const f32x4 sh = fast ? *(const LAS f32x4*)(SH + c) : *(const f32x4*)(md + c);
                h[hh] = x[k] * r2 * g2 + sh; }
            u32x4 w; w.x = cvt_pk_bf16(h[0][0], h[0][1]); w.y = cvt_pk_bf16(h[0][2], h[0][3]); w.z = cvt_pk_bf16(h[1][0], h[1][1]); w.w = cvt_pk_bf16(h[1][2], h[1][3]);
            *(u32x4*)(H + (size_t)row * D + lane * 8 + i * 512) = w; }
        if (more) {
#pragma unroll
            for (int k = 0; k < 8; ++k) x[k] = xn[k]; }
    }
#undef N0_LOAD
#undef RC
    __syncthreads();
}

__device__ __forceinline__ void phase_resnorm(const Args& a, int l, int gi_post, int mi_gate, float rs, bool has_next, int ln, int gi_pre, int mi_shift, int mi_scale, bool final_out, int M, LAS unsigned char* lds) {
    const float* YP = (const float*)(a.ws + WS_YP);
    const int tid = threadIdx.x, lane = tid & 63, wid = tid >> 6, G = gridDim.x;
    float* X = (float*)(a.ws + WS_X); const bf16_t* Y = (const bf16_t*)(a.ws + WS_Y); bf16_t* H = (bf16_t*)(a.ws + WS_H); const float* MOD = (const float*)(a.ws + WS_MOD);
    const float* gpost = a.in[6] + (size_t)(l * 6 + gi_post) * D; const float* gpre = a.in[6] + (size_t)(ln * 6 + gi_pre) * D;
    LAS float* GG = (LAS float*)lds; LAS float* G2 = GG + D; LAS float* SH = G2 + D;
    const int per = (M + G - 1) / G, r0 = (int)blockIdx.x * per, r1 = (r0 + per < M) ? r0 + per : M;
    if (r0 >= M) return;
    const int m0 = mod_of_row(r0);
    { const float* gate = MOD + ((size_t)l * 5 + m0) * 18432 + (size_t)mi_gate * D; const float* md = MOD + ((size_t)ln * 5 + m0) * 18432;
      const int c = tid * 4;
      const f32x4 gt = *(const f32x4*)(gate + c), gp = *(const f32x4*)(gpost + c);
      *(LAS f32x4*)(GG + c) = gt * rs * gp;
      if (has_next) { const f32x4 g = *(const f32x4*)(gpre + c), sc = *(const f32x4*)(md + (size_t)mi_scale * D + c), sh = *(const f32x4*)(md + (size_t)mi_shift * D + c);
          *(LAS f32x4*)(G2 + c) = g * (sc + 1.f); *(LAS f32x4*)(SH + c) = sh; } }
    __syncthreads();
#define RC(k) (lane * 8 + ((k) >> 1) * 512 + ((k) & 1) * 4)
#define RN_LOAD(xx, yy, rw) do { _Pragma("unroll") for (int k = 0; k < 8; ++k) xx[k] = *(const f32x4*)(X + (size_t)(rw) * D + RC(k)); \
        if ((rw) < MLAT) { _Pragma("unroll") for (int i = 0; i < 4; ++i) { const u32x4 w = *(const u32x4*)(Y + (size_t)(rw) * D + lane * 8 + i * 512); \
                yy[2 * i] = (f32x4){__uint_as_float(w.x << 16), __uint_as_float(w.x & 0xffff0000u), __uint_as_float(w.y << 16), __uint_as_float(w.y & 0xffff0000u)}; \
                yy[2 * i + 1] = (f32x4){__uint_as_float(w.z << 16), __uint_as_float(w.z & 0xffff0000u), __uint_as_float(w.w << 16), __uint_as_float(w.w & 0xffff0000u)}; } } \
        else { _Pragma("unroll") for (int k = 0; k < 8; ++k) { const float* yp = YP + (size_t)((rw) - MLAT) * D + RC(k); yy[k] = (*(const f32x4*)yp + *(const f32x4*)(yp + (size_t)MCTX * D)) + (*(const f32x4*)(yp + (size_t)2 * MCTX * D) + *(const f32x4*)(yp + (size_t)3 * MCTX * D)); } } } while (0)
    f32x4 y[8], x[8], yn[8], xn[8];
    const int ntail = (r1 - r0) & 7, rend = (ntail == 4) ? r1 - 4 : r1;
    LAS float* red = (LAS float*)(lds + 3 * D * 4);
    const int trow = rend + (wid >> 1), thalf = wid & 1;
    f32x4 xt[4], yt[4];
    if (ntail == 4) {
#pragma unroll
        for (int kk = 0; kk < 4; ++kk) xt[kk] = *(const f32x4*)(X + (size_t)trow * D + RC(4 * thalf + kk));
        if (trow < MLAT) {
#pragma unroll
            for (int ii = 0; ii < 2; ++ii) { const u32x4 w = *(const u32x4*)(Y + (size_t)trow * D + lane * 8 + (2 * thalf + ii) * 512);
                yt[2 * ii] = (f32x4){__uint_as_float(w.x << 16), __uint_as_float(w.x & 0xffff0000u), __uint_as_float(w.y << 16), __uint_as_float(w.y & 0xffff0000u)};
                yt[2 * ii + 1] = (f32x4){__uint_as_float(w.z << 16), __uint_as_float(w.z & 0xffff0000u), __uint_as_float(w.w << 16), __uint_as_float(w.w & 0xffff0000u)}; }
        } else {
#pragma unroll
            for (int kk = 0; kk < 4; ++kk) { const float* yp = YP + (size_t)(trow - MLAT) * D + RC(4 * thalf + kk); yt[kk] = (*(const f32x4*)yp + *(const f32x4*)(yp + (size_t)MCTX * D)) + (*(const f32x4*)(yp + (size_t)2 * MCTX * D) + *(const f32x4*)(yp + (size_t)3 * MCTX * D)); } }
    }
    if (r0 + wid < rend) RN_LOAD(x, y, r0 + wid);
    for (int row = r0 + wid; row < rend; row += 8) {
        const int m = mod_of_row(row); const bool fast = (m == m0);
        const bool more = row + 8 < rend;
        if (more) RN_LOAD(xn, yn, row + 8);
        float ss = 0.f;
#pragma unroll
        for (int i = 0; i < 8; ++i) ss += (y[i][0] * y[i][0] + y[i][1] * y[i][1]) + (y[i][2] * y[i][2] + y[i][3] * y[i][3]);
        ss = wave_sum(ss);
        const float r = rsqrtf(ss * (1.f / 2048.f) + EPS);
        const float* gate = MOD + ((size_t)l * 5 + m) * 18432 + (size_t)mi_gate * D; const float* md = MOD + ((size_t)ln * 5 + m) * 18432;
        float s2 = 0.f;
#pragma unroll
        for (int i = 0; i < 8; ++i) { const int c = RC(i);
            const f32x4 gg = fast ? *(const LAS f32x4*)(GG + c) : *(const f32x4*)(gate + c) * rs * *(const f32x4*)(gpost + c);
            x[i] = x[i] + gg * (y[i] * r);
            if (final_out) *(f32x4*)(a.out + (size_t)row * D + c) = x[i]; else *(f32x4*)(X + (size_t)row * D + c) = x[i];
            s2 += (x[i][0] * x[i][0] + x[i][1] * x[i][1]) + (x[i][2] * x[i][2] + x[i][3] * x[i][3]); }
        if (has_next) {
            s2 = wave_sum(s2);
            const float r2 = rsqrtf(s2 * (1.f / 2048.f) + EPS);
#pragma unroll
            for (int i = 0; i < 4; ++i) { f32x4 h[2];
#pragma unroll
                for (int hh = 0; hh < 2; ++hh) { const int k = 2 * i + hh, c = RC(k);
                    const f32x4 g2 = fast ? *(const LAS f32x4*)(G2 + c) : *(const f32x4*)(gpre + c) * (*(const f32x4*)(md + (size_t)mi_scale * D + c) + 1.f);
                    const f32x4 sh = fast ? *(const LAS f32x4*)(SH + c) : *(const f32x4*)(md + (size_t)mi_shift * D + c);
                    h[hh] = x[k] * r2 * g2 + sh; }
                u32x4 w; w.x = cvt_pk_bf16(h[0][0], h[0][1]); w.y = cvt_pk_bf16(h[0][2], h[0][3]); w.z = cvt_pk_bf16(h[1][0], h[1][1]); w.w = cvt_pk_bf16(h[1][2], h[1][3]);
                *(u32x4*)(H + (size_t)row * D + lane * 8 + i * 512) = w; } }
        if (more) {
#pragma unroll
            for (int i = 0; i < 8; ++i) { x[i] = xn[i]; y[i] = yn[i]; } }
    }
    if (ntail == 4) {
        const int row = trow, m = mod_of_row(row); const bool fast = (m == m0);
        float ss = 0.f;
#pragma unroll
        for (int kk = 0; kk < 4; ++kk) ss += (yt[kk][0] * yt[kk][0] + yt[kk][1] * yt[kk][1]) + (yt[kk][2] * yt[kk][2] + yt[kk][3] * yt[kk][3]);
        ss = wave_sum(ss);
        if (lane == 0) red[wid] = ss;
        __syncthreads();
        const float r = rsqrtf((red[wid] + red[wid ^ 1]) * (1.f / 2048.f) + EPS);
        const float* gate = MOD + ((size_t)l * 5 + m) * 18432 + (size_t)mi_gate * D; const float* md = MOD + ((size_t)ln * 5 + m) * 18432;
        float s2 = 0.f;
#pragma unroll
        for (int kk = 0; kk < 4; ++kk) { const int c = RC(4 * thalf + kk);
            const f32x4 gg = fast ? *(const LAS f32x4*)(GG + c) : *(const f32x4*)(gate + c) * rs * *(const f32x4*)(gpost + c);
            xt[kk] = xt[kk] + gg * (yt[kk] * r);
            if (final_out) *(f32x4*)(a.out + (size_t)row * D + c) = xt[kk]; else *(f32x4*)(X + (size_t)row * D + c) = xt[kk];
            s2 += (xt[kk][0] * xt[kk][0] + xt[kk][1] * xt[kk][1]) + (xt[kk][2] * xt[kk][2] + xt[kk][3] * xt[kk][3]); }
        if (has_next) {
            s2 = wave_sum(s2);
            if (lane == 0) red[8 + wid] = s2;
            __syncthreads();
            const float r2 = rsqrtf((red[8 + wid] + red[8 + (wid ^ 1)]) * (1.f / 2048.f) + EPS);
#pragma unroll
            for (int ii = 0; ii < 2; ++ii) { f32x4 h[2];
#pragma unroll
                for (int hh = 0; hh < 2; ++hh) { const int kk = 2 * ii + hh, c = RC(4 * thalf + kk);
                    const f32x4 g2 = fast ? *(const LAS f32x4*)(G2 + c) : *(const f32x4*)(gpre + c) * (*(const f32x4*)(md + (size_t)mi_scale * D + c) + 1.f);
                    const f32x4 sh = fast ? *(const LAS f32x4*)(SH + c) : *(const f32x4*)(md + (size_t)mi_shift * D + c);
                    h[hh] = xt[kk] * r2 * g2 + sh; }
                u32x4 w; w.x = cvt_pk_bf16(h[0][0], h[0][1]); w.y = cvt_pk_bf16(h[0][2], h[0][3]); w.z = cvt_pk_bf16(h[1][0], h[1][1]); w.w = cvt_pk_bf16(h[1][2], h[1][3]);
                *(u32x4*)(H + (size_t)row * D + lane * 8 + (2 * thalf + ii) * 512) = w; } }
    }
#undef RC
#undef RN_LOAD
    __syncthreads();
}

struct EpiF32 {
    static constexpr bool PERM = false, AFTER_DRAIN = false;
    float* C; int ldc;
    __device__ __forceinline__ void operator()(const f32x4 (&acc)[2][2][4][2], const Unit& u, int wr, int wc, int fr, int fq) const {
        const int row0 = u.pm * BM + wr * 64 + fr, col0 = u.pn * BM + wc * 32 + 4 * fq;
#pragma unroll
        for (int ai = 0; ai < 2; ++ai)
#pragma unroll
            for (int m = 0; m < 4; ++m) { float* rowp = C + (size_t)(row0 + ai * HALF + m * 16) * ldc + col0;
#pragma unroll
                for (int bj = 0; bj < 2; ++bj)
#pragma unroll
                    for (int n = 0; n < 2; ++n) *(f32x4*)(rowp + bj * HALF + n * 16) = acc[ai][bj][m][n]; }
    }
};
struct EpiSwiGLU {
    static constexpr bool PERM = true, AFTER_DRAIN = false;
    bf16_t* O; int ldc;
    __device__ __forceinline__ void operator()(const f32x4 (&acc)[2][2][4][2], const Unit& u, int wr, int wc, int fr, int fq) const {
        const int row0 = u.pm * BM + wr * 64 + fr, col0 = u.pn * 128 + wc * 32 + 8 * fq;
#pragma unroll
        for (int ai = 0; ai < 2; ++ai)
#pragma unroll
            for (int m = 0; m < 4; ++m) { bf16_t* rowp = O + (size_t)(row0 + ai * HALF + m * 16) * ldc + col0; float v[8];
#pragma unroll
                for (int n = 0; n < 2; ++n)
#pragma unroll
                    for (int j = 0; j < 4; ++j) v[4 * n + j] = siluf(acc[ai][0][m][n][j]) * acc[ai][1][m][n][j];
                u32x4 w; w.x = cvt_pk_bf16(v[0], v[1]); w.y = cvt_pk_bf16(v[2], v[3]); w.z = cvt_pk_bf16(v[4], v[5]); w.w = cvt_pk_bf16(v[6], v[7]);
                *(u32x4*)rowp = w; }
    }
};
struct EpiBf16 {
    static constexpr bool PERM = true, AFTER_DRAIN = false;
    bf16_t* O; int ldc;
    __device__ __forceinline__ void operator()(const f32x4 (&acc)[2][2][4][2], const Unit& u, int wr, int wc, int fr, int fq) const {
        const int row0 = u.pm * BM + wr * 64 + fr, col0 = u.pn * BM + wc * 32 + 8 * fq;
#pragma unroll
        for (int ai = 0; ai < 2; ++ai)
#pragma unroll
            for (int m = 0; m < 4; ++m) { bf16_t* rowp = O + (size_t)(row0 + ai * HALF + m * 16) * ldc + col0;
#pragma unroll
                for (int bj = 0; bj < 2; ++bj) { const f32x4 v0 = acc[ai][bj][m][0], v1 = acc[ai][bj][m][1];
                    u32x4 w; w.x = cvt_pk_bf16(v0[0], v0[1]); w.y = cvt_pk_bf16(v0[2], v0[3]); w.z = cvt_pk_bf16(v1[0], v1[1]); w.w = cvt_pk_bf16(v1[2], v1[3]);
                    *(u32x4*)(rowp + bj * HALF) = w; } }
    }
};

template <class Epi>
__device__ __forceinline__ void run_gemm(LAS unsigned char* lds, const bf16_t* A, const bf16_t* Bt, int M, int N, int K, const Epi& E, int rot, int ld = 0, int msplit = 0, int gsub = 0, int csub = 0) {
    Gemm g; g.A = A; g.Bt = Bt; g.M = M; g.N = N; g.K = K; g.ld = ld ? ld : K; g.msplit = msplit;
    StaticOrder S; const int G = gridDim.x; if (gsub) S.init(M, N, gsub, csub); else S.init(M, N, G, (int)((blockIdx.x + rot) % G));
    gemm_phase<Epi, StaticOrder, false>(lds, g, S, E, nullptr);
    __syncthreads();
}

__device__ __forceinline__ void phase_prep(const Args& a, int l) {
    const int lane = threadIdx.x & 63, gw = blockIdx.x * 8 + (threadIdx.x >> 6), nw = gridDim.x * 8;
    const bf16_t* P = (const bf16_t*)(a.ws + WS_P); const f32x2* tab = (const f32x2*)(a.ws + WS_TAB);
    float* QR = (float*)(a.ws + WS_QR);
    bf16_t* CQN = (bf16_t*)(a.ws + WS_CQN); bf16_t* CKVN = (bf16_t*)(a.ws + WS_CKVN); bf16_t* KB = (bf16_t*)(a.ws + WS_KB);
    const float* qn = a.in[19] + l * 512; const float* kvn = a.in[21] + l * 256;
    const int i = lane & 31;
    for (int row0 = gw; row0 < MR; row0 += 2 * nw) {
        float q1[2][3], q2[2][3], k1[2], k2[2], cs[2], sn[2]; f32x4 cq0[2], cq1[2], ckv[2]; int rw[2]; bool ok[2];
#pragma unroll
        for (int s2 = 0; s2 < 2; ++s2) { const int r = row0 + s2 * nw; ok[s2] = r < MR; rw[s2] = ok[s2] ? r : row0;
            const int row = rw[s2]; const bool latent = row < MLAT; const int t = latent ? (row & 2047) : 0;
            const bf16_t* pr = P + (size_t)row * INWP;
            const f32x2 cv = tab[t * 32 + i]; cs[s2] = latent ? cv.x : 1.f; sn[s2] = latent ? cv.y : 0.f;
#pragma unroll
            for (int j = 0; j < 3; ++j) { const int hh = (lane >> 5) + 2 * j; q1[s2][j] = bf2f(pr[OFF_RQ + hh * 64 + i]); q2[s2][j] = bf2f(pr[OFF_RQ + hh * 64 + 32 + i]); }
            cq0[s2] = ld_bf4(pr + OFF_CQ + lane * 4); cq1[s2] = ld_bf4(pr + OFF_CQ + 256 + lane * 4); ckv[s2] = ld_bf4(pr + OFF_CKV + lane * 4);
            k1[s2] = bf2f(pr[OFF_KR + i]); k2[s2] = bf2f(pr[OFF_KR + 32 + i]); }
#pragma unroll
        for (int s2 = 0; s2 < 2; ++s2) { if (!ok[s2]) continue;
            const int row = rw[s2]; const bool latent = row < MLAT;
            const int b = latent ? (row >> 11) : ((row - MLAT) >> 8), t = latent ? (row & 2047) : ((row - MLAT) & 255), ki = latent ? 256 + t : t;
#pragma unroll
            for (int j = 0; j < 3; ++j) { const int hh = (lane >> 5) + 2 * j;
                QR[(size_t)row * 384 + hh * 64 + i] = q1[s2][j] * cs[s2] - q2[s2][j] * sn[s2]; QR[(size_t)row * 384 + hh * 64 + 32 + i] = q1[s2][j] * sn[s2] + q2[s2][j] * cs[s2]; }
            { f32x4 v0 = cq0[s2], v1 = cq1[s2];
              float ss = (v0[0] * v0[0] + v0[1] * v0[1]) + (v0[2] * v0[2] + v0[3] * v0[3]) + (v1[0] * v1[0] + v1[1] * v1[1]) + (v1[2] * v1[2] + v1[3] * v1[3]);
              ss = wave_sum(ss); const float r = rsqrtf(ss * (1.f / 512.f) + EPS);
              const f32x4 g0 = *(const f32x4*)(qn + lane * 4), g1 = *(const f32x4*)(qn + 256 + lane * 4);
              v0 = v0 * r * g0; v1 = v1 * r * g1;
              u32x2 w; w.x = cvt_pk_bf16(v0[0], v0[1]); w.y = cvt_pk_bf16(v0[2], v0[3]); *(u32x2*)(CQN + (size_t)row * 512 + lane * 4) = w;
              w.x = cvt_pk_bf16(v1[0], v1[1]); w.y = cvt_pk_bf16(v1[2], v1[3]); *(u32x2*)(CQN + (size_t)row * 512 + 256 + lane * 4) = w; }
            { f32x4 v0 = ckv[s2];
              float ss = (v0[0] * v0[0] + v0[1] * v0[1]) + (v0[2] * v0[2] + v0[3] * v0[3]);
              ss = wave_sum(ss); const float r = rsqrtf(ss * (1.f / 256.f) + EPS);
              const f32x4 g0 = *(const f32x4*)(kvn + lane * 4);
              v0 = v0 * r * g0;
              u32x2 w; w.x = cvt_pk_bf16(v0[0], v0[1]); w.y = cvt_pk_bf16(v0[2], v0[3]); *(u32x2*)(CKVN + (size_t)row * 256 + lane * 4) = w; }
            { const bf16_t o1 = f2bf(k1[s2] * cs[s2] - k2[s2] * sn[s2]), o2 = f2bf(k1[s2] * sn[s2] + k2[s2] * cs[s2]);
              const int h0 = (lane >> 5) * 3;
#pragma unroll
              for (int hh = 0; hh < 3; ++hh) { bf16_t* kp = KB + ((size_t)(b * 6 + h0 + hh) * NKEY + ki) * 192; kp[128 + i] = o1; kp[160 + i] = o2; } } }
    }
}

__device__ __forceinline__ void phase_conv(const Args& a, int l, LAS unsigned char* lds) {
    const int tid = threadIdx.x, lane = tid & 63, wid = tid >> 6;
    const bf16_t* PG = (const bf16_t*)(a.ws + WS_PG); bf16_t* CVN = (bf16_t*)(a.ws + WS_CVN);
    LAS float* red = (LAS float*)lds;
    LAS float* fin = (LAS float*)(lds + 1024);
    float dwc[31];
#pragma unroll
    for (int w = 0; w < 31; ++w) dwc[w] = a.in[14][(size_t)(l * 31 + w) * 512 + tid];
    const float bias = a.in[15][l * 512 + tid], lg = a.in[16][l * 512 + tid], lb = a.in[17][l * 512 + tid];
    for (int it = gridDim.x - 1 - blockIdx.x; it < MR / 16; it += gridDim.x) {
        const int row0 = it * 16;
        int s0, s1; if (row0 < MLAT) { s0 = (row0 >> 11) << 11; s1 = s0 + 2048; } else { s0 = MLAT + (((row0 - MLAT) >> 8) << 8); s1 = s0 + 256; }
        float acc[16], rv[32];
#pragma unroll
        for (int j = 0; j < 16; ++j) acc[j] = bias;
#pragma unroll
        for (int i = 0; i < 46; ++i) { const int r = row0 - 15 + i; const bool ok = (r >= s0 && r < s1); const int rc = ok ? r : row0;
            const float av = bf2f(PG[(size_t)rc * GLUW + tid]), gv = bf2f(PG[(size_t)rc * GLUW + 512 + tid]);
            const float u = ok ? av * sigmf(gv) : 0.f;
#pragma unroll
            for (int j = 0; j < 16; ++j) { const int w = i - j; if (w >= 0 && w <= 30) acc[j] += u * dwc[w]; } }
#pragma unroll
        for (int j = 0; j < 16; ++j) { rv[2 * j] = acc[j]; rv[2 * j + 1] = acc[j] * acc[j]; }
#pragma unroll
        for (int k = 0; k < 16; ++k) { const bool up = (lane & 32) != 0; const float keep = up ? rv[k + 16] : rv[k], send = up ? rv[k] : rv[k + 16]; rv[k] = keep + __shfl_xor(send, 32); }
#pragma unroll
        for (int k = 0; k < 8; ++k) { const bool up = (lane & 16) != 0; const float keep = up ? rv[k + 8] : rv[k], send = up ? rv[k] : rv[k + 8]; rv[k] = keep + __shfl_xor(send, 16); }
#pragma unroll
        for (int k = 0; k < 4; ++k) { const bool up = (lane & 8) != 0; const float keep = up ? rv[k + 4] : rv[k], send = up ? rv[k] : rv[k + 4]; rv[k] = keep + __shfl_xor(send, 8); }
#pragma unroll
        for (int k = 0; k < 2; ++k) { const bool up = (lane & 4) != 0; const float keep = up ? rv[k + 2] : rv[k], send = up ? rv[k] : rv[k + 2]; rv[k] = keep + __shfl_xor(send, 4); }
        { const bool up = (lane & 2) != 0; const float keep = up ? rv[1] : rv[0], send = up ? rv[0] : rv[1]; rv[0] = keep + __shfl_xor(send, 2); }
        rv[0] += __shfl_xor(rv[0], 1);
        if ((lane & 1) == 0) red[wid * 32 + (lane >> 1)] = rv[0];
        __syncthreads();
        if (tid < 32) { float s = 0.f;
#pragma unroll
            for (int w = 0; w < 8; ++w) s += red[w * 32 + tid];
            fin[tid] = s; }
        __syncthreads();
#pragma unroll
        for (int j = 0; j < 16; ++j) { const float mean = fin[2 * j] * (1.f / 512.f), var = fin[2 * j + 1] * (1.f / 512.f) - mean * mean;
            const float y = (acc[j] - mean) * rsqrtf(fmaxf(var, 0.f) + EPS) * lg + lb;
            CVN[(size_t)(row0 + j) * 512 + tid] = f2bf(siluf(y)); }
        __syncthreads();
    }
}

__device__ __forceinline__ void phase_ret_local(const Args& a, LAS unsigned char* lds) {
    const int tid = threadIdx.x;
    const bf16_t* P = (const bf16_t*)(a.ws + WS_P); const f32x2* tab = (const f32x2*)(a.ws + WS_TAB);
    float* SF = (float*)(a.ws + WS_SF); float* SB = (float*)(a.ws + WS_SB);
    LAS float* kl = (LAS float*)lds;
    LAS float* vl = kl + 128 * 64;
    LAS float* wl = vl + 128 * 128;
    for (int it = blockIdx.x; it < 24 * NCH; it += gridDim.x) {
        const int cidx = it % NCH, bh = it / NCH, b = bh / 6, h = bh % 6;
        const bool latent = cidx >= 2;
        const int rowbase = latent ? b * 2048 + (cidx - 2) * 128 : MLAT + b * 256 + cidx * 128, t0 = latent ? (cidx - 2) * 128 : 0;
        const float l2g = log2f(1.f - exp2f(-5.f - (float)h));
#pragma unroll
        for (int j = 0; j < 8; ++j) { const int idx = tid + 512 * j, t = idx >> 5, i = idx & 31;
            const float x1 = bf2f(P[(size_t)(rowbase + t) * INWP + OFF_RK + h * 64 + i]), x2 = bf2f(P[(size_t)(rowbase + t) * INWP + OFF_RK + h * 64 + 32 + i]);
            float cs, sn; rope_cs(tab, i, t0 + t, latent, cs, sn);
            kl[t * 64 + i] = (x1 * cs - x2 * sn) * 0.125f; kl[t * 64 + 32 + i] = (x1 * sn + x2 * cs) * 0.125f; }
#pragma unroll
        for (int ii = 0; ii < 8; ++ii) { const int idx = tid + 512 * ii, j = idx >> 5, c4 = idx & 31;
            *(LAS f32x4*)(vl + j * 128 + c4 * 4) = ld_bf4(P + (size_t)(rowbase + j) * INWP + OFF_RV + h * 128 + c4 * 4); }
        if (tid < 256) { const int t = tid & 127; wl[tid] = exp2f(l2g * (float)(tid < 128 ? 127 - t : t)); }
        __syncthreads();
        { const int lane = tid & 63, wid = tid >> 6, fr = lane & 15, fq = lane >> 4;
          f32x4 accF[4], accB[4];
#pragma unroll
          for (int db = 0; db < 4; ++db) { accF[db] = (f32x4){0.f, 0.f, 0.f, 0.f}; accB[db] = (f32x4){0.f, 0.f, 0.f, 0.f}; }
#pragma unroll
          for (int ks = 0; ks < 4; ++ks) { const int t0q = ks * 32 + fq * 8; float vv[8], wfv[8], wbv[8];
#pragma unroll
              for (int j = 0; j < 8; ++j) { vv[j] = vl[(t0q + j) * 128 + wid * 16 + fr]; wfv[j] = wl[t0q + j]; wbv[j] = wl[128 + t0q + j]; }
              u32x4 w; w.x = cvt_pk_bf16(vv[0], vv[1]); w.y = cvt_pk_bf16(vv[2], vv[3]); w.z = cvt_pk_bf16(vv[4], vv[5]); w.w = cvt_pk_bf16(vv[6], vv[7]);
              const bf16x8 vb = __builtin_bit_cast(bf16x8, w);
#pragma unroll
              for (int db = 0; db < 4; ++db) { float kk[8];
#pragma unroll
                  for (int j = 0; j < 8; ++j) kk[j] = kl[(t0q + j) * 64 + db * 16 + fr];
                  w.x = cvt_pk_bf16(kk[0] * wfv[0], kk[1] * wfv[1]); w.y = cvt_pk_bf16(kk[2] * wfv[2], kk[3] * wfv[3]); w.z = cvt_pk_bf16(kk[4] * wfv[4], kk[5] * wfv[5]); w.w = cvt_pk_bf16(kk[6] * wfv[6], kk[7] * wfv[7]);
                  accF[db] = __builtin_amdgcn_mfma_f32_16x16x32_bf16(__builtin_bit_cast(bf16x8, w), vb, accF[db], 0, 0, 0);
                  w.x = cvt_pk_bf16(kk[0] * wbv[0], kk[1] * wbv[1]); w.y = cvt_pk_bf16(kk[2] * wbv[2], kk[3] * wbv[3]); w.z = cvt_pk_bf16(kk[4] * wbv[4], kk[5] * wbv[5]); w.w = cvt_pk_bf16(kk[6] * wbv[6], kk[7] * wbv[7]);
                  accB[db] = __builtin_amdgcn_mfma_f32_16x16x32_bf16(__builtin_bit_cast(bf16x8, w), vb, accB[db], 0, 0, 0); } }
          float* fo = SF + ((size_t)bh * NCH + cidx) * 8192 + (wid * 16 + fr) * 64 + fq * 4; float* go = SB + ((size_t)bh * NCH + cidx) * 8192 + (wid * 16 + fr) * 64 + fq * 4;
#pragma unroll
          for (int db = 0; db < 4; ++db) { *(f32x4*)(fo + db * 16) = accF[db]; *(f32x4*)(go + db * 16) = accB[db]; } }
        { bf16_t* rk = (bf16_t*)(a.ws + WS_RKB) + ((size_t)bh * NCH + cidx) * 8192; const int tok = tid >> 2, d0 = (tid & 3) * 16;
#pragma unroll
          for (int hq = 0; hq < 2; ++hq) { const f32x4 x0 = *(const LAS f32x4*)(kl + tok * 64 + d0 + hq * 8), x1 = *(const LAS f32x4*)(kl + tok * 64 + d0 + hq * 8 + 4);
              u32x4 w; w.x = cvt_pk_bf16(x0[0], x0[1]); w.y = cvt_pk_bf16(x0[2], x0[3]); w.z = cvt_pk_bf16(x1[0], x1[1]); w.w = cvt_pk_bf16(x1[2], x1[3]);
              *(u32x4*)(rk + tok * 64 + d0 + hq * 8) = w; } }
        { bf16_t* rv = (bf16_t*)(a.ws + WS_RVT) + ((size_t)bh * NCH + cidx) * 16384; const int dv = tid & 127, tg = tid >> 7;
#pragma unroll
          for (int i = 0; i < 4; ++i) { const int t0q = tg * 32 + i * 8; float x[8];
#pragma unroll
              for (int j = 0; j < 8; ++j) x[j] = vl[(t0q + j) * 128 + dv];
              u32x4 w; w.x = cvt_pk_bf16(x[0], x[1]); w.y = cvt_pk_bf16(x[2], x[3]); w.z = cvt_pk_bf16(x[4], x[5]); w.w = cvt_pk_bf16(x[6], x[7]);
              *(u32x4*)(rv + dv * 128 + t0q) = w; } }
        __syncthreads();
    }
}
__device__ __forceinline__ void phase_ret_combine(const Args& a) {
    for (int e = blockIdx.x * NTHR + threadIdx.x; e < 24 * 2 * 2048; e += gridDim.x * NTHR) {
        const int q = e & 2047, bhd = e >> 11, dir = bhd & 1, bh = bhd >> 1, h = bh % 6;
        const float gC = exp2f(128.f * log2f(1.f - exp2f(-5.f - (float)h)));
        float* base = (float*)(a.ws + (dir ? WS_SB : WS_SF)) + (size_t)bh * NCH * 8192 + q * 4;
        f32x4 F[NCH];
#pragma unroll
        for (int c = 0; c < NCH; ++c) F[c] = *(const f32x4*)(base + (size_t)c * 8192);
        f32x4 S = {0.f, 0.f, 0.f, 0.f};
        if (dir == 0) {
#pragma unroll
            for (int c = 0; c < NCH; ++c) { *(f32x4*)(base + (size_t)c * 8192) = S; S = S * gC + F[c]; }
        } else {
#pragma unroll
            for (int st = 0; st < NCH; ++st) { const int c = st < 2 ? 1 - st : 19 - st; *(f32x4*)(base + (size_t)c * 8192) = S; S = S * gC + F[c]; }
        }
    }
}

constexpr int RK_STRIDE = 144, RV_STRIDE = 272;
__device__ __forceinline__ void phase_ret_out(const Args& a, int l, LAS unsigned char* lds) {
    const int tid = threadIdx.x, lane = tid & 63, wid = tid >> 6, fr = lane & 15, fq = lane >> 4;
    const bf16_t* P = (const bf16_t*)(a.ws + WS_P); const float* QR = (const float*)(a.ws + WS_QR);
    const float* SF = (const float*)(a.ws + WS_SF); const float* SB = (const float*)(a.ws + WS_SB); bf16_t* CAT = (bf16_t*)(a.ws + WS_CAT);
    LAS unsigned char* Kb = lds;
    LAS unsigned char* Vt = Kb + 128 * RK_STRIDE;
    LAS unsigned char* St = Vt + 128 * RV_STRIDE;
    const int nch = (l == 0) ? 18 : 16, nitem = 24 * nch;
    for (int it = blockIdx.x; it < nitem; it += gridDim.x) {
        const int c = it % nch, bh = it / nch, cidx = c + (18 - nch), b = bh / 6, h = bh % 6;
        const int rowbase = cidx < 2 ? MLAT + b * 256 + cidx * 128 : b * 2048 + (cidx - 2) * 128;
        const float l2g = log2f(1.f - exp2f(-5.f - (float)h));
        { const bf16_t* rk = (const bf16_t*)(a.ws + WS_RKB) + ((size_t)bh * NCH + cidx) * 8192;
          const bf16_t* rv = (const bf16_t*)(a.ws + WS_RVT) + ((size_t)bh * NCH + cidx) * 16384;
          const float* sf = SF + ((size_t)bh * NCH + cidx) * 8192; const float* sb = SB + ((size_t)bh * NCH + cidx) * 8192;
#pragma unroll
          for (int i = 0; i < 2; ++i) { const int idx = tid + 512 * i, r = idx >> 3, cc = idx & 7; *(LAS u32x4*)(Kb + r * RK_STRIDE + cc * 16) = *(const u32x4*)(rk + r * 64 + cc * 8); }
#pragma unroll
          for (int i = 0; i < 4; ++i) { const int idx = tid + 512 * i, r = idx >> 4, cc = idx & 15; *(LAS u32x4*)(Vt + r * RV_STRIDE + cc * 16) = *(const u32x4*)(rv + r * 128 + cc * 8); }
#pragma unroll
          for (int i = 0; i < 4; ++i) { const int idx = tid + 512 * i, r = idx >> 4, c4 = idx & 15;
              const f32x4 f4 = *(const f32x4*)(sf + r * 64 + c4 * 4), b4 = *(const f32x4*)(sb + r * 64 + c4 * 4);
              u32x2 w; w.x = cvt_pk_bf16(f4[0], f4[1]); w.y = cvt_pk_bf16(f4[2], f4[3]); *(LAS u32x2*)(St + r * RV_STRIDE + c4 * 8) = w;
              w.x = cvt_pk_bf16(b4[0], b4[1]); w.y = cvt_pk_bf16(b4[2], b4[3]); *(LAS u32x2*)(St + r * RV_STRIDE + 128 + c4 * 8) = w; } }
        const int il = wid * 16 + fr, row = rowbase + il;
        f32x4 qv[2][2];
#pragma unroll
        for (int ks = 0; ks < 2; ++ks) { qv[ks][0] = *(const f32x4*)(QR + (size_t)row * 384 + h * 64 + ks * 32 + fq * 8); qv[ks][1] = *(const f32x4*)(QR + (size_t)row * 384 + h * 64 + ks * 32 + fq * 8 + 4); }
        const float wf = exp2f(l2g * (float)(il + 1)), wb = exp2f(l2g * (float)(128 - il));
        bf16x8 qb[2], qw[4];
#pragma unroll
        for (int ks = 0; ks < 2; ++ks) { const f32x4 x0 = qv[ks][0], x1 = qv[ks][1]; u32x4 w;
            w.x = cvt_pk_bf16(x0[0], x0[1]); w.y = cvt_pk_bf16(x0[2], x0[3]); w.z = cvt_pk_bf16(x1[0], x1[1]); w.w = cvt_pk_bf16(x1[2], x1[3]); qb[ks] = __builtin_bit_cast(bf16x8, w);
            const f32x4 y0 = x0 * wf, y1 = x1 * wf, z0 = x0 * wb, z1 = x1 * wb;
            w.x = cvt_pk_bf16(y0[0], y0[1]); w.y = cvt_pk_bf16(y0[2], y0[3]); w.z = cvt_pk_bf16(y1[0], y1[1]); w.w = cvt_pk_bf16(y1[2], y1[3]); qw[ks] = __builtin_bit_cast(bf16x8, w);
            w.x = cvt_pk_bf16(z0[0], z0[1]); w.y = cvt_pk_bf16(z0[2], z0[3]); w.z = cvt_pk_bf16(z1[0], z1[1]); w.w = cvt_pk_bf16(z1[2], z1[3]); qw[2 + ks] = __builtin_bit_cast(bf16x8, w); }
        __syncthreads();
        bf16x8 pf[4];
#pragma unroll
        for (int p = 0; p < 4; ++p) { f32x4 s0 = {0.f, 0.f, 0.f, 0.f}, s1 = {0.f, 0.f, 0.f, 0.f};
            const int kr0 = p * 32 + (fr >> 2) * 8 + (fr & 3);
#pragma unroll
            for (int ks = 0; ks < 2; ++ks) { const bf16x8 k0 = *(const LAS bf16x8*)(Kb + kr0 * RK_STRIDE + ks * 64 + fq * 16), k1 = *(const LAS bf16x8*)(Kb + (kr0 + 4) * RK_STRIDE + ks * 64 + fq * 16);
                s0 = __builtin_amdgcn_mfma_f32_16x16x32_bf16(k0, qb[ks], s0, 0, 0, 0); s1 = __builtin_amdgcn_mfma_f32_16x16x32_bf16(k1, qb[ks], s1, 0, 0, 0); }
#pragma unroll
            for (int j = 0; j < 4; ++j) { const int k0i = p * 32 + fq * 8 + j, k1i = k0i + 4; const int d0 = il > k0i ? il - k0i : k0i - il, d1 = il > k1i ? il - k1i : k1i - il;
                s0[j] *= exp2f(l2g * (float)d0); s1[j] *= exp2f(l2g * (float)d1); }
            u32x4 w; w.x = cvt_pk_bf16(s0[0], s0[1]); w.y = cvt_pk_bf16(s0[2], s0[3]); w.z = cvt_pk_bf16(s1[0], s1[1]); w.w = cvt_pk_bf16(s1[2], s1[3]); pf[p] = __builtin_bit_cast(bf16x8, w); }
        f32x4 o[8];
#pragma unroll
        for (int db = 0; db < 8; ++db) o[db] = (f32x4){0.f, 0.f, 0.f, 0.f};
#pragma unroll
        for (int p = 0; p < 4; ++p)
#pragma unroll
            for (int db = 0; db < 8; ++db) { const bf16x8 vf = *(const LAS bf16x8*)(Vt + (db * 16 + fr) * RV_STRIDE + p * 64 + fq * 16), sfr = *(const LAS bf16x8*)(St + (db * 16 + fr) * RV_STRIDE + p * 64 + fq * 16);
                o[db] = __builtin_amdgcn_mfma_f32_16x16x32_bf16(vf, pf[p], o[db], 0, 0, 0);
                o[db] = __builtin_amdgcn_mfma_f32_16x16x32_bf16(sfr, qw[p], o[db], 0, 0, 0); }
        float sm = 0.f;
#pragma unroll
        for (int db = 0; db < 8; ++db) sm += (o[db][0] + o[db][1]) + (o[db][2] + o[db][3]);
        sm += __shfl_xor(sm, 16); sm += __shfl_xor(sm, 32);
        const float mu = sm * (1.f / 128.f); float qd = 0.f;
#pragma unroll
        for (int db = 0; db < 8; ++db) { o[db] = o[db] - mu; qd += (o[db][0] * o[db][0] + o[db][1] * o[db][1]) + (o[db][2] * o[db][2] + o[db][3] * o[db][3]); }
        qd += __shfl_xor(qd, 16); qd += __shfl_xor(qd, 32);
        const float rstd = rsqrtf(qd * (1.f / 128.f) + EPS);
#pragma unroll
        for (int db = 0; db < 8; ++db) { const int cc = h * 128 + db * 16 + fq * 4;
            const f32x4 rg = ld_bf4(P + (size_t)row * INWP + OFF_RG + cc), gn4 = *(const f32x4*)(a.in[13] + l * 768 + cc); float v[4];
#pragma unroll
            for (int e = 0; e < 4; ++e) v[e] = siluf(rg[e]) * (o[db][e] * rstd * gn4[e]);
            u32x2 w; w.x = cvt_pk_bf16(v[0], v[1]); w.y = cvt_pk_bf16(v[2], v[3]);
            *(u32x2*)(CAT + (size_t)row * D + cc) = w; }
        __syncthreads();
    }
}

__device__ __forceinline__ void phase_post(const Args& a) {
    const int lane = threadIdx.x & 63, gw = blockIdx.x * 8 + (threadIdx.x >> 6), nw = gridDim.x * 8;
    const bf16_t* QF = (const bf16_t*)(a.ws + WS_QF); const bf16_t* KVF = (const bf16_t*)(a.ws + WS_KVF);
    bf16_t* QB = (bf16_t*)(a.ws + WS_QB); bf16_t* KB = (bf16_t*)(a.ws + WS_KB); bf16_t* VT = (bf16_t*)(a.ws + WS_VT);
    const float qscale = 0.07216878364870322f * 1.4426950408889634f;
    for (int wi = gw; wi < MR / 8; wi += nw) {
        const int r0 = wi * 8; const bool latent = r0 < MLAT;
        const int b = latent ? (r0 >> 11) : ((r0 - MLAT) >> 8), t0 = latent ? (r0 & 2047) : ((r0 - MLAT) & 255), ki0 = latent ? 256 + t0 : t0;
        const int i = lane & 31; const f32x2* tab = (const f32x2*)(a.ws + WS_TAB);
        for (int r4 = 0; r4 < 8; r4 += 4) {
            u32x2 qraw[4][3], kraw[4][3]; float x1[4][3], x2[4][3], cs[4], sn[4];
#pragma unroll
            for (int rr = 0; rr < 4; ++rr) { const int row = r0 + r4 + rr, t = t0 + r4 + rr;
                const f32x2 cv = tab[(latent ? t : 0) * 32 + i]; cs[rr] = latent ? cv.x : 1.f; sn[rr] = latent ? cv.y : 0.f;
#pragma unroll
                for (int ii = 0; ii < 3; ++ii) { const int idx = lane * 4 + ii * 256, hh = idx >> 7, dd = idx & 127;
                    qraw[rr][ii] = *(const u32x2*)(QF + (size_t)row * 1280 + hh * 192 + dd); kraw[rr][ii] = *(const u32x2*)(KVF + (size_t)row * 1536 + hh * 256 + dd); }
#pragma unroll
                for (int j = 0; j < 3; ++j) { const int hh = (lane >> 5) + 2 * j; x1[rr][j] = bf2f(QF[(size_t)row * 1280 + hh * 192 + 128 + i]); x2[rr][j] = bf2f(QF[(size_t)row * 1280 + hh * 192 + 160 + i]); } }
#pragma unroll
            for (int rr = 0; rr < 4; ++rr) { const int ki = ki0 + r4 + rr;
#pragma unroll
                for (int ii = 0; ii < 3; ++ii) { const int idx = lane * 4 + ii * 256, hh = idx >> 7, dd = idx & 127;
                    const u32x2 qw = qraw[rr][ii];
                    const f32x4 q4 = (f32x4){__uint_as_float(qw.x << 16), __uint_as_float(qw.x & 0xffff0000u), __uint_as_float(qw.y << 16), __uint_as_float(qw.y & 0xffff0000u)} * qscale;
                    u32x2 w; w.x = cvt_pk_bf16(q4[0], q4[1]); w.y = cvt_pk_bf16(q4[2], q4[3]);
                    *(u32x2*)(QB + ((size_t)(b * 6 + hh) * NKEY + ki) * 192 + dd) = w;
                    *(u32x2*)(KB + ((size_t)(b * 6 + hh) * NKEY + ki) * 192 + dd) = kraw[rr][ii]; }
#pragma unroll
                for (int j = 0; j < 3; ++j) { const int hh = (lane >> 5) + 2 * j;
                    bf16_t* qp = QB + ((size_t)(b * 6 + hh) * NKEY + ki) * 192;
                    qp[128 + i] = f2bf((x1[rr][j] * cs[rr] - x2[rr][j] * sn[rr]) * qscale); qp[160 + i] = f2bf((x1[rr][j] * sn[rr] + x2[rr][j] * cs[rr]) * qscale); } } }
#pragma unroll 4
        for (int ii = 0; ii < 12; ++ii) { const int hd = lane + 64 * ii, hh = hd >> 7, dv = hd & 127; bf16_t v[8];
#pragma unroll
            for (int rr = 0; rr < 8; ++rr) v[rr] = KVF[(size_t)(r0 + rr) * 1536 + hh * 256 + 128 + dv];
            u32x4 w; w.x = (unsigned)v[0] | ((unsigned)v[1] << 16); w.y = (unsigned)v[2] | ((unsigned)v[3] << 16); w.z = (unsigned)v[4] | ((unsigned)v[5] << 16); w.w = (unsigned)v[6] | ((unsigned)v[7] << 16);
            *(u32x4*)(VT + (((size_t)(b * 6 + hh) * 36 + (ki0 >> 6)) * 128 + dv) * 64 + (ki0 & 63)) = w; }
    }
}

constexpr int KS_STRIDE = 400, VS_STRIDE = 144, KS_BYTES = 64 * KS_STRIDE, VS_BYTES = 128 * VS_STRIDE, ATT_BUF = KS_BYTES + VS_BYTES;
__device__ __forceinline__ void phase_attn(const Args& a, int l, LAS unsigned char* lds) {
    const int tid = threadIdx.x, lane = tid & 63, wid = tid >> 6, fr = lane & 15, fq = lane >> 4;
    const bf16_t* QB = (const bf16_t*)(a.ws + WS_QB); const bf16_t* KB = (const bf16_t*)(a.ws + WS_KB); const bf16_t* VT = (const bf16_t*)(a.ws + WS_VT);
    bf16_t* CAT = (bf16_t*)(a.ws + WS_CAT);
    LAS unsigned char* kring = lds; LAS unsigned char* vring = lds + 2 * KS_BYTES;
    const int nqt = (l == 0) ? 9 : 8, nitem = 24 * nqt;
    for (int it = blockIdx.x; it < nitem; it += gridDim.x) {
        const int bh = it % 24, qi = it / 24, qt = (l == 0) ? (qi == 8 ? 0 : qi + 1) : qi + 1, b = bh / 6, h = bh % 6;
        const int nk = (qt == 0) ? 256 : NKEY, ntile = nk / 64;
        const bf16_t* kbase = KB + (size_t)bh * NKEY * 192; const bf16_t* vbase = VT + (size_t)bh * 128 * NKEY; const bf16_t* qbase = QB + (size_t)bh * NKEY * 192;
        const int q0 = qt * 256 + wid * 32;
        bf16x8 qf[2][6];
#pragma unroll
        for (int g = 0; g < 2; ++g)
#pragma unroll
            for (int ks = 0; ks < 6; ++ks) qf[g][ks] = *(const bf16x8*)(qbase + (size_t)(q0 + g * 16 + fr) * 192 + ks * 32 + fq * 8);
        f32x4 o[8][2];
#pragma unroll
        for (int db = 0; db < 8; ++db) { o[db][0] = (f32x4){0.f, 0.f, 0.f, 0.f}; o[db][1] = (f32x4){0.f, 0.f, 0.f, 0.f}; }
        float mrun[2] = {-1e30f, -1e30f}, lrun[2] = {0.f, 0.f};
        u32x4 kst[3], vst[2];
#define AT_KLOAD(tile) do { const bf16_t* kp_ = kbase + (size_t)(tile) * (64 * 192) + tid * 8; _Pragma("unroll") for (int i = 0; i < 3; ++i) kst[i] = *(const u32x4*)(kp_ + i * 4096); } while (0)
#define AT_VLOAD(tile) do { const bf16_t* vp_ = vbase + (size_t)(tile) * (128 * 64) + tid * 8; _Pragma("unroll") for (int i = 0; i < 2; ++i) vst[i] = *(const u32x4*)(vp_ + i * 4096); } while (0)
#define AT_KSTORE(buf) do { LAS unsigned char* kb_ = kring + (buf) * KS_BYTES; _Pragma("unroll") for (int i = 0; i < 3; ++i) { const int c = tid + 512 * i, r = c / 24, cc = c % 24; *(LAS u32x4*)(kb_ + r * KS_STRIDE + cc * 16) = kst[i]; } } while (0)
#define AT_VSTORE(buf) do { LAS unsigned char* vb_ = vring + (buf) * VS_BYTES; _Pragma("unroll") for (int i = 0; i < 2; ++i) { const int c = tid + 512 * i, r = c >> 3, cc = c & 7; *(LAS u32x4*)(vb_ + r * VS_STRIDE + cc * 16) = vst[i]; } } while (0)
#define AT_QK(sx, buf) do { LAS unsigned char* kb_ = kring + (buf) * KS_BYTES; __builtin_amdgcn_s_setprio(1); \
            _Pragma("unroll") for (int kbk = 0; kbk < 4; ++kbk) { sx[kbk][0] = (f32x4){0.f, 0.f, 0.f, 0.f}; sx[kbk][1] = (f32x4){0.f, 0.f, 0.f, 0.f}; \
                const int krow = (kbk >> 1) * 32 + (fr >> 2) * 8 + (kbk & 1) * 4 + (fr & 3); \
                _Pragma("unroll") for (int ks = 0; ks < 6; ++ks) { const bf16x8 kf = *(const LAS bf16x8*)(kb_ + krow * KS_STRIDE + ks * 64 + fq * 16); \
                    sx[kbk][0] = __builtin_amdgcn_mfma_f32_16x16x32_bf16(kf, qf[0][ks], sx[kbk][0], 0, 0, 0); \
                    sx[kbk][1] = __builtin_amdgcn_mfma_f32_16x16x32_bf16(kf, qf[1][ks], sx[kbk][1], 0, 0, 0); } } __builtin_amdgcn_s_setprio(0); } while (0)
#define AT_SMPV(sx, buf) do { LAS unsigned char* vb_ = vring + (buf) * VS_BYTES; bf16x8 pf[2][2]; \
            _Pragma("unroll") for (int g = 0; g < 2; ++g) { \
                float mx = sx[0][g][0]; \
                _Pragma("unroll") for (int kbk = 0; kbk < 4; ++kbk) _Pragma("unroll") for (int j = 0; j < 4; ++j) mx = fmaxf(mx, sx[kbk][g][j]); \
                mx = fmaxf(mx, __shfl_xor(mx, 16)); mx = fmaxf(mx, __shfl_xor(mx, 32)); \
                const float mnew = fmaxf(mrun[g], mx), alpha = __builtin_amdgcn_exp2f(mrun[g] - mnew); mrun[g] = mnew; \
                float ps = 0.f; \
                _Pragma("unroll") for (int kbk = 0; kbk < 4; ++kbk) _Pragma("unroll") for (int j = 0; j < 4; ++j) { const float p = __builtin_amdgcn_exp2f(sx[kbk][g][j] - mnew); sx[kbk][g][j] = p; ps += p; } \
                lrun[g] = lrun[g] * alpha + ps; \
                if (__builtin_amdgcn_ballot_w64(alpha != 1.0f) != 0ull) { _Pragma("unroll") for (int db = 0; db < 8; ++db) o[db][g] *= alpha; } \
                _Pragma("unroll") for (int p = 0; p < 2; ++p) { u32x4 w; w.x = cvt_pk_bf16(sx[2 * p][g][0], sx[2 * p][g][1]); w.y = cvt_pk_bf16(sx[2 * p][g][2], sx[2 * p][g][3]); \
                    w.z = cvt_pk_bf16(sx[2 * p + 1][g][0], sx[2 * p + 1][g][1]); w.w = cvt_pk_bf16(sx[2 * p + 1][g][2], sx[2 * p + 1][g][3]); pf[g][p] = __builtin_bit_cast(bf16x8, w); } } \
            __builtin_amdgcn_s_setprio(1); \
            _Pragma("unroll") for (int p = 0; p < 2; ++p) _Pragma("unroll") for (int db = 0; db < 8; ++db) { const bf16x8 vf = *(const LAS bf16x8*)(vb_ + (db * 16 + fr) * VS_STRIDE + p * 64 + fq * 16); \
                o[db][0] = __builtin_amdgcn_mfma_f32_16x16x32_bf16(vf, pf[0][p], o[db][0], 0, 0, 0); \
                o[db][1] = __builtin_amdgcn_mfma_f32_16x16x32_bf16(vf, pf[1][p], o[db][1], 0, 0, 0); } __builtin_amdgcn_s_setprio(0); } while (0)
        AT_KLOAD(0); AT_VLOAD(0); AT_KSTORE(0); AT_VSTORE(0);
        __syncthreads();
        f32x4 sx[4][2];
        int vb_cur = 0, vb_prev = 2;
        for (int tile = 0; tile < ntile; ++tile) {
            const int kb_cur = tile & 1, vb_nxt = (vb_cur == 2) ? 0 : vb_cur + 1;
            if (tile + 1 < ntile) { AT_KLOAD(tile + 1); AT_VLOAD(tile + 1); }
            if (wid < 4) { AT_QK(sx, kb_cur); AT_SMPV(sx, vb_cur); }
            else { if (tile > 0) AT_SMPV(sx, vb_prev); AT_QK(sx, kb_cur); }
            if (tile + 1 < ntile) { AT_KSTORE(kb_cur ^ 1); AT_VSTORE(vb_nxt); }
            __syncthreads();
            vb_prev = vb_cur; vb_cur = vb_nxt;
        }
        if (wid >= 4) AT_SMPV(sx, vb_prev);
        __syncthreads();
#pragma unroll
        for (int g = 0; g < 2; ++g) { float lt = lrun[g]; lt += __shfl_xor(lt, 16); lt += __shfl_xor(lt, 32); const float inv = 1.f / lt;
            const int q = q0 + g * 16 + fr; const int row = q < 256 ? MLAT + b * 256 + q : b * 2048 + (q - 256);
#pragma unroll
            for (int db = 0; db < 8; ++db) { const f32x4 v = o[db][g] * inv; u32x2 w; w.x = cvt_pk_bf16(v[0], v[1]); w.y = cvt_pk_bf16(v[2], v[3]);
                *(u32x2*)(CAT + (size_t)row * D + 1280 + h * 128 + db * 16 + fq * 4) = w; } }
#undef AT_KLOAD
#undef AT_VLOAD
#undef AT_KSTORE
#undef AT_VSTORE
#undef AT_QK
#undef AT_SMPV
    }
}

constexpr int PH_PER_LAYER = 13, NPHASE = 2 + 2 * PH_PER_LAYER;

template <int LP>
__device__ __forceinline__ void layer_phase(const Args& a, const int l, LAS unsigned char* lds) {
    unsigned char* ws = a.ws; const bool last = (l == 1); const int Mlate = last ? MLAT : MR;
    bf16_t* H = (bf16_t*)(ws + WS_H); bf16_t* ACT = (bf16_t*)(ws + WS_P); bf16_t* Y = (bf16_t*)(ws + WS_Y); bf16_t* CAT = (bf16_t*)(ws + WS_CAT);
    if constexpr (LP == 0) { EpiSwiGLU E; E.O = ACT; E.ldc = DFF; run_gemm(lds, H, (const bf16_t*)(ws + WS_WFFIN + (size_t)(l * 2) * SZ_WFFIN), MR, 2 * DFF, D, E, 0); deferred_window(a, l, DW_IDLE2, DW_START2, DW_Q2, lds); }
    if constexpr (LP == 1) { const bf16_t* W = (const bf16_t*)(ws + WS_WFFOUT + (size_t)(l * 2) * SZ_WFFOUT);
        { EpiBf16 E; E.O = Y; E.ldc = D; run_gemm(lds, ACT, W, MLAT, D, DFF, E, 0); }
        { EpiF32 E; E.C = (float*)(ws + WS_YP); E.ldc = D; run_gemm(lds, ACT + (size_t)MLAT * DFF, W, 4 * MCTX, D, DFF / 4, E, 0, DFF, MCTX / 256); } deferred_window(a, l, DW_IDLE3, DW_START3, DW_Q3, lds); }
    if constexpr (LP == 2) phase_resnorm(a, l, 1, 2, 0.5f, true, l, 2, 3, 4, false, MR, lds);
    if constexpr (LP == 3) { EpiBf16 E; E.O = (bf16_t*)(ws + WS_P); E.ldc = INWP; run_gemm(lds, H, (const bf16_t*)(ws + WS_WIN + (size_t)l * SZ_WIN), MR, INWP, D, E, 0); deferred_window(a, l, DW_IDLE5, DW_START5, DW_Q5, lds); }
    if constexpr (LP == 4) { if (a.sub & 1) phase_prep(a, l); if (a.sub & 4) phase_ret_local(a, lds); }
    if constexpr (LP == 5) {
        {
          const int G = gridDim.x, bid = (int)blockIdx.x; const bool part = (G == DEFER_GRID);
          if (!part || bid < 144) { EpiBf16 E; E.O = (bf16_t*)(ws + WS_PG); E.ldc = GLUW; run_gemm(lds, H, (const bf16_t*)(ws + WS_WGLU + (size_t)l * SZ_WGLU), MR, GLUW, D, E, 0, 0, 0, part ? 144 : 0, bid); }
          if (!part || bid >= 144) {
              { EpiBf16 E; E.O = (bf16_t*)(ws + WS_QF); E.ldc = 1280; run_gemm(lds, (const bf16_t*)(ws + WS_CQN), (const bf16_t*)(ws + WS_WUQ + (size_t)l * SZ_WUQ), MR, 1280, 512, E, 0, 0, 0, part ? G - 144 : 0, bid - 144); }
              { EpiBf16 E; E.O = (bf16_t*)(ws + WS_KVF); E.ldc = 1536; run_gemm(lds, (const bf16_t*)(ws + WS_CKVN), (const bf16_t*)(ws + WS_WUKV + (size_t)l * SZ_WUKV), MR, 1536, 256, E, 0, 0, 0, part ? G - 144 : 0, part ? (bid - 144 + 68) % (DEFER_GRID - 144) : 0); } } }
        if (a.sub & 256) phase_ret_combine(a);
    }
    if constexpr (LP == 6) { if (a.sub & 2) phase_conv(a, l, lds); if (a.sub & 8) phase_post(a); if (a.sub & 16) phase_ret_out(a, l, lds); }
    if constexpr (LP == 7) { phase_attn(a, l, lds);
        { const int nitem = 24 * (last ? 8 : 9), G = gridDim.x;
          if ((int)blockIdx.x >= nitem && G > nitem) { EpiBf16 E; E.O = CAT + 768; E.ldc = D; run_gemm(lds, (const bf16_t*)(ws + WS_CVN), (const bf16_t*)(ws + WS_WPW + (size_t)l * SZ_WPW), MR, 512, 512, E, 0, 0, 0, G - nitem, (int)blockIdx.x - nitem); }
          else if (G <= nitem) { EpiBf16 E; E.O = CAT + 768; E.ldc = D; run_gemm(lds, (const bf16_t*)(ws + WS_CVN), (const bf16_t*)(ws + WS_WPW + (size_t)l * SZ_WPW), MR, 512, 512, E, 0); } }
        deferred_window(a, l, DW_IDLE9, DW_START9, DW_Q9, lds); }
    if constexpr (LP == 8) { const bf16_t* W = (const bf16_t*)(ws + WS_WOUT + (size_t)l * SZ_WOUT);
        { EpiBf16 E; E.O = Y; E.ldc = D; run_gemm(lds, CAT, W, MLAT, D, D, E, 0); }
        if (!last) { EpiF32 E; E.C = (float*)(ws + WS_YP); E.ldc = D; run_gemm(lds, CAT + (size_t)MLAT * D, W, 4 * MCTX, D, D / 4, E, 0, D, MCTX / 256); } deferred_window(a, l, DW_IDLE10, DW_START10, DW_Q10, lds); }
    if constexpr (LP == 9) phase_resnorm(a, l, 3, 5, 1.0f, true, l, 4, 6, 7, false, Mlate, lds);
    if constexpr (LP == 10) { EpiSwiGLU E; E.O = ACT; E.ldc = DFF; run_gemm(lds, H, (const bf16_t*)(ws + WS_WFFIN + (size_t)(l * 2 + 1) * SZ_WFFIN), Mlate, 2 * DFF, D, E, 0); deferred_window(a, l, DW_IDLE12, DW_START12, DW_Q12, lds); }
    if constexpr (LP == 11) { const bf16_t* W = (const bf16_t*)(ws + WS_WFFOUT + (size_t)(l * 2 + 1) * SZ_WFFOUT);
        { EpiBf16 E; E.O = Y; E.ldc = D; run_gemm(lds, ACT, W, MLAT, D, DFF, E, 0); }
        if (!last) { EpiF32 E; E.C = (float*)(ws + WS_YP); E.ldc = D; run_gemm(lds, ACT + (size_t)MLAT * DFF, W, 4 * MCTX, D, DFF / 4, E, 0, DFF, MCTX / 256); } deferred_window(a, l, DW_IDLE13, DW_START13, DW_Q13, lds); }
    if constexpr (LP == 12) phase_resnorm(a, l, 5, 8, 0.5f, !last, last ? l : l + 1, 0, 0, 1, last, Mlate, lds);
}

__global__ void __launch_bounds__(NTHR, 2) hybrid_fwd(Args a) {
    extern __shared__ __attribute__((aligned(16))) unsigned char lds_raw[];
    LAS unsigned char* lds = (LAS unsigned char*)lds_raw;
    cg::grid_group grid = cg::this_grid();
    volatile LAS unsigned* xst = (volatile LAS unsigned*)(lds + LDS_BYTES - 16);
    if (threadIdx.x == 0) { xst[0] = 0u; xst[1] = 0u; }
    __syncthreads();
    XcdBarrier xbar = xcd_barrier_post((unsigned*)(a.ws + WS_BAR), xst);
#ifndef REPMASK
#define REPMASK 0ull
#endif
#define RUN_PH(ph, stmt) if (a.ph_lo <= (ph) && (ph) < a.ph_hi) { if ((ph) > a.ph_lo) { if ((ph) == 1) grid.sync(); else xcd_barrier(xbar); } stmt; }
    RUN_PH(0, phase_prologue(a, lds))
    RUN_PH(1, phase_norm0(a, lds))
#define RUN_LAYER(l) \
    RUN_PH(2 + (l) * 13 + 0, layer_phase<0>(a, l, lds)) RUN_PH(2 + (l) * 13 + 1, layer_phase<1>(a, l, lds)) RUN_PH(2 + (l) * 13 + 2, layer_phase<2>(a, l, lds)) \
    RUN_PH(2 + (l) * 13 + 3, layer_phase<3>(a, l, lds)) RUN_PH(2 + (l) * 13 + 4, layer_phase<4>(a, l, lds)) RUN_PH(2 + (l) * 13 + 5, layer_phase<5>(a, l, lds)) \
    RUN_PH(2 + (l) * 13 + 6, layer_phase<6>(a, l, lds)) RUN_PH(2 + (l) * 13 + 7, layer_phase<7>(a, l, lds)) RUN_PH(2 + (l) * 13 + 8, layer_phase<8>(a, l, lds)) \
    RUN_PH(2 + (l) * 13 + 9, layer_phase<9>(a, l, lds)) RUN_PH(2 + (l) * 13 + 10, layer_phase<10>(a, l, lds)) RUN_PH(2 + (l) * 13 + 11, layer_phase<11>(a, l, lds)) \
    RUN_PH(2 + (l) * 13 + 12, layer_phase<12>(a, l, lds))
    RUN_LAYER(0)
    RUN_LAYER(1)
#ifdef EXTRA_SYNCS
    if (a.ph_hi - a.ph_lo > 1) { for (int i = 0; i < EXTRA_SYNCS; ++i) grid.sync(); }
#endif
}

#ifndef ONE_LAUNCH
#define ONE_LAUNCH 0
#endif

extern "C" void kernel_launch(void* const* d_in, const int* in_sizes, int n_in, void* d_out, int out_size, void* d_ws, size_t ws_size, hipStream_t stream) {
    static int grid = 0;
    if (grid == 0) {
        if (n_in != 23 || ws_size < WS_END) { fprintf(stderr, "kernel_launch: need 23 inputs and %zu bytes of workspace; got %d, %zu\n", (size_t)WS_END, n_in, ws_size); grid = -1; return; }
        int dev = 0, cus = 0, per_cu = 0;
        hipGetDevice(&dev); hipDeviceGetAttribute(&cus, hipDeviceAttributeMultiprocessorCount, dev);
        if (hipFuncSetAttribute((const void*)hybrid_fwd, hipFuncAttributeMaxDynamicSharedMemorySize, LDS_BYTES) != hipSuccess) { fprintf(stderr, "kernel_launch: hipFuncSetAttribute failed\n"); grid = -1; return; }
        if (hipOccupancyMaxActiveBlocksPerMultiprocessor(&per_cu, (const void*)hybrid_fwd, NTHR, LDS_BYTES) != hipSuccess || per_cu < 1) { fprintf(stderr, "kernel_launch: occupancy query gave %d\n", per_cu); per_cu = 1; }
        (void)hipGetLastError();
        grid = cus * 1;
        fprintf(stderr, "kernel_launch: grid %d (per_cu %d)\n", grid, per_cu);
    }
    if (grid < 0) return;
    if (hipMemsetAsync((char*)d_ws + WS_BAR, 0, 16384, stream) != hipSuccess) { fprintf(stderr, "kernel_launch: memset failed\n"); return; }
    Args a{};
    for (int i = 0; i < 23; ++i) a.in[i] = (const float*)d_in[i];
    a.out = (float*)d_out; a.ws = (unsigned char*)d_ws; a.sub = ~0ull;
#if ONE_LAUNCH
    a.ph_lo = 0; a.ph_hi = NPHASE;
    { void* args[] = {&a}; hipError_t e = hipLaunchCooperativeKernel((const void*)hybrid_fwd, dim3(grid), dim3(NTHR), args, LDS_BYTES, stream);
      if (e != hipSuccess) fprintf(stderr, "cooperative launch failed: %s\n", hipGetErrorString(e)); }
#ifdef EXTRA_PH
    { const int extra[] = EXTRA_PH; a.sub = EXTRA_SUB; for (int ph : extra) { a.ph_lo = ph; a.ph_hi = ph + 1; void* args[] = {&a}; (void)hipLaunchCooperativeKernel((const void*)hybrid_fwd, dim3(grid), dim3(NTHR), args, LDS_BYTES, stream); } }
#endif
#else
    for (int ph = 0; ph < NPHASE; ++ph) {
        a.ph_lo = ph; a.ph_hi = ph + 1;
        void* args[] = {&a}; hipError_t e = hipLaunchCooperativeKernel((const void*)hybrid_fwd, dim3(grid), dim3(NTHR), args, LDS_BYTES, stream);
        if (e != hipSuccess) { fprintf(stderr, "launch %d failed: %s\n", ph, hipGetErrorString(e)); break; }
    }
#endif
}
```

```cpp
#include <hip/hip_runtime.h>
#include <hip/hip_cooperative_groups.h>
#include <cstdio>
namespace cg = cooperative_groups;

#define ONE_LAUNCH 1
#define EXTRA_SUB ~0ull
namespace pg8 {
#define PG8_LAS __attribute__((address_space(3)))
typedef unsigned short bf16_t;
typedef short bf16x8 __attribute__((ext_vector_type(8)));
typedef float f32x4 __attribute__((ext_vector_type(4)));
typedef unsigned u32x4 __attribute__((ext_vector_type(4)));
constexpr int BM = 256, BK = 64, HALF = 128, HTB = HALF * BK * 2  , STAGE_BYTES = 8 * HTB, NXCD = 8, WGM = 8;

__host__ __device__ __forceinline__ int lds_byte(int r, int c) { const int st = (r >> 4) * 2 + (c >> 5), rr = r & 15, cc = c & 31, ob = rr * 64 + cc * 2; return st * 1024 + (ob ^ (((ob >> 9) & 1) << 5)); }
__host__ __device__ __forceinline__ void stage_rc(int b, int& R, int& C) { const int st = b / 1024, sb = b % 1024, swz = sb ^ (((sb >> 9) & 1) << 5); R = (st >> 1) * 16 + swz / 64; C = (st & 1) * 32 + (swz % 64) / 2; }
__host__ __device__ __forceinline__ int perm32(int rho) { const int n = rho >> 4, i = rho & 15; return 8 * (i >> 2) + 4 * n + (i & 3); }

struct Unit { int pm, pn; };
struct Gemm { const bf16_t* A; const bf16_t* Bt; int M, N, K, ld, msplit; };

struct StaticOrder {
    int nM, nN, nwg, G, c;
    __host__ __device__ void init(int M, int N, int G_, int c_) { nM = M / BM; nN = N / BM; nwg = nM * nN; G = G_; c = c_; }
    __host__ __device__ bool next(int i, Unit& u) const {
        const long L = (long)i * G + c; if (L >= nwg) return false;
        int wgid = (int)L; { const int q = nwg / NXCD, r = nwg % NXCD, xcd = wgid % NXCD, off = wgid / NXCD; wgid = (xcd < r ? xcd * (q + 1) : r * (q + 1) + (xcd - r) * q) + off; }
        const int nig = WGM * nN, gid = wgid / nig, fm = gid * WGM, gsz = (nM - fm) < WGM ? (nM - fm) : WGM;
        u.pm = fm + ((wgid % nig) % gsz); u.pn = (wgid % nig) / gsz; return true;
    }
    __device__ __forceinline__ void a_ready(const Unit&) const {}
    __device__ __forceinline__ void done(const Unit&) const {}
};
__device__ __forceinline__ unsigned cvt_pk_bf16(float lo, float hi) { unsigned r; asm volatile("v_cvt_pk_bf16_f32 %0, %1, %2" : "=v"(r) : "v"(lo), "v"(hi)); return r; }
typedef float f32x2 __attribute__((ext_vector_type(2)));

template <class Epi, class Sched, bool STAMP = false>
__device__ __forceinline__ void gemm_phase(PG8_LAS unsigned char* lds, const Gemm g, const Sched& S, const Epi& E, unsigned long long* stamps) {
    const int tid = threadIdx.x, wid = __builtin_amdgcn_readfirstlane(tid >> 6), lane = tid & 63, wr = wid >> 2, wc = wid & 3, fr = lane & 15, fq = lane >> 4;
    const int K = g.K, nt = K / BK, LD = g.ld, MSPL = g.msplit;
    int ts_lo = 0, ts_hi = 0, nts = 0; const unsigned long long rt_entry = STAMP ? (unsigned long long)wall_clock64() : 0ull;
#define PG8_STAMP() do { if (STAMP && wid == 0 && nts < 64) { const unsigned long long _c = (unsigned long long)clock64(); \
        ts_lo = (lane == nts) ? (int)(unsigned)_c : ts_lo; ts_hi = (lane == nts) ? (int)(unsigned)(_c >> 32) : ts_hi; ++nts; } } while (0)
    PG8_STAMP();
    unsigned voffA[2], voffB[2];
#pragma unroll
    for (int i = 0; i < 2; ++i) { int R, C; stage_rc(tid * 16 + i * 8192, R, C); const int Rb = Epi::PERM ? ((R & ~31) + perm32(R & 31)) : R;
        voffA[i] = (unsigned)(R * LD + C) * 2u; voffB[i] = (unsigned)(Rb * LD + C) * 2u; }
    const size_t kstep = (size_t)(BK * 2);
    const size_t hstep = (size_t)HALF * LD * 2;
    const size_t tstep = 2 * hstep;
    const unsigned ldsw = (unsigned)wid * 1024u;
    const int aoff = lds_byte(wr * 64 + fr, fq * 8), boff = lds_byte(wc * 32 + fr, fq * 8);
#define PG8_SA(b, h) (((b) * 2 + (h)) * HTB)
#define PG8_SB(b, h) ((4 + (b) * 2 + (h)) * HTB)
#define PG8_STAGE(bufoff, gbase, voff) do { _Pragma("unroll") for (int _i = 0; _i < 2; ++_i) \
        __builtin_amdgcn_global_load_lds((const unsigned*)((const char*)(gbase) + (voff)[_i]), (PG8_LAS unsigned*)(lds + (bufoff) + ldsw + _i * 8192), 16, 0, 0); } while (0)
#define PG8_LDA(dst, b, h) do { _Pragma("unroll") for (int m = 0; m < 4; ++m) _Pragma("unroll") for (int k = 0; k < 2; ++k) dst[m][k] = *(const PG8_LAS bf16x8*)(lds + PG8_SA(b, h) + aoff + m * 2048 + k * 1024); } while (0)
#define PG8_LDB(dst, b, h) do { _Pragma("unroll") for (int n = 0; n < 2; ++n) _Pragma("unroll") for (int k = 0; k < 2; ++k) dst[n][k] = *(const PG8_LAS bf16x8*)(lds + PG8_SB(b, h) + boff + n * 2048 + k * 1024); } while (0)
#define PG8_MMA(ai, bj, At, Bt) do { __builtin_amdgcn_s_setprio(1); _Pragma("unroll") for (int m = 0; m < 4; ++m) _Pragma("unroll") for (int n = 0; n < 2; ++n) _Pragma("unroll") for (int k = 0; k < 2; ++k) \
        acc[ai][bj][m][n] = __builtin_amdgcn_mfma_f32_16x16x32_bf16(Bt[n][k], At[m][k], acc[ai][bj][m][n], 0, 0, 0); __builtin_amdgcn_s_setprio(0); } while (0)
#define PG8_WAIT_V(n) asm volatile("s_waitcnt vmcnt(" #n ")" ::: "memory")
#define PG8_WAIT_L(n) asm volatile("s_waitcnt lgkmcnt(" #n ")" ::: "memory")
#define PG8_BAR __builtin_amdgcn_s_barrier()
#define PG8_SCHED __builtin_amdgcn_sched_barrier(0)
    Unit cur, nxt; int ui = 0;
    if (!S.next(0, cur)) return;
    f32x4 acc[2][2][4][2];
#pragma unroll
    for (int a = 0; a < 2; ++a)
#pragma unroll
        for (int b = 0; b < 2; ++b)
#pragma unroll
            for (int m = 0; m < 4; ++m)
#pragma unroll
                for (int n = 0; n < 2; ++n) acc[a][b][m][n] = (f32x4){0.f, 0.f, 0.f, 0.f};
    bf16x8 At[4][2], B0[2][2], B1[2][2];
#define PG8_OFFA(u) (MSPL ? (size_t)((u).pm % MSPL) * tstep + (size_t)((u).pm / MSPL) * ((size_t)K * 2) : (size_t)(u).pm * tstep)
#define PG8_OFFB(u) ((size_t)(u).pn * tstep + (MSPL ? (size_t)((u).pm / MSPL) * ((size_t)K * 2) : (size_t)0))
    const char* cA = (const char*)g.A + PG8_OFFA(cur); const char* cB = (const char*)g.Bt + PG8_OFFB(cur);
    S.a_ready(cur);
    PG8_STAGE(PG8_SB(0, 0), cB, voffB); PG8_STAGE(PG8_SA(0, 0), cA, voffA); PG8_STAGE(PG8_SB(0, 1), cB + hstep, voffB); PG8_STAGE(PG8_SA(0, 1), cA + hstep, voffA);
    if (wr == 1) PG8_BAR;
    PG8_WAIT_V(4); PG8_BAR;
    PG8_STAGE(PG8_SB(1, 0), cB + kstep, voffB); PG8_STAGE(PG8_SA(1, 0), cA + kstep, voffA); PG8_STAGE(PG8_SB(1, 1), cB + hstep + kstep, voffB);
    PG8_WAIT_V(6); PG8_BAR;
    PG8_STAMP();
    for (;;) {
        const bool has_next = S.next(ui + 1, nxt);
        const char* nA = has_next ? (const char*)g.A + PG8_OFFA(nxt) : cA; const char* nB = has_next ? (const char*)g.Bt + PG8_OFFB(nxt) : cB;
        for (int t = 0; t < nt; t += 2) {
            const bool last = (t == nt - 2);
            const char* a1 = cA + (size_t)(t + 1) * kstep;
            const char* a2 = last ? nA : cA + (size_t)(t + 2) * kstep; const char* b2 = last ? nB : cB + (size_t)(t + 2) * kstep;
            const char* a3 = a2 + kstep; const char* b3 = b2 + kstep;
            if (last && has_next) S.a_ready(nxt);
            PG8_LDB(B0, 0, 0); PG8_SCHED; PG8_LDA(At, 0, 0); PG8_STAGE(PG8_SA(1, 1), a1 + hstep, voffA);
            PG8_WAIT_L(8); PG8_BAR; PG8_WAIT_L(0); PG8_MMA(0, 0, At, B0); PG8_BAR; PG8_SCHED;
            PG8_LDB(B1, 0, 1); PG8_STAGE(PG8_SB(0, 0), b2, voffB);
            PG8_BAR; PG8_WAIT_L(0); PG8_MMA(0, 1, At, B1); PG8_BAR;
            PG8_LDA(At, 0, 1); PG8_STAGE(PG8_SA(0, 0), a2, voffA);
            PG8_BAR; PG8_WAIT_L(0); PG8_MMA(1, 0, At, B0); PG8_BAR; PG8_SCHED;
            PG8_STAGE(PG8_SB(0, 1), b2 + hstep, voffB);
            PG8_WAIT_V(6); PG8_BAR; PG8_MMA(1, 1, At, B1); PG8_BAR;
            PG8_LDB(B0, 1, 0); PG8_SCHED; PG8_LDA(At, 1, 0); PG8_STAGE(PG8_SA(0, 1), a2 + hstep, voffA);
            PG8_WAIT_L(8); PG8_BAR; PG8_WAIT_L(0); PG8_MMA(0, 0, At, B0); PG8_BAR; PG8_SCHED;
            PG8_LDB(B1, 1, 1); PG8_STAGE(PG8_SB(1, 0), b3, voffB);
            PG8_BAR; PG8_WAIT_L(0); PG8_MMA(0, 1, At, B1); PG8_BAR;
            PG8_LDA(At, 1, 1); PG8_STAGE(PG8_SA(1, 0), a3, voffA);
            PG8_BAR; PG8_WAIT_L(0); PG8_MMA(1, 0, At, B0); PG8_BAR; PG8_SCHED;
            PG8_STAGE(PG8_SB(1, 1), b3 + hstep, voffB);
            PG8_WAIT_V(6); PG8_BAR; PG8_MMA(1, 1, At, B1); PG8_BAR;
        }
        PG8_STAMP();
        if constexpr (!Epi::AFTER_DRAIN) { E(acc, cur, wr, wc, fr, fq); S.done(cur); }
        PG8_STAMP();
        if (!has_next) break;
#pragma unroll
        for (int a = 0; a < 2; ++a)
#pragma unroll
            for (int b = 0; b < 2; ++b)
#pragma unroll
                for (int m = 0; m < 4; ++m)
#pragma unroll
                    for (int n = 0; n < 2; ++n) acc[a][b][m][n] = (f32x4){0.f, 0.f, 0.f, 0.f};
        cur = nxt; cA = nA; cB = nB; ++ui;
    }
    PG8_WAIT_V(0);
    if (wr == 0) PG8_BAR;
    PG8_BAR;
    if constexpr (Epi::AFTER_DRAIN) { E.fused(acc, cur, wr, wc, fr, fq, lds, wid, lane); S.done(cur); }
    PG8_STAMP();
    if (STAMP && wid == 0) { stamps[lane] = lane < nts ? (((unsigned long long)(unsigned)ts_hi << 32) | (unsigned)ts_lo) : 0ull;
        if (lane == 62) stamps[62] = rt_entry; if (lane == 63) stamps[63] = (unsigned long long)wall_clock64(); }
#undef PG8_STAMP
#undef PG8_SA
#undef PG8_SB
#undef PG8_STAGE
#undef PG8_LDA
#undef PG8_LDB
#undef PG8_MMA
#undef PG8_WAIT_V
#undef PG8_WAIT_L
#undef PG8_BAR
#undef PG8_SCHED
}
}
#ifndef LAS
#define LAS __attribute__((address_space(3)))
#endif
#define XB_TMO      128
#define XB_XCNT(j)  (256  + 64 * (j))
#define XB_XSUB(j)  (1280 + 64 * (j))
#define XB_XGEN(j)  (2304 + 64 * (j))
#define XB_TOP      3328
#define XB_TOPGEN   3392
#define XCD_BAR_WORDS 3456
#define XB_SPIN_CAP (1u << 18)

__device__ __forceinline__ unsigned xb_ld(unsigned* p)              { return __hip_atomic_load(p, __ATOMIC_RELAXED, __HIP_MEMORY_SCOPE_AGENT); }
__device__ __forceinline__ unsigned xb_add(unsigned* p, unsigned v) { return __hip_atomic_fetch_add(p, v, __ATOMIC_RELAXED, __HIP_MEMORY_SCOPE_AGENT); }
__device__ __forceinline__ unsigned xb_xcc_id() { return (unsigned)__builtin_amdgcn_s_getreg((3 << 11) | 20) & 0xFu; }
#define XB_SPIN(cond, bar) do { unsigned _sp = 0; while (cond) { __builtin_amdgcn_s_sleep(1); \
    if ((++_sp & 255u) == 0u) { if (xb_ld(&(bar)[XB_TMO])) break; if (_sp > XB_SPIN_CAP) { atomicAdd(&(bar)[XB_TMO], 1u); break; } } } } while (0)

struct XcdBarrier {
    unsigned* bar; unsigned x;
    volatile LAS unsigned* st;
};

__device__ __forceinline__ XcdBarrier xcd_barrier_post(unsigned* bar, volatile LAS unsigned* st) {
    XcdBarrier b; b.bar = bar; b.x = xb_xcc_id(); b.st = st;
    if (threadIdx.x == 0) (void)xb_add(&bar[XB_XCNT(b.x)], 1u);
    return b;
}
__device__ __forceinline__ void xcd_barrier_complete(unsigned* bar, unsigned x, unsigned& nloc, unsigned& nx) {
    const unsigned G = gridDim.x * gridDim.y * gridDim.z;
    unsigned sum, cnt, mine, sp = 0u;
    for (;;) {
        sum = 0u; cnt = 0u; mine = 0u;
#pragma unroll
        for (unsigned j = 0; j < 16; ++j) { const unsigned c = xb_ld(&bar[XB_XCNT(j)]); sum += c; cnt += (c > 0u) ? 1u : 0u; mine = (j == x) ? c : mine; }
        if (sum == G) break;
        __builtin_amdgcn_s_sleep(1);
        if ((++sp & 255u) == 0u) { if (xb_ld(&bar[XB_TMO])) break; if (sp > XB_SPIN_CAP) { atomicAdd(&bar[XB_TMO], 1u); break; } }
    }
    nloc = mine > 0u ? mine : 1u; nx = cnt > 0u ? cnt : 1u;
}

__device__ __forceinline__ void xcd_barrier(const XcdBarrier& b) {
    asm volatile("s_waitcnt vmcnt(0)" ::: "memory");
    __syncthreads();
    if (threadIdx.x == 0) {
        unsigned* bar = b.bar;
        __builtin_amdgcn_s_waitcnt(0);
        unsigned nloc = b.st[0], nx = b.st[1];
        if (nloc == 0u) { xcd_barrier_complete(bar, b.x, nloc, nx); b.st[0] = nloc; b.st[1] = nx; }
        const unsigned old = xb_add(&bar[XB_XSUB(b.x)], 1u);
        const unsigned gen = old / nloc;
        if (old + 1u == (gen + 1u) * nloc) {
            __builtin_amdgcn_fence(__ATOMIC_RELEASE, "agent");
            asm volatile("s_waitcnt vmcnt(0)" ::: "memory");
            const unsigned og = xb_add(&bar[XB_TOP], 1u);
            const unsigned tg = og / nx;
            if (og + 1u == (tg + 1u) * nx) xb_add(&bar[XB_TOPGEN], 1u);
            else XB_SPIN(xb_ld(&bar[XB_TOPGEN]) == tg, bar);
            __builtin_amdgcn_fence(__ATOMIC_ACQUIRE, "agent");
            xb_add(&bar[XB_XGEN(b.x)], 1u);
            asm volatile("s_waitcnt vmcnt(0)" ::: "memory");
        } else {
            XB_SPIN(xb_ld(&bar[XB_XGEN(b.x)]) == gen, bar);
            __builtin_amdgcn_fence(__ATOMIC_ACQUIRE, "agent");
            asm volatile("s_waitcnt vmcnt(0)" ::: "memory");
        }
    }
    __syncthreads();
}


using namespace pg8;
#undef LAS
#define LAS PG8_LAS
typedef unsigned u32x2 __attribute__((ext_vector_type(2)));

constexpr int D = 2048, NBATCH = 4, SEQ = 2048, CTXL = 256, DFF = 5632;
constexpr int MLAT = NBATCH * SEQ, MCTX = NBATCH * CTXL, MR = MLAT + MCTX;
constexpr int INW = 4160, INWP = 3328, GLUW = 1024;
constexpr int OFF_RQ = 0, OFF_RK = 384, OFF_RV = 768, OFF_RG = 1536, OFF_CQ = 2304, OFF_CKV = 2816, OFF_KR = 3072;
constexpr int NKEY = CTXL + SEQ;
constexpr int NCH = 18;
constexpr float EPS = 1e-6f;
constexpr int NTHR = 512;
constexpr int DEFER_GRID = 256;
constexpr int LDS_BYTES = 151552;

constexpr size_t SZ_WFFIN = (size_t)2 * DFF * D * 2;
constexpr size_t SZ_WFFOUT = (size_t)D * DFF * 2;
constexpr size_t SZ_WIN = (size_t)INWP * D * 2;
constexpr size_t SZ_WOUT = (size_t)D * D * 2;
constexpr size_t SZ_WUQ = (size_t)1280 * 512 * 2;
constexpr size_t SZ_WUKV = (size_t)1536 * 256 * 2;
constexpr size_t SZ_WPW = (size_t)512 * 512 * 2;
constexpr size_t WS_WFFIN = 0;
constexpr size_t WS_WFFOUT = WS_WFFIN + 4 * SZ_WFFIN;
constexpr size_t WS_WIN = WS_WFFOUT + 4 * SZ_WFFOUT;
constexpr size_t WS_WOUT = WS_WIN + 2 * SZ_WIN;
constexpr size_t WS_WUQ = WS_WOUT + 2 * SZ_WOUT;
constexpr size_t WS_WUKV = WS_WUQ + 2 * SZ_WUQ;
constexpr size_t WS_WPW = WS_WUKV + 2 * SZ_WUKV;
constexpr size_t WS_MOD = WS_WPW + 2 * SZ_WPW;
constexpr size_t WS_X = WS_MOD + (size_t)2 * 5 * 18432 * 4;
constexpr size_t WS_H = WS_X + (size_t)MR * D * 4;
constexpr size_t WS_Y = WS_H + (size_t)MR * D * 2;
constexpr size_t WS_P = WS_Y + (size_t)MR * D * 4;
constexpr size_t WS_QR = WS_P + (size_t)MR * INWP * 4;
constexpr size_t WS_KR = WS_QR + (size_t)MR * 384 * 4;
constexpr size_t WS_CQN = WS_KR + (size_t)MR * 384 * 4;
constexpr size_t WS_CKVN = WS_CQN + (size_t)MR * 512 * 2;
constexpr size_t WS_CVN = WS_CKVN + (size_t)MR * 256 * 2;
constexpr size_t WS_QF = WS_CVN + (size_t)MR * 512 * 2;
constexpr size_t WS_KVF = WS_QF + (size_t)MR * 1280 * 4;
constexpr size_t WS_QB = WS_KVF + (size_t)MR * 1536 * 4;
constexpr size_t WS_KB = WS_QB + (size_t)NBATCH * 6 * NKEY * 192 * 2;
constexpr size_t WS_VT = WS_KB + (size_t)NBATCH * 6 * NKEY * 192 * 2;
constexpr size_t WS_CAT = WS_VT + (size_t)NBATCH * 6 * 128 * NKEY * 2;
constexpr size_t WS_SF = WS_CAT + (size_t)MR * D * 2;
constexpr size_t WS_SB = WS_SF + (size_t)NBATCH * 6 * NCH * 8192 * 4;
constexpr size_t WS_TAB = WS_SB + (size_t)NBATCH * 6 * NCH * 8192 * 4;
constexpr size_t WS_YP = WS_TAB + (size_t)2048 * 32 * 8;
constexpr size_t WS_BAR = WS_YP + (size_t)4 * MCTX * D * 4;
constexpr size_t WS_RKB = WS_BAR + 16384;
constexpr size_t WS_RVT = WS_RKB + (size_t)24 * NCH * 128 * 64 * 2;
constexpr size_t SZ_WGLU = (size_t)GLUW * D * 2;
constexpr size_t WS_WGLU = WS_RVT + (size_t)24 * NCH * 128 * 128 * 2;
constexpr size_t WS_PG = WS_WGLU + 2 * SZ_WGLU;
constexpr size_t WS_END = WS_PG + (size_t)MR * GLUW * 2;

#ifndef REPMASK
#define REPMASK 0ull
#endif
struct Args { const float* in[23]; float* out; unsigned char* ws; unsigned long long sub; int ph_lo, ph_hi; };

__device__ __forceinline__ float wave_sum(float v) {
#pragma unroll
    for (int o = 32; o; o >>= 1) v += __shfl_xor(v, o);
    return v;
}
__device__ __forceinline__ float siluf(float a) { return a * __builtin_amdgcn_rcpf(1.f + __expf(-a)); }
__device__ __forceinline__ float sigmf(float a) { return __builtin_amdgcn_rcpf(1.f + __expf(-a)); }
__device__ __forceinline__ bf16_t f2bf(float f) { unsigned u = __float_as_uint(f); u += 0x7FFFu + ((u >> 16) & 1u); return (bf16_t)(u >> 16); }
__device__ __forceinline__ float bf2f(bf16_t v) { return __uint_as_float((unsigned)v << 16); }
__device__ __forceinline__ f32x4 ld_bf4(const bf16_t* p) { const u32x2 w = *(const u32x2*)p; return (f32x4){__uint_as_float(w.x << 16), __uint_as_float(w.x & 0xffff0000u), __uint_as_float(w.y << 16), __uint_as_float(w.y & 0xffff0000u)}; }
__device__ __forceinline__ int mod_of_row(int row) { return row < MLAT ? (row >> 11) : 4; }

__device__ __forceinline__ void rope_compute(int i, int t, float& cs, float& sn) {
    const float inv = exp2f(-(float)(i & 15) * (13.287712379549449f / 16.f));
    const float pos = (float)((i < 16) ? (t >> 6) : (t & 63));
    sincosf(pos * inv, &sn, &cs);
}
__device__ __forceinline__ void rope_cs(const f32x2* tab, int i, int t, bool latent, float& cs, float& sn) {
    const f32x2 v = tab[(latent ? t : 0) * 32 + i]; cs = latent ? v.x : 1.f; sn = latent ? v.y : 0.f;
}

__device__ __forceinline__ int map_col(int mode, int n) {
    if (mode == 1) { const int g = n >> 8, r = n & 255; return (r < 128) ? g * 128 + r : DFF + g * 128 + (r - 128); }
    if (mode == 2) return n < 2304 ? n : n + GLUW;
    if (mode == 3) return n + 2304;
    return n;
}
template <int MODE>
__device__ __forceinline__ void transpose_job(const float* src, bf16_t* dst, const int K, const int Nsrc, const int Ndst, const int goff, LAS float* tl) {
    const int tid = threadIdx.x, G = gridDim.x;
    const int ntn = Ndst >> 7, ntile = (K >> 7) * ntn;
    int t = ((int)blockIdx.x - goff % G + G) % G;
    const int n4 = (tid & 31) * 4, kr = tid >> 5;
    f32x4 v[8];
#define TJ_ISSUE(tt) do { const int tk_ = (tt) / ntn, tn_ = (tt) % ntn, k0_ = tk_ * 128, n_ = tn_ * 128 + n4; \
        const int scol_ = map_col(MODE, n_); \
        const bool valid_ = scol_ < Nsrc; const float* p_ = src + (size_t)(k0_ + kr) * Nsrc + scol_; \
        _Pragma("unroll") for (int i = 0; i < 8; ++i) v[i] = valid_ ? __builtin_nontemporal_load((const f32x4*)(p_ + (size_t)(16 * i) * Nsrc)) : (f32x4){0.f, 0.f, 0.f, 0.f}; } while (0)
    if (t < ntile) TJ_ISSUE(t);
    for (; t < ntile; t += G) {
        const int tk = t / ntn, tn = t % ntn, k0 = tk * 128, n0 = tn * 128;
#pragma unroll
        for (int i = 0; i < 8; ++i) { LAS float* q = tl + (kr + 16 * i) * 129 + n4; q[0] = v[i][0]; q[1] = v[i][1]; q[2] = v[i][2]; q[3] = v[i][3]; }
        __syncthreads();
        if (t + G < ntile) TJ_ISSUE(t + G);
#pragma unroll
        for (int i = 0; i < 4; ++i) { const int idx = tid + 512 * i, k8 = (idx & 15) * 8, n = idx >> 4; float x[8];
#pragma unroll
            for (int j = 0; j < 8; ++j) x[j] = tl[(k8 + j) * 129 + n];
            u32x4 w; w.x = cvt_pk_bf16(x[0], x[1]); w.y = cvt_pk_bf16(x[2], x[3]); w.z = cvt_pk_bf16(x[4], x[5]); w.w = cvt_pk_bf16(x[6], x[7]);
            *(u32x4*)(dst + (size_t)(n0 + n) * K + k0 + k8) = w; }
        __syncthreads();
    }
}

__device__ __forceinline__ void phase_prologue(const Args& a, LAS unsigned char* lds) {
    const int tid = threadIdx.x, G = gridDim.x, bid = blockIdx.x;
    LAS float* sl = (LAS float*)lds;
    LAS float* red = (LAS float*)(lds + 40960);
    LAS float* tl = (LAS float*)lds;
    for (int i = tid; i < 5 * 2048; i += NTHR) { const int m = i >> 11, k = i & 2047; const float c = m < 4 ? a.in[1][m * 2048 + k] : a.in[3][k]; sl[i] = siluf(c); }
    __syncthreads();
    float* MOD = (float*)(a.ws + WS_MOD);
    for (int it = bid; it < 256; it += G) {
        const int l = it >> 7, n0 = (it & 127) * 144, c4 = tid % 36, sl_i = tid / 36;
        f32x4 acc[5];
#pragma unroll
        for (int m = 0; m < 5; ++m) acc[m] = (f32x4){0.f, 0.f, 0.f, 0.f};
        if (sl_i < 14) {
            const float* w = a.in[4] + (size_t)l * 2048 * 18432 + n0 + c4 * 4;
#pragma unroll 8
            for (int k = sl_i; k < 2048; k += 14) { const f32x4 wv = __builtin_nontemporal_load((const f32x4*)(w + (size_t)k * 18432));
#pragma unroll
                for (int m = 0; m < 5; ++m) acc[m] += wv * sl[m * 2048 + k]; }
#pragma unroll
            for (int m = 0; m < 5; ++m) { LAS float* q = red + (sl_i * 5 + m) * 144 + c4 * 4; q[0] = acc[m][0]; q[1] = acc[m][1]; q[2] = acc[m][2]; q[3] = acc[m][3]; }
        }
        __syncthreads();
        for (int o = tid; o < 5 * 144; o += NTHR) { const int m = o / 144, c = o % 144; float s = 0.f;
#pragma unroll
            for (int q = 0; q < 14; ++q) s += red[(q * 5 + m) * 144 + c];
            MOD[((size_t)l * 5 + m) * 18432 + n0 + c] = s + a.in[5][l * 18432 + n0 + c]; }
        __syncthreads();
    }
    { f32x2* tab = (f32x2*)(a.ws + WS_TAB);
      for (int e = bid * NTHR + tid; e < 2048 * 32; e += G * NTHR) { float cs, sn; rope_compute(e & 31, e >> 5, cs, sn); tab[e] = (f32x2){cs, sn}; } }
    unsigned char* ws = a.ws; int goff = 0;
    const bool defer = (G == DEFER_GRID);
#pragma unroll 1
    for (int l = 0; l < 2; ++l) {
        if (defer && l == 1) break;
        transpose_job<1>(a.in[7] + (size_t)l * D * 2 * DFF, (bf16_t*)(ws + WS_WFFIN + (size_t)(l * 2 + 0) * SZ_WFFIN), D, 2 * DFF, 2 * DFF, goff, tl); goff += 16 * 88;
        transpose_job<0>(a.in[8] + (size_t)l * DFF * D, (bf16_t*)(ws + WS_WFFOUT + (size_t)(l * 2 + 0) * SZ_WFFOUT), DFF, D, D, goff, tl); goff += 44 * 16;
        transpose_job<2>(a.in[11] + (size_t)l * D * INW, (bf16_t*)(ws + WS_WIN + (size_t)l * SZ_WIN), D, INW, INWP, goff, tl); goff += 16 * 26;
        transpose_job<3>(a.in[11] + (size_t)l * D * INW, (bf16_t*)(ws + WS_WGLU + (size_t)l * SZ_WGLU), D, INW, GLUW, goff, tl); goff += 16 * 8;
        transpose_job<0>(a.in[20] + (size_t)l * 512 * 1152, (bf16_t*)(ws + WS_WUQ + (size_t)l * SZ_WUQ), 512, 1152, 1280, goff, tl); goff += 4 * 10;
        transpose_job<0>(a.in[22] + (size_t)l * 256 * 1536, (bf16_t*)(ws + WS_WUKV + (size_t)l * SZ_WUKV), 256, 1536, 1536, goff, tl); goff += 2 * 12;
        transpose_job<0>(a.in[18] + (size_t)l * 512 * 512, (bf16_t*)(ws + WS_WPW + (size_t)l * SZ_WPW), 512, 512, 512, goff, tl); goff += 4 * 4;
        if (defer) break;
        transpose_job<0>(a.in[12] + (size_t)l * D * D, (bf16_t*)(ws + WS_WOUT + (size_t)l * SZ_WOUT), D, D, D, goff, tl); goff += 16 * 16;
        transpose_job<1>(a.in[9] + (size_t)l * D * 2 * DFF, (bf16_t*)(ws + WS_WFFIN + (size_t)(l * 2 + 1) * SZ_WFFIN), D, 2 * DFF, 2 * DFF, goff, tl); goff += 16 * 88;
        transpose_job<0>(a.in[10] + (size_t)l * DFF * D, (bf16_t*)(ws + WS_WFFOUT + (size_t)(l * 2 + 1) * SZ_WFFOUT), DFF, D, D, goff, tl); goff += 44 * 16;
    }
}

constexpr int DJ_N[12] = {256, 1408, 704,   1408, 704, 544, 40, 24, 16, 256, 1408, 704};
constexpr int NDEF = 256 + 1408 + 704 + 1408 + 704 + 544 + 40 + 24 + 16 + 256 + 1408 + 704;
__device__ __forceinline__ void dj_decode(const Args& a, int d, const float*& src, bf16_t*& dst, int& K, int& Nsrc, int& Ndst, int& mode, int& t) {
    unsigned char* ws = a.ws; mode = 0; t = d;
    if (t < 256)  { src = a.in[12];                        dst = (bf16_t*)(ws + WS_WOUT);                  K = D;   Nsrc = D;       Ndst = D;       return; } t -= 256;
    if (t < 1408) { src = a.in[9];                         dst = (bf16_t*)(ws + WS_WFFIN + 1 * SZ_WFFIN);  K = D;   Nsrc = 2 * DFF; Ndst = 2 * DFF; mode = 1; return; } t -= 1408;
    if (t < 704)  { src = a.in[10];                        dst = (bf16_t*)(ws + WS_WFFOUT + 1 * SZ_WFFOUT); K = DFF; Nsrc = D;      Ndst = D;       return; } t -= 704;
    if (t < 1408) { src = a.in[7] + (size_t)D * 2 * DFF;   dst = (bf16_t*)(ws + WS_WFFIN + 2 * SZ_WFFIN);  K = D;   Nsrc = 2 * DFF; Ndst = 2 * DFF; mode = 1; return; } t -= 1408;
    if (t < 704)  { src = a.in[8] + (size_t)DFF * D;       dst = (bf16_t*)(ws + WS_WFFOUT + 2 * SZ_WFFOUT); K = DFF; Nsrc = D;      Ndst = D;       return; } t -= 704;
    if (t < 416)  { src = a.in[11] + (size_t)D * INW;      dst = (bf16_t*)(ws + WS_WIN + SZ_WIN);          K = D;   Nsrc = INW;     Ndst = INWP;    mode = 2; return; } t -= 416;
    if (t < 128)  { src = a.in[11] + (size_t)D * INW;      dst = (bf16_t*)(ws + WS_WGLU + SZ_WGLU);        K = D;   Nsrc = INW;     Ndst = GLUW;    mode = 3; return; } t -= 128;
    if (t < 40)   { src = a.in[20] + (size_t)512 * 1152;   dst = (bf16_t*)(ws + WS_WUQ + SZ_WUQ);          K = 512; Nsrc = 1152;    Ndst = 1280;    return; } t -= 40;
    if (t < 24)   { src = a.in[22] + (size_t)256 * 1536;   dst = (bf16_t*)(ws + WS_WUKV + SZ_WUKV);        K = 256; Nsrc = 1536;    Ndst = 1536;    return; } t -= 24;
    if (t < 16)   { src = a.in[18] + (size_t)512 * 512;    dst = (bf16_t*)(ws + WS_WPW + SZ_WPW);          K = 512; Nsrc = 512;     Ndst = 512;     return; } t -= 16;
    if (t < 256)  { src = a.in[12] + (size_t)D * D;        dst = (bf16_t*)(ws + WS_WOUT + SZ_WOUT);        K = D;   Nsrc = D;       Ndst = D;       return; } t -= 256;
    if (t < 1408) { src = a.in[9] + (size_t)D * 2 * DFF;   dst = (bf16_t*)(ws + WS_WFFIN + 3 * SZ_WFFIN);  K = D;   Nsrc = 2 * DFF; Ndst = 2 * DFF; mode = 1; return; } t -= 1408;
    src = a.in[10] + (size_t)DFF * D; dst = (bf16_t*)(ws + WS_WFFOUT + 3 * SZ_WFFOUT); K = DFF; Nsrc = D; Ndst = D;
}
__device__ __forceinline__ void deferred_convert(const Args& a, int first, int stride, int count, LAS float* tl) {
    const int tid = threadIdx.x, n4 = (tid & 31) * 4, kr = tid >> 5;
    f32x4 v[8];
#define DJ_ISSUE(dd) do { const float* src_; bf16_t* dst_; int K_, Ns_, Nd_, md_, t_; dj_decode(a, (dd), src_, dst_, K_, Ns_, Nd_, md_, t_); \
        const int ntn_ = Nd_ >> 7, tk_ = t_ / ntn_, tn_ = t_ % ntn_, k0_ = tk_ * 128, n_ = tn_ * 128 + n4; \
        const int scol_ = map_col(md_, n_); \
        const bool valid_ = scol_ < Ns_; const float* p_ = src_ + (size_t)(k0_ + kr) * Ns_ + scol_; \
        _Pragma("unroll") for (int i = 0; i < 8; ++i) v[i] = valid_ ? __builtin_nontemporal_load((const f32x4*)(p_ + (size_t)(16 * i) * Ns_)) : (f32x4){0.f, 0.f, 0.f, 0.f}; } while (0)
    int d = first;
    if (count > 0 && d < NDEF) DJ_ISSUE(d);
    for (int k = 0; k < count && d < NDEF; ++k, d += stride) {
        const float* src; bf16_t* dst; int K, Nsrc, Ndst, mode, t; dj_decode(a, d, src, dst, K, Nsrc, Ndst, mode, t);
        const int ntn = Ndst >> 7, tk = t / ntn, tn = t % ntn, k0 = tk * 128, n0 = tn * 128;
#pragma unroll
        for (int i = 0; i < 8; ++i) { LAS float* q = tl + (kr + 16 * i) * 129 + n4; q[0] = v[i][0]; q[1] = v[i][1]; q[2] = v[i][2]; q[3] = v[i][3]; }
        __syncthreads();
        if (k + 1 < count && d + stride < NDEF) DJ_ISSUE(d + stride);
#pragma unroll
        for (int i = 0; i < 4; ++i) { const int idx = tid + 512 * i, k8 = (idx & 15) * 8, n = idx >> 4; float x[8];
#pragma unroll
            for (int j = 0; j < 8; ++j) x[j] = tl[(k8 + j) * 129 + n];
            u32x4 w; w.x = cvt_pk_bf16(x[0], x[1]); w.y = cvt_pk_bf16(x[2], x[3]); w.z = cvt_pk_bf16(x[4], x[5]); w.w = cvt_pk_bf16(x[6], x[7]);
            *(u32x4*)(dst + (size_t)(n0 + n) * K + k0 + k8) = w; }
        __syncthreads();
    }
#undef DJ_ISSUE
}
constexpr int DW_START2 = 0,    DW_IDLE2 = 48,   DW_Q2 = 10;
constexpr int DW_START3 = DW_START2 + (256 - DW_IDLE2) * DW_Q2,   DW_IDLE3 = 128,  DW_Q3 = 6;
constexpr int DW_START5 = DW_START3 + (256 - DW_IDLE3) * DW_Q3,   DW_IDLE5 = 212,  DW_Q5 = 12;
constexpr int DW_START9 = DW_START5 + (256 - DW_IDLE5) * DW_Q5,   DW_IDLE9 = 216,  DW_Q9 = 22;
constexpr int DW_START10 = DW_START9 + (256 - DW_IDLE9) * DW_Q9,  DW_IDLE10 = 128, DW_Q10 = 2;
constexpr int DW_START12 = DW_START10 + (256 - DW_IDLE10) * DW_Q10, DW_IDLE12 = 48, DW_Q12 = 10;
constexpr int DW_START13 = DW_START12 + (256 - DW_IDLE12) * DW_Q12, DW_IDLE13 = 128, DW_Q13 = 8;
constexpr int DW_END = DW_START13 + (256 - DW_IDLE13) * DW_Q13;
static_assert(DW_START3 >= 256, "W_out(0) must be converted before phase 10");
static_assert(DW_START3 >= 256 + 1408, "FFN-b in (0) must be converted before phase 12");
static_assert(DW_START5 >= 256 + 1408 + 704, "FFN-b out (0) must be converted before phase 13");
static_assert(DW_END >= NDEF, "every deferred tile must be converted before layer 1 starts");
__device__ __forceinline__ void deferred_window(const Args& a, int l, int idle0, int start, int quota, LAS unsigned char* lds) {
    if (l != 0 || gridDim.x != DEFER_GRID || (int)blockIdx.x < idle0) return;
    deferred_convert(a, start + ((int)blockIdx.x - idle0), DEFER_GRID - idle0, quota, (LAS float*)lds);
}

__device__ __forceinline__ void norm_mod_store(const f32x4 (&x)[8], const float* g, const float* shift, const float* scale, bf16_t* hrow, int lane) {
    float ss = 0.f;
#pragma unroll
    for (int i = 0; i < 8; ++i) ss += (x[i][0] * x[i][0] + x[i][1] * x[i][1]) + (x[i][2] * x[i][2] + x[i][3] * x[i][3]);
    ss = wave_sum(ss);
    const float r = rsqrtf(ss * (1.f / 2048.f) + EPS);
#pragma unroll
    for (int i = 0; i < 8; ++i) { const int c = lane * 4 + i * 256;
        const f32x4 gv = *(const f32x4*)(g + c), sh = *(const f32x4*)(shift + c), sc = *(const f32x4*)(scale + c);
        const f32x4 h = (x[i] * r * gv) * (sc + 1.f) + sh;
        u32x2 w; w.x = cvt_pk_bf16(h[0], h[1]); w.y = cvt_pk_bf16(h[2], h[3]);
        *(u32x2*)(hrow + c) = w; }
}

__device__ __forceinline__ void phase_norm0(const Args& a, LAS unsigned char* lds) {
    const int tid = threadIdx.x, lane = tid & 63, wid = tid >> 6, G = gridDim.x;
    float* X = (float*)(a.ws + WS_X); bf16_t* H = (bf16_t*)(a.ws + WS_H); const float* MOD = (const float*)(a.ws + WS_MOD);
    const float* gpre = a.in[6];
    LAS float* G2 = (LAS float*)lds; LAS float* SH = G2 + D;
    const int per = (MR + G - 1) / G, r0 = (int)blockIdx.x * per, r1 = (r0 + per < MR) ? r0 + per : MR;
    if (r0 >= MR) return;
    const int m0 = mod_of_row(r0);
    { const float* md = MOD + (size_t)m0 * 18432; const int c = tid * 4;
      *(LAS f32x4*)(G2 + c) = *(const f32x4*)(gpre + c) * (*(const f32x4*)(md + D + c) + 1.f); *(LAS f32x4*)(SH + c) = *(const f32x4*)(md + c); }
    __syncthreads();
#define RC(k) (lane * 8 + ((k) >> 1) * 512 + ((k) & 1) * 4)
#define N0_LOAD(xx, rw) do { const float* src_ = (rw) < MLAT ? a.in[0] + (size_t)(rw) * D : a.in[2] + (size_t)((rw) - MLAT) * D; \
        _Pragma("unroll") for (int k = 0; k < 8; ++k) xx[k] = *(const f32x4*)(src_ + RC(k)); } while (0)
    f32x4 x[8], xn[8];
    if (r0 + wid < r1) N0_LOAD(x, r0 + wid);
    for (int row = r0 + wid; row < r1; row += 8) {
        const int m = mod_of_row(row); const bool fast = (m == m0); const bool more = row + 8 < r1;
        if (more) N0_LOAD(xn, row + 8);
        const float* md = MOD + (size_t)m * 18432;
        float s2 = 0.f;
#pragma unroll
        for (int k = 0; k < 8; ++k) { *(f32x4*)(X + (size_t)row * D + RC(k)) = x[k]; s2 += (x[k][0] * x[k][0] + x[k][1] * x[k][1]) + (x[k][2] * x[k][2] + x[k][3] * x[k][3]); }
        s2 = wave_sum(s2);
        const float r2 = rsqrtf(s2 * (1.f / 2048.f) + EPS);
#pragma unroll
        for (int i = 0; i < 4; ++i) { f32x4 h[2];
#pragma unroll
            for (int hh = 0; hh < 2; ++hh) { const int k = 2 * i + hh, c = RC(k);
                const f32x4 g2 = fast ? *(const LAS f32x4*)(G2 + c) : *(const f32x4*)(gpre + c) * (*(const f32x4*)(md + D + c) + 1.f);
                const f32x4 sh = fast ? *(const LAS f32x4*)(SH + c) : *(const f32x4*)(md + c);
                h[hh] = x[k] * r2 * g2 + sh; }
            u32x4 w; w.x = cvt_pk_bf16(h[0][0], h[0][1]); w.y = cvt_pk_bf16(h[0][2], h[0][3]); w.z = cvt_pk_bf16(h[1][0], h[1][1]); w.w = cvt_pk_bf16(h[1][2], h[1][3]);
            *(u32x4*)(H + (size_t)row * D + lane * 8 + i * 512) = w; }
        if (more) {
#pragma unroll
            for (int k = 0; k < 8; ++k) x[k] = xn[k]; }
    }
#undef N0_LOAD
#undef RC
    __syncthreads();
}

__device__ __forceinline__ void phase_resnorm(const Args& a, int l, int gi_post, int mi_gate, float rs, bool has_next, int ln, int gi_pre, int mi_shift, int mi_scale, bool final_out, int M, LAS unsigned char* lds) {
    const float* YP = (const float*)(a.ws + WS_YP);
    const int tid = threadIdx.x, lane = tid & 63, wid = tid >> 6, G = gridDim.x;
    float* X = (float*)(a.ws + WS_X); const bf16_t* Y = (const bf16_t*)(a.ws + WS_Y); bf16_t* H = (bf16_t*)(a.ws + WS_H); const float* MOD = (const float*)(a.ws + WS_MOD);
    const float* gpost = a.in[6] + (size_t)(l * 6 + gi_post) * D; const float* gpre = a.in[6] + (size_t)(ln * 6 + gi_pre) * D;
    LAS float* GG = (LAS float*)lds; LAS float* G2 = GG + D; LAS float* SH = G2 + D;
    const int per = (M + G - 1) / G, r0 = (int)blockIdx.x * per, r1 = (r0 + per < M) ? r0 + per : M;
    if (r0 >= M) return;
    const int m0 = mod_of_row(r0);
    { const float* gate = MOD + ((size_t)l * 5 + m0) * 18432 + (size_t)mi_gate * D; const float* md = MOD + ((size_t)ln * 5 + m0) * 18432;
      const int c = tid * 4;
      const f32x4 gt = *(const f32x4*)(gate + c), gp = *(const f32x4*)(gpost + c);
      *(LAS f32x4*)(GG + c) = gt * rs * gp;
      if (has_next) { const f32x4 g = *(const f32x4*)(gpre + c), sc = *(const f32x4*)(md + (size_t)mi_scale * D + c), sh = *(const f32x4*)(md + (size_t)mi_shift * D + c);
          *(LAS f32x4*)(G2 + c) = g * (sc + 1.f); *(LAS f32x4*)(SH + c) = sh; } }
    __syncthreads();
#define RC(k) (lane * 8 + ((k) >> 1) * 512 + ((k) & 1) * 4)
#define RN_LOAD(xx, yy, rw) do { _Pragma("unroll") for (int k = 0; k < 8; ++k) xx[k] = *(const f32x4*)(X + (size_t)(rw) * D + RC(k)); \
        if ((rw) < MLAT) { _Pragma("unroll") for (int i = 0; i < 4; ++i) { const u32x4 w = *(const u32x4*)(Y + (size_t)(rw) * D + lane * 8 + i * 512); \
                yy[2 * i] = (f32x4){__uint_as_float(w.x << 16), __uint_as_float(w.x & 0xffff0000u), __uint_as_float(w.y << 16), __uint_as_float(w.y & 0xffff0000u)}; \
                yy[2 * i + 1] = (f32x4){__uint_as_float(w.z << 16), __uint_as_float(w.z & 0xffff0000u), __uint_as_float(w.w << 16), __uint_as_float(w.w & 0xffff0000u)}; } } \
        else { _Pragma("unroll") for (int k = 0; k < 8; ++k) { const float* yp = YP + (size_t)((rw) - MLAT) * D + RC(k); yy[k] = (*(const f32x4*)yp + *(const f32x4*)(yp + (size_t)MCTX * D)) + (*(const f32x4*)(yp + (size_t)2 * MCTX * D) + *(const f32x4*)(yp + (size_t)3 * MCTX * D)); } } } while (0)
    f32x4 y[8], x[8], yn[8], xn[8];
    if (r0 + wid < r1) RN_LOAD(x, y, r0 + wid);
    for (int row = r0 + wid; row < r1; row += 8) {
        const int m = mod_of_row(row); const bool fast = (m == m0);
        const bool more = row + 8 < r1;
        if (more) RN_LOAD(xn, yn, row + 8);
        float ss = 0.f;
#pragma unroll
        for (int i = 0; i < 8; ++i) ss += (y[i][0] * y[i][0] + y[i][1] * y[i][1]) + (y[i][2] * y[i][2] + y[i][3] * y[i][3]);
        ss = wave_sum(ss);
        const float r = rsqrtf(ss * (1.f / 2048.f) + EPS);
        const float* gate = MOD + ((size_t)l * 5 + m) * 18432 + (size_t)mi_gate * D; const float* md = MOD + ((size_t)ln * 5 + m) * 18432;
        float s2 = 0.f;
#pragma unroll
        for (int i = 0; i < 8; ++i) { const int c = RC(i);
            const f32x4 gg = fast ? *(const LAS f32x4*)(GG + c) : *(const f32x4*)(gate + c) * rs * *(const f32x4*)(gpost + c);
            x[i] = x[i] + gg * (y[i] * r);
            if (final_out) *(f32x4*)(a.out + (size_t)row * D + c) = x[i]; else *(f32x4*)(X + (size_t)row * D + c) = x[i];
            s2 += (x[i][0] * x[i][0] + x[i][1] * x[i][1]) + (x[i][2] * x[i][2] + x[i][3] * x[i][3]); }
        if (has_next) {
            s2 = wave_sum(s2);
            const float r2 = rsqrtf(s2 * (1.f / 2048.f) + EPS);
#pragma unroll
            for (int i = 0; i < 4; ++i) { f32x4 h[2];
#pragma unroll
                for (int hh = 0; hh < 2; ++hh) { const int k = 2 * i + hh, c = RC(k);
                    const f32x4 g2 = fast ? *(const LAS f32x4*)(G2 + c) : *(const f32x4*)(gpre + c) * (*(const f32x4*)(md + (size_t)mi_scale * D + c) + 1.f);
                    const f32x4 sh = fast ? *(const LAS f32x4*)(SH + c) : *(const f32x4*)(md + (size_t)mi_shift * D + c);
                    h[hh] = x[k] * r2 * g2 + sh; }
                u32x4 w; w.x = cvt_pk_bf16(h[0][0], h[0][1]); w.y = cvt_pk_bf16(h[0][2], h[0][3]); w.z = cvt_pk_bf16(h[1][0], h[1][1]); w.w = cvt_pk_bf16(h[1][2], h[1][3]);
                *(u32x4*)(H + (size_t)row * D + lane * 8 + i * 512) = w; } }
        if (more) {
#pragma unroll
            for (int i = 0; i < 8; ++i) { x[i] = xn[i]; y[i] = yn[i]; } }
    }
#undef RC
#undef RN_LOAD
    __syncthreads();
}

struct EpiF32 {
    static constexpr bool PERM = false, AFTER_DRAIN = false;
    float* C; int ldc;
    __device__ __forceinline__ void operator()(const f32x4 (&acc)[2][2][4][2], const Unit& u, int wr, int wc, int fr, int fq) const {
        const int row0 = u.pm * BM + wr * 64 + fr, col0 = u.pn * BM + wc * 32 + 4 * fq;
#pragma unroll
        for (int ai = 0; ai < 2; ++ai)
#pragma unroll
            for (int m = 0; m < 4; ++m) { float* rowp = C + (size_t)(row0 + ai * HALF + m * 16) * ldc + col0;
#pragma unroll
                for (int bj = 0; bj < 2; ++bj)
#pragma unroll
                    for (int n = 0; n < 2; ++n) *(f32x4*)(rowp + bj * HALF + n * 16) = acc[ai][bj][m][n]; }
    }
};
struct EpiSwiGLU {
    static constexpr bool PERM = true, AFTER_DRAIN = false;
    bf16_t* O; int ldc;
    __device__ __forceinline__ void operator()(const f32x4 (&acc)[2][2][4][2], const Unit& u, int wr, int wc, int fr, int fq) const {
        const int row0 = u.pm * BM + wr * 64 + fr, col0 = u.pn * 128 + wc * 32 + 8 * fq;
#pragma unroll
        for (int ai = 0; ai < 2; ++ai)
#pragma unroll
            for (int m = 0; m < 4; ++m) { bf16_t* rowp = O + (size_t)(row0 + ai * HALF + m * 16) * ldc + col0; float v[8];
#pragma unroll
                for (int n = 0; n < 2; ++n)
#pragma unroll
                    for (int j = 0; j < 4; ++j) v[4 * n + j] = siluf(acc[ai][0][m][n][j]) * acc[ai][1][m][n][j];
                u32x4 w; w.x = cvt_pk_bf16(v[0], v[1]); w.y = cvt_pk_bf16(v[2], v[3]); w.z = cvt_pk_bf16(v[4], v[5]); w.w = cvt_pk_bf16(v[6], v[7]);
                *(u32x4*)rowp = w; }
    }
};
struct EpiBf16 {
    static constexpr bool PERM = true, AFTER_DRAIN = false;
    bf16_t* O; int ldc;
    __device__ __forceinline__ void operator()(const f32x4 (&acc)[2][2][4][2], const Unit& u, int wr, int wc, int fr, int fq) const {
        const int row0 = u.pm * BM + wr * 64 + fr, col0 = u.pn * BM + wc * 32 + 8 * fq;
#pragma unroll
        for (int ai = 0; ai < 2; ++ai)
#pragma unroll
            for (int m = 0; m < 4; ++m) { bf16_t* rowp = O + (size_t)(row0 + ai * HALF + m * 16) * ldc + col0;
#pragma unroll
                for (int bj = 0; bj < 2; ++bj) { const f32x4 v0 = acc[ai][bj][m][0], v1 = acc[ai][bj][m][1];
                    u32x4 w; w.x = cvt_pk_bf16(v0[0], v0[1]); w.y = cvt_pk_bf16(v0[2], v0[3]); w.z = cvt_pk_bf16(v1[0], v1[1]); w.w = cvt_pk_bf16(v1[2], v1[3]);
                    *(u32x4*)(rowp + bj * HALF) = w; } }
    }
};

template <class Epi>
__device__ __forceinline__ void run_gemm(LAS unsigned char* lds, const bf16_t* A, const bf16_t* Bt, int M, int N, int K, const Epi& E, int rot, int ld = 0, int msplit = 0, int gsub = 0, int csub = 0) {
    Gemm g; g.A = A; g.Bt = Bt; g.M = M; g.N = N; g.K = K; g.ld = ld ? ld : K; g.msplit = msplit;
    StaticOrder S; const int G = gridDim.x; if (gsub) S.init(M, N, gsub, csub); else S.init(M, N, G, (int)((blockIdx.x + rot) % G));
    gemm_phase<Epi, StaticOrder, false>(lds, g, S, E, nullptr);
    __syncthreads();
}

__device__ __forceinline__ void phase_prep(const Args& a, int l) {
    const int lane = threadIdx.x & 63, gw = blockIdx.x * 8 + (threadIdx.x >> 6), nw = gridDim.x * 8;
    const bf16_t* P = (const bf16_t*)(a.ws + WS_P); const f32x2* tab = (const f32x2*)(a.ws + WS_TAB);
    float* QR = (float*)(a.ws + WS_QR);
    bf16_t* CQN = (bf16_t*)(a.ws + WS_CQN); bf16_t* CKVN = (bf16_t*)(a.ws + WS_CKVN); bf16_t* KB = (bf16_t*)(a.ws + WS_KB);
    const float* qn = a.in[19] + l * 512; const float* kvn = a.in[21] + l * 256;
    const int i = lane & 31;
    for (int row0 = gw; row0 < MR; row0 += 2 * nw) {
        float q1[2][3], q2[2][3], k1[2], k2[2], cs[2], sn[2]; f32x4 cq0[2], cq1[2], ckv[2]; int rw[2]; bool ok[2];
#pragma unroll
        for (int s2 = 0; s2 < 2; ++s2) { const int r = row0 + s2 * nw; ok[s2] = r < MR; rw[s2] = ok[s2] ? r : row0;
            const int row = rw[s2]; const bool latent = row < MLAT; const int t = latent ? (row & 2047) : 0;
            const bf16_t* pr = P + (size_t)row * INWP;
            const f32x2 cv = tab[t * 32 + i]; cs[s2] = latent ? cv.x : 1.f; sn[s2] = latent ? cv.y : 0.f;
#pragma unroll
            for (int j = 0; j < 3; ++j) { const int hh = (lane >> 5) + 2 * j; q1[s2][j] = bf2f(pr[OFF_RQ + hh * 64 + i]); q2[s2][j] = bf2f(pr[OFF_RQ + hh * 64 + 32 + i]); }
            cq0[s2] = ld_bf4(pr + OFF_CQ + lane * 4); cq1[s2] = ld_bf4(pr + OFF_CQ + 256 + lane * 4); ckv[s2] = ld_bf4(pr + OFF_CKV + lane * 4);
            k1[s2] = bf2f(pr[OFF_KR + i]); k2[s2] = bf2f(pr[OFF_KR + 32 + i]); }
#pragma unroll
        for (int s2 = 0; s2 < 2; ++s2) { if (!ok[s2]) continue;
            const int row = rw[s2]; const bool latent = row < MLAT;
            const int b = latent ? (row >> 11) : ((row - MLAT) >> 8), t = latent ? (row & 2047) : ((row - MLAT) & 255), ki = latent ? 256 + t : t;
#pragma unroll
            for (int j = 0; j < 3; ++j) { const int hh = (lane >> 5) + 2 * j;
                QR[(size_t)row * 384 + hh * 64 + i] = q1[s2][j] * cs[s2] - q2[s2][j] * sn[s2]; QR[(size_t)row * 384 + hh * 64 + 32 + i] = q1[s2][j] * sn[s2] + q2[s2][j] * cs[s2]; }
            { f32x4 v0 = cq0[s2], v1 = cq1[s2];
              float ss = (v0[0] * v0[0] + v0[1] * v0[1]) + (v0[2] * v0[2] + v0[3] * v0[3]) + (v1[0] * v1[0] + v1[1] * v1[1]) + (v1[2] * v1[2] + v1[3] * v1[3]);
              ss = wave_sum(ss); const float r = rsqrtf(ss * (1.f / 512.f) + EPS);
              const f32x4 g0 = *(const f32x4*)(qn + lane * 4), g1 = *(const f32x4*)(qn + 256 + lane * 4);
              v0 = v0 * r * g0; v1 = v1 * r * g1;
              u32x2 w; w.x = cvt_pk_bf16(v0[0], v0[1]); w.y = cvt_pk_bf16(v0[2], v0[3]); *(u32x2*)(CQN + (size_t)row * 512 + lane * 4) = w;
              w.x = cvt_pk_bf16(v1[0], v1[1]); w.y = cvt_pk_bf16(v1[2], v1[3]); *(u32x2*)(CQN + (size_t)row * 512 + 256 + lane * 4) = w; }
            { f32x4 v0 = ckv[s2];
              float ss = (v0[0] * v0[0] + v0[1] * v0[1]) + (v0[2] * v0[2] + v0[3] * v0[3]);
              ss = wave_sum(ss); const float r = rsqrtf(ss * (1.f / 256.f) + EPS);
              const f32x4 g0 = *(const f32x4*)(kvn + lane * 4);
              v0 = v0 * r * g0;
              u32x2 w; w.x = cvt_pk_bf16(v0[0], v0[1]); w.y = cvt_pk_bf16(v0[2], v0[3]); *(u32x2*)(CKVN + (size_t)row * 256 + lane * 4) = w; }
            { const bf16_t o1 = f2bf(k1[s2] * cs[s2] - k2[s2] * sn[s2]), o2 = f2bf(k1[s2] * sn[s2] + k2[s2] * cs[s2]);
              const int h0 = (lane >> 5) * 3;
#pragma unroll
              for (int hh = 0; hh < 3; ++hh) { bf16_t* kp = KB + ((size_t)(b * 6 + h0 + hh) * NKEY + ki) * 192; kp[128 + i] = o1; kp[160 + i] = o2; } } }
    }
}

__device__ __forceinline__ void phase_conv(const Args& a, int l, LAS unsigned char* lds) {
    const int tid = threadIdx.x, lane = tid & 63, wid = tid >> 6;
    const bf16_t* PG = (const bf16_t*)(a.ws + WS_PG); bf16_t* CVN = (bf16_t*)(a.ws + WS_CVN);
    LAS float* red = (LAS float*)lds;
    LAS float* fin = (LAS float*)(lds + 1024);
    float dwc[31];
#pragma unroll
    for (int w = 0; w < 31; ++w) dwc[w] = a.in[14][(size_t)(l * 31 + w) * 512 + tid];
    const float bias = a.in[15][l * 512 + tid], lg = a.in[16][l * 512 + tid], lb = a.in[17][l * 512 + tid];
    for (int it = gridDim.x - 1 - blockIdx.x; it < MR / 16; it += gridDim.x) {
        const int row0 = it * 16;
        int s0, s1; if (row0 < MLAT) { s0 = (row0 >> 11) << 11; s1 = s0 + 2048; } else { s0 = MLAT + (((row0 - MLAT) >> 8) << 8); s1 = s0 + 256; }
        float acc[16], rv[32];
#pragma unroll
        for (int j = 0; j < 16; ++j) acc[j] = bias;
#pragma unroll
        for (int i = 0; i < 46; ++i) { const int r = row0 - 15 + i; const bool ok = (r >= s0 && r < s1); const int rc = ok ? r : row0;
            const float av = bf2f(PG[(size_t)rc * GLUW + tid]), gv = bf2f(PG[(size_t)rc * GLUW + 512 + tid]);
            const float u = ok ? av * sigmf(gv) : 0.f;
#pragma unroll
            for (int j = 0; j < 16; ++j) { const int w = i - j; if (w >= 0 && w <= 30) acc[j] += u * dwc[w]; } }
#pragma unroll
        for (int j = 0; j < 16; ++j) { rv[2 * j] = acc[j]; rv[2 * j + 1] = acc[j] * acc[j]; }
#pragma unroll
        for (int k = 0; k < 16; ++k) { const bool up = (lane & 32) != 0; const float keep = up ? rv[k + 16] : rv[k], send = up ? rv[k] : rv[k + 16]; rv[k] = keep + __shfl_xor(send, 32); }
#pragma unroll
        for (int k = 0; k < 8; ++k) { const bool up = (lane & 16) != 0; const float keep = up ? rv[k + 8] : rv[k], send = up ? rv[k] : rv[k + 8]; rv[k] = keep + __shfl_xor(send, 16); }
#pragma unroll
        for (int k = 0; k < 4; ++k) { const bool up = (lane & 8) != 0; const float keep = up ? rv[k + 4] : rv[k], send = up ? rv[k] : rv[k + 4]; rv[k] = keep + __shfl_xor(send, 8); }
#pragma unroll
        for (int k = 0; k < 2; ++k) { const bool up = (lane & 4) != 0; const float keep = up ? rv[k + 2] : rv[k], send = up ? rv[k] : rv[k + 2]; rv[k] = keep + __shfl_xor(send, 4); }
        { const bool up = (lane & 2) != 0; const float keep = up ? rv[1] : rv[0], send = up ? rv[0] : rv[1]; rv[0] = keep + __shfl_xor(send, 2); }
        rv[0] += __shfl_xor(rv[0], 1);
        if ((lane & 1) == 0) red[wid * 32 + (lane >> 1)] = rv[0];
        __syncthreads();
        if (tid < 32) { float s = 0.f;
#pragma unroll
            for (int w = 0; w < 8; ++w) s += red[w * 32 + tid];
            fin[tid] = s; }
        __syncthreads();
#pragma unroll
        for (int j = 0; j < 16; ++j) { const float mean = fin[2 * j] * (1.f / 512.f), var = fin[2 * j + 1] * (1.f / 512.f) - mean * mean;
            const float y = (acc[j] - mean) * rsqrtf(fmaxf(var, 0.f) + EPS) * lg + lb;
            CVN[(size_t)(row0 + j) * 512 + tid] = f2bf(siluf(y)); }
        __syncthreads();
    }
}

__device__ __forceinline__ void phase_ret_local(const Args& a, LAS unsigned char* lds) {
    const int tid = threadIdx.x;
    const bf16_t* P = (const bf16_t*)(a.ws + WS_P); const f32x2* tab = (const f32x2*)(a.ws + WS_TAB);
    float* SF = (float*)(a.ws + WS_SF); float* SB = (float*)(a.ws + WS_SB);
    LAS float* kl = (LAS float*)lds;
    LAS float* vl = kl + 128 * 64;
    LAS float* wl = vl + 128 * 128;
    for (int it = blockIdx.x; it < 24 * NCH; it += gridDim.x) {
        const int cidx = it % NCH, bh = it / NCH, b = bh / 6, h = bh % 6;
        const bool latent = cidx >= 2;
        const int rowbase = latent ? b * 2048 + (cidx - 2) * 128 : MLAT + b * 256 + cidx * 128, t0 = latent ? (cidx - 2) * 128 : 0;
        const float l2g = log2f(1.f - exp2f(-5.f - (float)h));
#pragma unroll
        for (int j = 0; j < 8; ++j) { const int idx = tid + 512 * j, t = idx >> 5, i = idx & 31;
            const float x1 = bf2f(P[(size_t)(rowbase + t) * INWP + OFF_RK + h * 64 + i]), x2 = bf2f(P[(size_t)(rowbase + t) * INWP + OFF_RK + h * 64 + 32 + i]);
            float cs, sn; rope_cs(tab, i, t0 + t, latent, cs, sn);
            kl[t * 64 + i] = (x1 * cs - x2 * sn) * 0.125f; kl[t * 64 + 32 + i] = (x1 * sn + x2 * cs) * 0.125f; }
#pragma unroll
        for (int ii = 0; ii < 8; ++ii) { const int idx = tid + 512 * ii, j = idx >> 5, c4 = idx & 31;
            *(LAS f32x4*)(vl + j * 128 + c4 * 4) = ld_bf4(P + (size_t)(rowbase + j) * INWP + OFF_RV + h * 128 + c4 * 4); }
        if (tid < 256) { const int t = tid & 127; wl[tid] = exp2f(l2g * (float)(tid < 128 ? 127 - t : t)); }
        __syncthreads();
        { const int lane = tid & 63, wid = tid >> 6, fr = lane & 15, fq = lane >> 4;
          f32x4 accF[4], accB[4];
#pragma unroll
          for (int db = 0; db < 4; ++db) { accF[db] = (f32x4){0.f, 0.f, 0.f, 0.f}; accB[db] = (f32x4){0.f, 0.f, 0.f, 0.f}; }
#pragma unroll
          for (int ks = 0; ks < 4; ++ks) { const int t0q = ks * 32 + fq * 8; float vv[8], wfv[8], wbv[8];
#pragma unroll
              for (int j = 0; j < 8; ++j) { vv[j] = vl[(t0q + j) * 128 + wid * 16 + fr]; wfv[j] = wl[t0q + j]; wbv[j] = wl[128 + t0q + j]; }
              u32x4 w; w.x = cvt_pk_bf16(vv[0], vv[1]); w.y = cvt_pk_bf16(vv[2], vv[3]); w.z = cvt_pk_bf16(vv[4], vv[5]); w.w = cvt_pk_bf16(vv[6], vv[7]);
              const bf16x8 vb = __builtin_bit_cast(bf16x8, w);
#pragma unroll
              for (int db = 0; db < 4; ++db) { float kk[8];
#pragma unroll
                  for (int j = 0; j < 8; ++j) kk[j] = kl[(t0q + j) * 64 + db * 16 + fr];
                  w.x = cvt_pk_bf16(kk[0] * wfv[0], kk[1] * wfv[1]); w.y = cvt_pk_bf16(kk[2] * wfv[2], kk[3] * wfv[3]); w.z = cvt_pk_bf16(kk[4] * wfv[4], kk[5] * wfv[5]); w.w = cvt_pk_bf16(kk[6] * wfv[6], kk[7] * wfv[7]);
                  accF[db] = __builtin_amdgcn_mfma_f32_16x16x32_bf16(__builtin_bit_cast(bf16x8, w), vb, accF[db], 0, 0, 0);
                  w.x = cvt_pk_bf16(kk[0] * wbv[0], kk[1] * wbv[1]); w.y = cvt_pk_bf16(kk[2] * wbv[2], kk[3] * wbv[3]); w.z = cvt_pk_bf16(kk[4] * wbv[4], kk[5] * wbv[5]); w.w = cvt_pk_bf16(kk[6] * wbv[6], kk[7] * wbv[7]);
                  accB[db] = __builtin_amdgcn_mfma_f32_16x16x32_bf16(__builtin_bit_cast(bf16x8, w), vb, accB[db], 0, 0, 0); } }
          float* fo = SF + ((size_t)bh * NCH + cidx) * 8192 + (wid * 16 + fr) * 64 + fq * 4; float* go = SB + ((size_t)bh * NCH + cidx) * 8192 + (wid * 16 + fr) * 64 + fq * 4;
#pragma unroll
          for (int db = 0; db < 4; ++db) { *(f32x4*)(fo + db * 16) = accF[db]; *(f32x4*)(go + db * 16) = accB[db]; } }
        { bf16_t* rk = (bf16_t*)(a.ws + WS_RKB) + ((size_t)bh * NCH + cidx) * 8192; const int tok = tid >> 2, d0 = (tid & 3) * 16;
#pragma unroll
          for (int hq = 0; hq < 2; ++hq) { const f32x4 x0 = *(const LAS f32x4*)(kl + tok * 64 + d0 + hq * 8), x1 = *(const LAS f32x4*)(kl + tok * 64 + d0 + hq * 8 + 4);
              u32x4 w; w.x = cvt_pk_bf16(x0[0], x0[1]); w.y = cvt_pk_bf16(x0[2], x0[3]); w.z = cvt_pk_bf16(x1[0], x1[1]); w.w = cvt_pk_bf16(x1[2], x1[3]);
              *(u32x4*)(rk + tok * 64 + d0 + hq * 8) = w; } }
        { bf16_t* rv = (bf16_t*)(a.ws + WS_RVT) + ((size_t)bh * NCH + cidx) * 16384; const int dv = tid & 127, tg = tid >> 7;
#pragma unroll
          for (int i = 0; i < 4; ++i) { const int t0q = tg * 32 + i * 8; float x[8];
#pragma unroll
              for (int j = 0; j < 8; ++j) x[j] = vl[(t0q + j) * 128 + dv];
              u32x4 w; w.x = cvt_pk_bf16(x[0], x[1]); w.y = cvt_pk_bf16(x[2], x[3]); w.z = cvt_pk_bf16(x[4], x[5]); w.w = cvt_pk_bf16(x[6], x[7]);
              *(u32x4*)(rv + dv * 128 + t0q) = w; } }
        __syncthreads();
    }
}
__device__ __forceinline__ void phase_ret_combine(const Args& a) {
    for (int e = blockIdx.x * NTHR + threadIdx.x; e < 24 * 2 * 2048; e += gridDim.x * NTHR) {
        const int q = e & 2047, bhd = e >> 11, dir = bhd & 1, bh = bhd >> 1, h = bh % 6;
        const float gC = exp2f(128.f * log2f(1.f - exp2f(-5.f - (float)h)));
        float* base = (float*)(a.ws + (dir ? WS_SB : WS_SF)) + (size_t)bh * NCH * 8192 + q * 4;
        f32x4 F[NCH];
#pragma unroll
        for (int c = 0; c < NCH; ++c) F[c] = *(const f32x4*)(base + (size_t)c * 8192);
        f32x4 S = {0.f, 0.f, 0.f, 0.f};
        if (dir == 0) {
#pragma unroll
            for (int c = 0; c < NCH; ++c) { *(f32x4*)(base + (size_t)c * 8192) = S; S = S * gC + F[c]; }
        } else {
#pragma unroll
            for (int st = 0; st < NCH; ++st) { const int c = st < 2 ? 1 - st : 19 - st; *(f32x4*)(base + (size_t)c * 8192) = S; S = S * gC + F[c]; }
        }
    }
}

constexpr int RK_STRIDE = 144, RV_STRIDE = 272;
__device__ __forceinline__ void phase_ret_out(const Args& a, int l, LAS unsigned char* lds) {
    const int tid = threadIdx.x, lane = tid & 63, wid = tid >> 6, fr = lane & 15, fq = lane >> 4;
    const bf16_t* P = (const bf16_t*)(a.ws + WS_P); const float* QR = (const float*)(a.ws + WS_QR);
    const float* SF = (const float*)(a.ws + WS_SF); const float* SB = (const float*)(a.ws + WS_SB); bf16_t* CAT = (bf16_t*)(a.ws + WS_CAT);
    LAS unsigned char* Kb = lds;
    LAS unsigned char* Vt = Kb + 128 * RK_STRIDE;
    LAS unsigned char* St = Vt + 128 * RV_STRIDE;
    const int nch = (l == 0) ? 18 : 16, nitem = 24 * nch;
    for (int it = blockIdx.x; it < nitem; it += gridDim.x) {
        const int c = it % nch, bh = it / nch, cidx = c + (18 - nch), b = bh / 6, h = bh % 6;
        const int rowbase = cidx < 2 ? MLAT + b * 256 + cidx * 128 : b * 2048 + (cidx - 2) * 128;
        const float l2g = log2f(1.f - exp2f(-5.f - (float)h));
        { const bf16_t* rk = (const bf16_t*)(a.ws + WS_RKB) + ((size_t)bh * NCH + cidx) * 8192;
          const bf16_t* rv = (const bf16_t*)(a.ws + WS_RVT) + ((size_t)bh * NCH + cidx) * 16384;
          const float* sf = SF + ((size_t)bh * NCH + cidx) * 8192; const float* sb = SB + ((size_t)bh * NCH + cidx) * 8192;
#pragma unroll
          for (int i = 0; i < 2; ++i) { const int idx = tid + 512 * i, r = idx >> 3, cc = idx & 7; *(LAS u32x4*)(Kb + r * RK_STRIDE + cc * 16) = *(const u32x4*)(rk + r * 64 + cc * 8); }
#pragma unroll
          for (int i = 0; i < 4; ++i) { const int idx = tid + 512 * i, r = idx >> 4, cc = idx & 15; *(LAS u32x4*)(Vt + r * RV_STRIDE + cc * 16) = *(const u32x4*)(rv + r * 128 + cc * 8); }
#pragma unroll
          for (int i = 0; i < 4; ++i) { const int idx = tid + 512 * i, r = idx >> 4, c4 = idx & 15;
              const f32x4 f4 = *(const f32x4*)(sf + r * 64 + c4 * 4), b4 = *(const f32x4*)(sb + r * 64 + c4 * 4);
              u32x2 w; w.x = cvt_pk_bf16(f4[0], f4[1]); w.y = cvt_pk_bf16(f4[2], f4[3]); *(LAS u32x2*)(St + r * RV_STRIDE + c4 * 8) = w;
              w.x = cvt_pk_bf16(b4[0], b4[1]); w.y = cvt_pk_bf16(b4[2], b4[3]); *(LAS u32x2*)(St + r * RV_STRIDE + 128 + c4 * 8) = w; } }
        const int il = wid * 16 + fr, row = rowbase + il;
        f32x4 qv[2][2];
#pragma unroll
        for (int ks = 0; ks < 2; ++ks) { qv[ks][0] = *(const f32x4*)(QR + (size_t)row * 384 + h * 64 + ks * 32 + fq * 8); qv[ks][1] = *(const f32x4*)(QR + (size_t)row * 384 + h * 64 + ks * 32 + fq * 8 + 4); }
        const float wf = exp2f(l2g * (float)(il + 1)), wb = exp2f(l2g * (float)(128 - il));
        bf16x8 qb[2], qw[4];
#pragma unroll
        for (int ks = 0; ks < 2; ++ks) { const f32x4 x0 = qv[ks][0], x1 = qv[ks][1]; u32x4 w;
            w.x = cvt_pk_bf16(x0[0], x0[1]); w.y = cvt_pk_bf16(x0[2], x0[3]); w.z = cvt_pk_bf16(x1[0], x1[1]); w.w = cvt_pk_bf16(x1[2], x1[3]); qb[ks] = __builtin_bit_cast(bf16x8, w);
            const f32x4 y0 = x0 * wf, y1 = x1 * wf, z0 = x0 * wb, z1 = x1 * wb;
            w.x = cvt_pk_bf16(y0[0], y0[1]); w.y = cvt_pk_bf16(y0[2], y0[3]); w.z = cvt_pk_bf16(y1[0], y1[1]); w.w = cvt_pk_bf16(y1[2], y1[3]); qw[ks] = __builtin_bit_cast(bf16x8, w);
            w.x = cvt_pk_bf16(z0[0], z0[1]); w.y = cvt_pk_bf16(z0[2], z0[3]); w.z = cvt_pk_bf16(z1[0], z1[1]); w.w = cvt_pk_bf16(z1[2], z1[3]); qw[2 + ks] = __builtin_bit_cast(bf16x8, w); }
        __syncthreads();
        bf16x8 pf[4];
#pragma unroll
        for (int p = 0; p < 4; ++p) { f32x4 s0 = {0.f, 0.f, 0.f, 0.f}, s1 = {0.f, 0.f, 0.f, 0.f};
            const int kr0 = p * 32 + (fr >> 2) * 8 + (fr & 3);
#pragma unroll
            for (int ks = 0; ks < 2; ++ks) { const bf16x8 k0 = *(const LAS bf16x8*)(Kb + kr0 * RK_STRIDE + ks * 64 + fq * 16), k1 = *(const LAS bf16x8*)(Kb + (kr0 + 4) * RK_STRIDE + ks * 64 + fq * 16);
                s0 = __builtin_amdgcn_mfma_f32_16x16x32_bf16(k0, qb[ks], s0, 0, 0, 0); s1 = __builtin_amdgcn_mfma_f32_16x16x32_bf16(k1, qb[ks], s1, 0, 0, 0); }
#pragma unroll
            for (int j = 0; j < 4; ++j) { const int k0i = p * 32 + fq * 8 + j, k1i = k0i + 4; const int d0 = il > k0i ? il - k0i : k0i - il, d1 = il > k1i ? il - k1i : k1i - il;
                s0[j] *= exp2f(l2g * (float)d0); s1[j] *= exp2f(l2g * (float)d1); }
            u32x4 w; w.x = cvt_pk_bf16(s0[0], s0[1]); w.y = cvt_pk_bf16(s0[2], s0[3]); w.z = cvt_pk_bf16(s1[0], s1[1]); w.w = cvt_pk_bf16(s1[2], s1[3]); pf[p] = __builtin_bit_cast(bf16x8, w); }
        f32x4 o[8];
#pragma unroll
        for (int db = 0; db < 8; ++db) o[db] = (f32x4){0.f, 0.f, 0.f, 0.f};
#pragma unroll
        for (int p = 0; p < 4; ++p)
#pragma unroll
            for (int db = 0; db < 8; ++db) { const bf16x8 vf = *(const LAS bf16x8*)(Vt + (db * 16 + fr) * RV_STRIDE + p * 64 + fq * 16), sfr = *(const LAS bf16x8*)(St + (db * 16 + fr) * RV_STRIDE + p * 64 + fq * 16);
                o[db] = __builtin_amdgcn_mfma_f32_16x16x32_bf16(vf, pf[p], o[db], 0, 0, 0);
                o[db] = __builtin_amdgcn_mfma_f32_16x16x32_bf16(sfr, qw[p], o[db], 0, 0, 0); }
        float sm = 0.f;
#pragma unroll
        for (int db = 0; db < 8; ++db) sm += (o[db][0] + o[db][1]) + (o[db][2] + o[db][3]);
        sm += __shfl_xor(sm, 16); sm += __shfl_xor(sm, 32);
        const float mu = sm * (1.f / 128.f); float qd = 0.f;
#pragma unroll
        for (int db = 0; db < 8; ++db) { o[db] = o[db] - mu; qd += (o[db][0] * o[db][0] + o[db][1] * o[db][1]) + (o[db][2] * o[db][2] + o[db][3] * o[db][3]); }
        qd += __shfl_xor(qd, 16); qd += __shfl_xor(qd, 32);
        const float rstd = rsqrtf(qd * (1.f / 128.f) + EPS);
#pragma unroll
        for (int db = 0; db < 8; ++db) { const int cc = h * 128 + db * 16 + fq * 4;
            const f32x4 rg = ld_bf4(P + (size_t)row * INWP + OFF_RG + cc), gn4 = *(const f32x4*)(a.in[13] + l * 768 + cc); float v[4];
#pragma unroll
            for (int e = 0; e < 4; ++e) v[e] = siluf(rg[e]) * (o[db][e] * rstd * gn4[e]);
            u32x2 w; w.x = cvt_pk_bf16(v[0], v[1]); w.y = cvt_pk_bf16(v[2], v[3]);
            *(u32x2*)(CAT + (size_t)row * D + cc) = w; }
        __syncthreads();
    }
}

__device__ __forceinline__ void phase_post(const Args& a) {
    const int lane = threadIdx.x & 63, gw = blockIdx.x * 8 + (threadIdx.x >> 6), nw = gridDim.x * 8;
    const bf16_t* QF = (const bf16_t*)(a.ws + WS_QF); const bf16_t* KVF = (const bf16_t*)(a.ws + WS_KVF);
    bf16_t* QB = (bf16_t*)(a.ws + WS_QB); bf16_t* KB = (bf16_t*)(a.ws + WS_KB); bf16_t* VT = (bf16_t*)(a.ws + WS_VT);
    const float qscale = 0.07216878364870322f * 1.4426950408889634f;
    for (int wi = gw; wi < MR / 8; wi += nw) {
        const int r0 = wi * 8; const bool latent = r0 < MLAT;
        const int b = latent ? (r0 >> 11) : ((r0 - MLAT) >> 8), t0 = latent ? (r0 & 2047) : ((r0 - MLAT) & 255), ki0 = latent ? 256 + t0 : t0;
        const int i = lane & 31; const f32x2* tab = (const f32x2*)(a.ws + WS_TAB);
        for (int r4 = 0; r4 < 8; r4 += 4) {
            u32x2 qraw[4][3], kraw[4][3]; float x1[4][3], x2[4][3], cs[4], sn[4];
#pragma unroll
            for (int rr = 0; rr < 4; ++rr) { const int row = r0 + r4 + rr, t = t0 + r4 + rr;
                const f32x2 cv = tab[(latent ? t : 0) * 32 + i]; cs[rr] = latent ? cv.x : 1.f; sn[rr] = latent ? cv.y : 0.f;
#pragma unroll
                for (int ii = 0; ii < 3; ++ii) { const int idx = lane * 4 + ii * 256, hh = idx >> 7, dd = idx & 127;
                    qraw[rr][ii] = *(const u32x2*)(QF + (size_t)row * 1280 + hh * 192 + dd); kraw[rr][ii] = *(const u32x2*)(KVF + (size_t)row * 1536 + hh * 256 + dd); }
#pragma unroll
                for (int j = 0; j < 3; ++j) { const int hh = (lane >> 5) + 2 * j; x1[rr][j] = bf2f(QF[(size_t)row * 1280 + hh * 192 + 128 + i]); x2[rr][j] = bf2f(QF[(size_t)row * 1280 + hh * 192 + 160 + i]); } }
#pragma unroll
            for (int rr = 0; rr < 4; ++rr) { const int ki = ki0 + r4 + rr;
#pragma unroll
                for (int ii = 0; ii < 3; ++ii) { const int idx = lane * 4 + ii * 256, hh = idx >> 7, dd = idx & 127;
                    const u32x2 qw = qraw[rr][ii];
                    const f32x4 q4 = (f32x4){__uint_as_float(qw.x << 16), __uint_as_float(qw.x & 0xffff0000u), __uint_as_float(qw.y << 16), __uint_as_float(qw.y & 0xffff0000u)} * qscale;
                    u32x2 w; w.x = cvt_pk_bf16(q4[0], q4[1]); w.y = cvt_pk_bf16(q4[2], q4[3]);
                    *(u32x2*)(QB + ((size_t)(b * 6 + hh) * NKEY + ki) * 192 + dd) = w;
                    *(u32x2*)(KB + ((size_t)(b * 6 + hh) * NKEY + ki) * 192 + dd) = kraw[rr][ii]; }
#pragma unroll
                for (int j = 0; j < 3; ++j) { const int hh = (lane >> 5) + 2 * j;
                    bf16_t* qp = QB + ((size_t)(b * 6 + hh) * NKEY + ki) * 192;
                    qp[128 + i] = f2bf((x1[rr][j] * cs[rr] - x2[rr][j] * sn[rr]) * qscale); qp[160 + i] = f2bf((x1[rr][j] * sn[rr] + x2[rr][j] * cs[rr]) * qscale); } } }
#pragma unroll 4
        for (int ii = 0; ii < 12; ++ii) { const int hd = lane + 64 * ii, hh = hd >> 7, dv = hd & 127; bf16_t v[8];
#pragma unroll
            for (int rr = 0; rr < 8; ++rr) v[rr] = KVF[(size_t)(r0 + rr) * 1536 + hh * 256 + 128 + dv];
            u32x4 w; w.x = (unsigned)v[0] | ((unsigned)v[1] << 16); w.y = (unsigned)v[2] | ((unsigned)v[3] << 16); w.z = (unsigned)v[4] | ((unsigned)v[5] << 16); w.w = (unsigned)v[6] | ((unsigned)v[7] << 16);
            *(u32x4*)(VT + (((size_t)(b * 6 + hh) * 36 + (ki0 >> 6)) * 128 + dv) * 64 + (ki0 & 63)) = w; }
    }
}

constexpr int KS_STRIDE = 400, VS_STRIDE = 144, KS_BYTES = 64 * KS_STRIDE, VS_BYTES = 128 * VS_STRIDE, ATT_BUF = KS_BYTES + VS_BYTES;
__device__ __forceinline__ void phase_attn(const Args& a, int l, LAS unsigned char* lds) {
    const int tid = threadIdx.x, lane = tid & 63, wid = tid >> 6, fr = lane & 15, fq = lane >> 4;
    const bf16_t* QB = (const bf16_t*)(a.ws + WS_QB); const bf16_t* KB = (const bf16_t*)(a.ws + WS_KB); const bf16_t* VT = (const bf16_t*)(a.ws + WS_VT);
    bf16_t* CAT = (bf16_t*)(a.ws + WS_CAT);
    LAS unsigned char* kring = lds; LAS unsigned char* vring = lds + 2 * KS_BYTES;
    const int nqt = (l == 0) ? 9 : 8, nitem = 24 * nqt;
    for (int it = blockIdx.x; it < nitem; it += gridDim.x) {
        const int bh = it % 24, qi = it / 24, qt = (l == 0) ? (qi == 8 ? 0 : qi + 1) : qi + 1, b = bh / 6, h = bh % 6;
        const int nk = (qt == 0) ? 256 : NKEY, ntile = nk / 64;
        const bf16_t* kbase = KB + (size_t)bh * NKEY * 192; const bf16_t* vbase = VT + (size_t)bh * 128 * NKEY; const bf16_t* qbase = QB + (size_t)bh * NKEY * 192;
        const int q0 = qt * 256 + wid * 32;
        bf16x8 qf[2][6];
#pragma unroll
        for (int g = 0; g < 2; ++g)
#pragma unroll
            for (int ks = 0; ks < 6; ++ks) qf[g][ks] = *(const bf16x8*)(qbase + (size_t)(q0 + g * 16 + fr) * 192 + ks * 32 + fq * 8);
        f32x4 o[8][2];
#pragma unroll
        for (int db = 0; db < 8; ++db) { o[db][0] = (f32x4){0.f, 0.f, 0.f, 0.f}; o[db][1] = (f32x4){0.f, 0.f, 0.f, 0.f}; }
        float mrun[2] = {-1e30f, -1e30f}, lrun[2] = {0.f, 0.f};
        u32x4 kst[3], vst[2];
#define AT_KLOAD(tile) do { const bf16_t* kp_ = kbase + (size_t)(tile) * (64 * 192) + tid * 8; _Pragma("unroll") for (int i = 0; i < 3; ++i) kst[i] = *(const u32x4*)(kp_ + i * 4096); } while (0)
#define AT_VLOAD(tile) do { const bf16_t* vp_ = vbase + (size_t)(tile) * (128 * 64) + tid * 8; _Pragma("unroll") for (int i = 0; i < 2; ++i) vst[i] = *(const u32x4*)(vp_ + i * 4096); } while (0)
#define AT_KSTORE(buf) do { LAS unsigned char* kb_ = kring + (buf) * KS_BYTES; _Pragma("unroll") for (int i = 0; i < 3; ++i) { const int c = tid + 512 * i, r = c / 24, cc = c % 24; *(LAS u32x4*)(kb_ + r * KS_STRIDE + cc * 16) = kst[i]; } } while (0)
#define AT_VSTORE(buf) do { LAS unsigned char* vb_ = vring + (buf) * VS_BYTES; _Pragma("unroll") for (int i = 0; i < 2; ++i) { const int c = tid + 512 * i, r = c >> 3, cc = c & 7; *(LAS u32x4*)(vb_ + r * VS_STRIDE + cc * 16) = vst[i]; } } while (0)
#define AT_QK(sx, buf) do { LAS unsigned char* kb_ = kring + (buf) * KS_BYTES; \
            _Pragma("unroll") for (int kbk = 0; kbk < 4; ++kbk) { sx[kbk][0] = (f32x4){0.f, 0.f, 0.f, 0.f}; sx[kbk][1] = (f32x4){0.f, 0.f, 0.f, 0.f}; \
                const int krow = (kbk >> 1) * 32 + (fr >> 2) * 8 + (kbk & 1) * 4 + (fr & 3); \
                _Pragma("unroll") for (int ks = 0; ks < 6; ++ks) { const bf16x8 kf = *(const LAS bf16x8*)(kb_ + krow * KS_STRIDE + ks * 64 + fq * 16); \
                    sx[kbk][0] = __builtin_amdgcn_mfma_f32_16x16x32_bf16(kf, qf[0][ks], sx[kbk][0], 0, 0, 0); \
                    sx[kbk][1] = __builtin_amdgcn_mfma_f32_16x16x32_bf16(kf, qf[1][ks], sx[kbk][1], 0, 0, 0); } } } while (0)
#define AT_SMPV(sx, buf) do { LAS unsigned char* vb_ = vring + (buf) * VS_BYTES; bf16x8 pf[2][2]; \
            _Pragma("unroll") for (int g = 0; g < 2; ++g) { \
                float mx = sx[0][g][0]; \
                _Pragma("unroll") for (int kbk = 0; kbk < 4; ++kbk) _Pragma("unroll") for (int j = 0; j < 4; ++j) mx = fmaxf(mx, sx[kbk][g][j]); \
                mx = fmaxf(mx, __shfl_xor(mx, 16)); mx = fmaxf(mx, __shfl_xor(mx, 32)); \
                const float mnew = fmaxf(mrun[g], mx), alpha = __builtin_amdgcn_exp2f(mrun[g] - mnew); mrun[g] = mnew; \
                float ps = 0.f; \
                _Pragma("unroll") for (int kbk = 0; kbk < 4; ++kbk) _Pragma("unroll") for (int j = 0; j < 4; ++j) { const float p = __builtin_amdgcn_exp2f(sx[kbk][g][j] - mnew); sx[kbk][g][j] = p; ps += p; } \
                lrun[g] = lrun[g] * alpha + ps; \
                _Pragma("unroll") for (int db = 0; db < 8; ++db) o[db][g] *= alpha; \
                _Pragma("unroll") for (int p = 0; p < 2; ++p) { u32x4 w; w.x = cvt_pk_bf16(sx[2 * p][g][0], sx[2 * p][g][1]); w.y = cvt_pk_bf16(sx[2 * p][g][2], sx[2 * p][g][3]); \
                    w.z = cvt_pk_bf16(sx[2 * p + 1][g][0], sx[2 * p + 1][g][1]); w.w = cvt_pk_bf16(sx[2 * p + 1][g][2], sx[2 * p + 1][g][3]); pf[g][p] = __builtin_bit_cast(bf16x8, w); } } \
            _Pragma("unroll") for (int p = 0; p < 2; ++p) _Pragma("unroll") for (int db = 0; db < 8; ++db) { const bf16x8 vf = *(const LAS bf16x8*)(vb_ + (db * 16 + fr) * VS_STRIDE + p * 64 + fq * 16); \
                o[db][0] = __builtin_amdgcn_mfma_f32_16x16x32_bf16(vf, pf[0][p], o[db][0], 0, 0, 0); \
                o[db][1] = __builtin_amdgcn_mfma_f32_16x16x32_bf16(vf, pf[1][p], o[db][1], 0, 0, 0); } } while (0)
        AT_KLOAD(0); AT_VLOAD(0); AT_KSTORE(0); AT_VSTORE(0);
        __syncthreads();
        f32x4 sx[4][2];
        int vb_cur = 0, vb_prev = 2;
        for (int tile = 0; tile < ntile; ++tile) {
            const int kb_cur = tile & 1, vb_nxt = (vb_cur == 2) ? 0 : vb_cur + 1;
            if (tile + 1 < ntile) { AT_KLOAD(tile + 1); AT_VLOAD(tile + 1); }
            if (wid < 4) { AT_QK(sx, kb_cur); AT_SMPV(sx, vb_cur); }
            else { if (tile > 0) AT_SMPV(sx, vb_prev); AT_QK(sx, kb_cur); }
            if (tile + 1 < ntile) { AT_KSTORE(kb_cur ^ 1); AT_VSTORE(vb_nxt); }
            __syncthreads();
            vb_prev = vb_cur; vb_cur = vb_nxt;
        }
        if (wid >= 4) AT_SMPV(sx, vb_prev);
        __syncthreads();
#pragma unroll
        for (int g = 0; g < 2; ++g) { float lt = lrun[g]; lt += __shfl_xor(lt, 16); lt += __shfl_xor(lt, 32); const float inv = 1.f / lt;
            const int q = q0 + g * 16 + fr; const int row = q < 256 ? MLAT + b * 256 + q : b * 2048 + (q - 256);
#pragma unroll
            for (int db = 0; db < 8; ++db) { const f32x4 v = o[db][g] * inv; u32x2 w; w.x = cvt_pk_bf16(v[0], v[1]); w.y = cvt_pk_bf16(v[2], v[3]);
                *(u32x2*)(CAT + (size_t)row * D + 1280 + h * 128 + db * 16 + fq * 4) = w; } }
#undef AT_KLOAD
#undef AT_VLOAD
#undef AT_KSTORE
#undef AT_VSTORE
#undef AT_QK
#undef AT_SMPV
    }
}

constexpr int PH_PER_LAYER = 13, NPHASE = 2 + 2 * PH_PER_LAYER;

template <int LP>
__device__ __forceinline__ void layer_phase(const Args& a, const int l, LAS unsigned char* lds) {
    unsigned char* ws = a.ws; const bool last = (l == 1); const int Mlate = last ? MLAT : MR;
    bf16_t* H = (bf16_t*)(ws + WS_H); bf16_t* ACT = (bf16_t*)(ws + WS_P); bf16_t* Y = (bf16_t*)(ws + WS_Y); bf16_t* CAT = (bf16_t*)(ws + WS_CAT);
    if constexpr (LP == 0) { EpiSwiGLU E; E.O = ACT; E.ldc = DFF; run_gemm(lds, H, (const bf16_t*)(ws + WS_WFFIN + (size_t)(l * 2) * SZ_WFFIN), MR, 2 * DFF, D, E, 0); deferred_window(a, l, DW_IDLE2, DW_START2, DW_Q2, lds); }
    if constexpr (LP == 1) { const bf16_t* W = (const bf16_t*)(ws + WS_WFFOUT + (size_t)(l * 2) * SZ_WFFOUT);
        { EpiBf16 E; E.O = Y; E.ldc = D; run_gemm(lds, ACT, W, MLAT, D, DFF, E, 0); }
        { EpiF32 E; E.C = (float*)(ws + WS_YP); E.ldc = D; run_gemm(lds, ACT + (size_t)MLAT * DFF, W, 4 * MCTX, D, DFF / 4, E, 0, DFF, MCTX / 256); } deferred_window(a, l, DW_IDLE3, DW_START3, DW_Q3, lds); }
    if constexpr (LP == 2) phase_resnorm(a, l, 1, 2, 0.5f, true, l, 2, 3, 4, false, MR, lds);
    if constexpr (LP == 3) { EpiBf16 E; E.O = (bf16_t*)(ws + WS_P); E.ldc = INWP; run_gemm(lds, H, (const bf16_t*)(ws + WS_WIN + (size_t)l * SZ_WIN), MR, INWP, D, E, 0); deferred_window(a, l, DW_IDLE5, DW_START5, DW_Q5, lds); }
    if constexpr (LP == 4) { if (a.sub & 1) phase_prep(a, l); if (a.sub & 4) phase_ret_local(a, lds); }
    if constexpr (LP == 5) {
        {
          const int G = gridDim.x, bid = (int)blockIdx.x; const bool part = (G == DEFER_GRID);
          if (!part || bid < 144) { EpiBf16 E; E.O = (bf16_t*)(ws + WS_PG); E.ldc = GLUW; run_gemm(lds, H, (const bf16_t*)(ws + WS_WGLU + (size_t)l * SZ_WGLU), MR, GLUW, D, E, 0, 0, 0, part ? 144 : 0, bid); }
          if (!part || bid >= 144) {
              { EpiBf16 E; E.O = (bf16_t*)(ws + WS_QF); E.ldc = 1280; run_gemm(lds, (const bf16_t*)(ws + WS_CQN), (const bf16_t*)(ws + WS_WUQ + (size_t)l * SZ_WUQ), MR, 1280, 512, E, 0, 0, 0, part ? G - 144 : 0, bid - 144); }
              { EpiBf16 E; E.O = (bf16_t*)(ws + WS_KVF); E.ldc = 1536; run_gemm(lds, (const bf16_t*)(ws + WS_CKVN), (const bf16_t*)(ws + WS_WUKV + (size_t)l * SZ_WUKV), MR, 1536, 256, E, 0, 0, 0, part ? G - 144 : 0, part ? (bid - 144 + 68) % (DEFER_GRID - 144) : 0); } } }
        if (a.sub & 256) phase_ret_combine(a);
    }
    if constexpr (LP == 6) { if (a.sub & 2) phase_conv(a, l, lds); if (a.sub & 8) phase_post(a); if (a.sub & 16) phase_ret_out(a, l, lds); }
    if constexpr (LP == 7) { phase_attn(a, l, lds);
        { const int nitem = 24 * (last ? 8 : 9), G = gridDim.x;
          if ((int)blockIdx.x >= nitem && G > nitem) { EpiBf16 E; E.O = CAT + 768; E.ldc = D; run_gemm(lds, (const bf16_t*)(ws + WS_CVN), (const bf16_t*)(ws + WS_WPW + (size_t)l * SZ_WPW), MR, 512, 512, E, 0, 0, 0, G - nitem, (int)blockIdx.x - nitem); }
          else if (G <= nitem) { EpiBf16 E; E.O = CAT + 768; E.ldc = D; run_gemm(lds, (const bf16_t*)(ws + WS_CVN), (const bf16_t*)(ws + WS_WPW + (size_t)l * SZ_WPW), MR, 512, 512, E, 0); } }
        deferred_window(a, l, DW_IDLE9, DW_START9, DW_Q9, lds); }
    if constexpr (LP == 8) { const bf16_t* W = (const bf16_t*)(ws + WS_WOUT + (size_t)l * SZ_WOUT);
        { EpiBf16 E; E.O = Y; E.ldc = D; run_gemm(lds, CAT, W, MLAT, D, D, E, 0); }
        if (!last) { EpiF32 E; E.C = (float*)(ws + WS_YP); E.ldc = D; run_gemm(lds, CAT + (size_t)MLAT * D, W, 4 * MCTX, D, D / 4, E, 0, D, MCTX / 256); } deferred_window(a, l, DW_IDLE10, DW_START10, DW_Q10, lds); }
    if constexpr (LP == 9) phase_resnorm(a, l, 3, 5, 1.0f, true, l, 4, 6, 7, false, Mlate, lds);
    if constexpr (LP == 10) { EpiSwiGLU E; E.O = ACT; E.ldc = DFF; run_gemm(lds, H, (const bf16_t*)(ws + WS_WFFIN + (size_t)(l * 2 + 1) * SZ_WFFIN), Mlate, 2 * DFF, D, E, 0); deferred_window(a, l, DW_IDLE12, DW_START12, DW_Q12, lds); }
    if constexpr (LP == 11) { const bf16_t* W = (const bf16_t*)(ws + WS_WFFOUT + (size_t)(l * 2 + 1) * SZ_WFFOUT);
        { EpiBf16 E; E.O = Y; E.ldc = D; run_gemm(lds, ACT, W, MLAT, D, DFF, E, 0); }
        if (!last) { EpiF32 E; E.C = (float*)(ws + WS_YP); E.ldc = D; run_gemm(lds, ACT + (size_t)MLAT * DFF, W, 4 * MCTX, D, DFF / 4, E, 0, DFF, MCTX / 256); } deferred_window(a, l, DW_IDLE13, DW_START13, DW_Q13, lds); }
    if constexpr (LP == 12) phase_resnorm(a, l, 5, 8, 0.5f, !last, last ? l : l + 1, 0, 0, 1, last, Mlate, lds);
}

__global__ void __launch_bounds__(NTHR, 2) hybrid_fwd(Args a) {
    extern __shared__ __attribute__((aligned(16))) unsigned char lds_raw[];
    LAS unsigned char* lds = (LAS unsigned char*)lds_raw;
    cg::grid_group grid = cg::this_grid();
    volatile LAS unsigned* xst = (volatile LAS unsigned*)(lds + LDS_BYTES - 16);
    if (threadIdx.x == 0) { xst[0] = 0u; xst[1] = 0u; }
    __syncthreads();
    XcdBarrier xbar = xcd_barrier_post((unsigned*)(a.ws + WS_BAR), xst);
#ifndef REPMASK
#define REPMASK 0ull
#endif
#define RUN_PH(ph, stmt) if (a.ph_lo <= (ph) && (ph) < a.ph_hi) { if ((ph) > a.ph_lo) { if ((ph) == 1) grid.sync(); else xcd_barrier(xbar); } stmt; }
    RUN_PH(0, phase_prologue(a, lds))
    RUN_PH(1, phase_norm0(a, lds))
#define RUN_LAYER(l) \
    RUN_PH(2 + (l) * 13 + 0, layer_phase<0>(a, l, lds)) RUN_PH(2 + (l) * 13 + 1, layer_phase<1>(a, l, lds)) RUN_PH(2 + (l) * 13 + 2, layer_phase<2>(a, l, lds)) \
    RUN_PH(2 + (l) * 13 + 3, layer_phase<3>(a, l, lds)) RUN_PH(2 + (l) * 13 + 4, layer_phase<4>(a, l, lds)) RUN_PH(2 + (l) * 13 + 5, layer_phase<5>(a, l, lds)) \
    RUN_PH(2 + (l) * 13 + 6, layer_phase<6>(a, l, lds)) RUN_PH(2 + (l) * 13 + 7, layer_phase<7>(a, l, lds)) RUN_PH(2 + (l) * 13 + 8, layer_phase<8>(a, l, lds)) \
    RUN_PH(2 + (l) * 13 + 9, layer_phase<9>(a, l, lds)) RUN_PH(2 + (l) * 13 + 10, layer_phase<10>(a, l, lds)) RUN_PH(2 + (l) * 13 + 11, layer_phase<11>(a, l, lds)) \
    RUN_PH(2 + (l) * 13 + 12, layer_phase<12>(a, l, lds))
    RUN_LAYER(0)
    RUN_LAYER(1)
#ifdef EXTRA_SYNCS
    if (a.ph_hi - a.ph_lo > 1) { for (int i = 0; i < EXTRA_SYNCS; ++i) grid.sync(); }
#endif
}

#ifndef ONE_LAUNCH
#define ONE_LAUNCH 0
#endif

extern "C" void kernel_launch(void* const* d_in, const int* in_sizes, int n_in, void* d_out, int out_size, void* d_ws, size_t ws_size, hipStream_t stream) {
    static int grid = 0;
    if (grid == 0) {
        if (n_in != 23 || ws_size < WS_END) { fprintf(stderr, "kernel_launch: need 23 inputs and %zu bytes of workspace; got %d, %zu\n", (size_t)WS_END, n_in, ws_size); grid = -1; return; }
        int dev = 0, cus = 0, per_cu = 0;
        hipGetDevice(&dev); hipDeviceGetAttribute(&cus, hipDeviceAttributeMultiprocessorCount, dev);
        if (hipFuncSetAttribute((const void*)hybrid_fwd, hipFuncAttributeMaxDynamicSharedMemorySize, LDS_BYTES) != hipSuccess) { fprintf(stderr, "kernel_launch: hipFuncSetAttribute failed\n"); grid = -1; return; }
        if (hipOccupancyMaxActiveBlocksPerMultiprocessor(&per_cu, (const void*)hybrid_fwd, NTHR, LDS_BYTES) != hipSuccess || per_cu < 1) { fprintf(stderr, "kernel_launch: occupancy query gave %d\n", per_cu); per_cu = 1; }
        (void)hipGetLastError();
        grid = cus * 1;
        fprintf(stderr, "kernel_launch: grid %d (per_cu %d)\n", grid, per_cu);
    }
    if (grid < 0) return;
    if (hipMemsetAsync((char*)d_ws + WS_BAR, 0, 16384, stream) != hipSuccess) { fprintf(stderr, "kernel_launch: memset failed\n"); return; }
    Args a{};
    for (int i = 0; i < 23; ++i) a.in[i] = (const float*)d_in[i];
    a.out = (float*)d_out; a.ws = (unsigned char*)d_ws; a.sub = ~0ull;
#if ONE_LAUNCH
    a.ph_lo = 0; a.ph_hi = NPHASE;
    { void* args[] = {&a}; hipError_t e = hipLaunchCooperativeKernel((const void*)hybrid_fwd, dim3(grid), dim3(NTHR), args, LDS_BYTES, stream);
      if (e != hipSuccess) fprintf(stderr, "cooperative launch failed: %s\n", hipGetErrorString(e)); }
#ifdef EXTRA_PH
    { const int extra[] = EXTRA_PH; a.sub = EXTRA_SUB; for (int ph : extra) { a.ph_lo = ph; a.ph_hi = ph + 1; void* args[] = {&a}; (void)hipLaunchCooperativeKernel((const void*)hybrid_fwd, dim3(grid), dim3(NTHR), args, LDS_BYTES, stream); } }
#endif
#else
    for (int ph = 0; ph < NPHASE; ++ph) {
        a.ph_lo = ph; a.ph_hi = ph + 1;
        void* args[] = {&a}; hipError_t e = hipLaunchCooperativeKernel((const void*)hybrid_fwd, dim3(grid), dim3(NTHR), args, LDS_BYTES, stream);
        if (e != hipSuccess) { fprintf(stderr, "launch %d failed: %s\n", ph, hipGetErrorString(e)); break; }
    }
#endif
}
```

```cpp
#include <hip/hip_runtime.h>
#include <hip/hip_cooperative_groups.h>
#include <cstdio>
namespace cg = cooperative_groups;

#define ONE_LAUNCH 1
#define EXTRA_SUB ~0ull
namespace pg8 {
#define PG8_LAS __attribute__((address_space(3)))
typedef unsigned short bf16_t;
typedef short bf16x8 __attribute__((ext_vector_type(8)));
typedef float f32x4 __attribute__((ext_vector_type(4)));
typedef unsigned u32x4 __attribute__((ext_vector_type(4)));
constexpr int BM = 256, BK = 64, HALF = 128, HTB = HALF * BK * 2  , STAGE_BYTES = 8 * HTB, NXCD = 8, WGM = 8;

__host__ __device__ __forceinline__ int lds_byte(int r, int c) { const int st = (r >> 4) * 2 + (c >> 5), rr = r & 15, cc = c & 31, ob = rr * 64 + cc * 2; return st * 1024 + (ob ^ (((ob >> 9) & 1) << 5)); }
__host__ __device__ __forceinline__ void stage_rc(int b, int& R, int& C) { const int st = b / 1024, sb = b % 1024, swz = sb ^ (((sb >> 9) & 1) << 5); R = (st >> 1) * 16 + swz / 64; C = (st & 1) * 32 + (swz % 64) / 2; }
__host__ __device__ __forceinline__ int perm32(int rho) { const int n = rho >> 4, i = rho & 15; return 8 * (i >> 2) + 4 * n + (i & 3); }

struct Unit { int pm, pn; };
struct Gemm { const bf16_t* A; const bf16_t* Bt; int M, N, K, ld, msplit; };

struct StaticOrder {
    int nM, nN, nwg, G, c;
    __host__ __device__ void init(int M, int N, int G_, int c_) { nM = M / BM; nN = N / BM; nwg = nM * nN; G = G_; c = c_; }
    __host__ __device__ bool next(int i, Unit& u) const {
        const long L = (long)i * G + c; if (L >= nwg) return false;
        int wgid = (int)L; { const int q = nwg / NXCD, r = nwg % NXCD, xcd = wgid % NXCD, off = wgid / NXCD; wgid = (xcd < r ? xcd * (q + 1) : r * (q + 1) + (xcd - r) * q) + off; }
        const int nig = WGM * nN, gid = wgid / nig, fm = gid * WGM, gsz = (nM - fm) < WGM ? (nM - fm) : WGM;
        u.pm = fm + ((wgid % nig) % gsz); u.pn = (wgid % nig) / gsz; return true;
    }
    __device__ __forceinline__ void a_ready(const Unit&) const {}
    __device__ __forceinline__ void done(const Unit&) const {}
};
__device__ __forceinline__ unsigned cvt_pk_bf16(float lo, float hi) { unsigned r; asm volatile("v_cvt_pk_bf16_f32 %0, %1, %2" : "=v"(r) : "v"(lo), "v"(hi)); return r; }
typedef float f32x2 __attribute__((ext_vector_type(2)));

template <class Epi, class Sched, bool STAMP = false>
__device__ __forceinline__ void gemm_phase(PG8_LAS unsigned char* lds, const Gemm g, const Sched& S, const Epi& E, unsigned long long* stamps) {
    const int tid = threadIdx.x, wid = __builtin_amdgcn_readfirstlane(tid >> 6), lane = tid & 63, wr = wid >> 2, wc = wid & 3, fr = lane & 15, fq = lane >> 4;
    const int K = g.K, nt = K / BK, LD = g.ld, MSPL = g.msplit;
    int ts_lo = 0, ts_hi = 0, nts = 0; const unsigned long long rt_entry = STAMP ? (unsigned long long)wall_clock64() : 0ull;
#define PG8_STAMP() do { if (STAMP && wid == 0 && nts < 64) { const unsigned long long _c = (unsigned long long)clock64(); \
        ts_lo = (lane == nts) ? (int)(unsigned)_c : ts_lo; ts_hi = (lane == nts) ? (int)(unsigned)(_c >> 32) : ts_hi; ++nts; } } while (0)
    PG8_STAMP();
    unsigned voffA[2], voffB[2];
#pragma unroll
    for (int i = 0; i < 2; ++i) { int R, C; stage_rc(tid * 16 + i * 8192, R, C); const int Rb = Epi::PERM ? ((R & ~31) + perm32(R & 31)) : R;
        voffA[i] = (unsigned)(R * LD + C) * 2u; voffB[i] = (unsigned)(Rb * LD + C) * 2u; }
    const size_t kstep = (size_t)(BK * 2);
    const size_t hstep = (size_t)HALF * LD * 2;
    const size_t tstep = 2 * hstep;
    const unsigned ldsw = (unsigned)wid * 1024u;
    const int aoff = lds_byte(wr * 64 + fr, fq * 8), boff = lds_byte(wc * 32 + fr, fq * 8);
#define PG8_SA(b, h) (((b) * 2 + (h)) * HTB)
#define PG8_SB(b, h) ((4 + (b) * 2 + (h)) * HTB)
#define PG8_STAGE(bufoff, gbase, voff) do { _Pragma("unroll") for (int _i = 0; _i < 2; ++_i) \
        __builtin_amdgcn_global_load_lds((const unsigned*)((const char*)(gbase) + (voff)[_i]), (PG8_LAS unsigned*)(lds + (bufoff) + ldsw + _i * 8192), 16, 0, 0); } while (0)
#define PG8_LDA(dst, b, h) do { _Pragma("unroll") for (int m = 0; m < 4; ++m) _Pragma("unroll") for (int k = 0; k < 2; ++k) dst[m][k] = *(const PG8_LAS bf16x8*)(lds + PG8_SA(b, h) + aoff + m * 2048 + k * 1024); } while (0)
#define PG8_LDB(dst, b, h) do { _Pragma("unroll") for (int n = 0; n < 2; ++n) _Pragma("unroll") for (int k = 0; k < 2; ++k) dst[n][k] = *(const PG8_LAS bf16x8*)(lds + PG8_SB(b, h) + boff + n * 2048 + k * 1024); } while (0)
#define PG8_MMA(ai, bj, At, Bt) do { __builtin_amdgcn_s_setprio(1); _Pragma("unroll") for (int m = 0; m < 4; ++m) _Pragma("unroll") for (int n = 0; n < 2; ++n) _Pragma("unroll") for (int k = 0; k < 2; ++k) \
        acc[ai][bj][m][n] = __builtin_amdgcn_mfma_f32_16x16x32_bf16(Bt[n][k], At[m][k], acc[ai][bj][m][n], 0, 0, 0); __builtin_amdgcn_s_setprio(0); } while (0)
#define PG8_WAIT_V(n) asm volatile("s_waitcnt vmcnt(" #n ")" ::: "memory")
#define PG8_WAIT_L(n) asm volatile("s_waitcnt lgkmcnt(" #n ")" ::: "memory")
#define PG8_BAR __builtin_amdgcn_s_barrier()
#define PG8_SCHED __builtin_amdgcn_sched_barrier(0)
    Unit cur, nxt; int ui = 0;
    if (!S.next(0, cur)) return;
    f32x4 acc[2][2][4][2];
#pragma unroll
    for (int a = 0; a < 2; ++a)
#pragma unroll
        for (int b = 0; b < 2; ++b)
#pragma unroll
            for (int m = 0; m < 4; ++m)
#pragma unroll
                for (int n = 0; n < 2; ++n) acc[a][b][m][n] = (f32x4){0.f, 0.f, 0.f, 0.f};
    bf16x8 At[4][2], B0[2][2], B1[2][2];
#define PG8_OFFA(u) (MSPL ? (size_t)((u).pm % MSPL) * tstep + (size_t)((u).pm / MSPL) * ((size_t)K * 2) : (size_t)(u).pm * tstep)
#define PG8_OFFB(u) ((size_t)(u).pn * tstep + (MSPL ? (size_t)((u).pm / MSPL) * ((size_t)K * 2) : (size_t)0))
    const char* cA = (const char*)g.A + PG8_OFFA(cur); const char* cB = (const char*)g.Bt + PG8_OFFB(cur);
    S.a_ready(cur);
    PG8_STAGE(PG8_SB(0, 0), cB, voffB); PG8_STAGE(PG8_SA(0, 0), cA, voffA); PG8_STAGE(PG8_SB(0, 1), cB + hstep, voffB); PG8_STAGE(PG8_SA(0, 1), cA + hstep, voffA);
    if (wr == 1) PG8_BAR;
    PG8_WAIT_V(4); PG8_BAR;
    PG8_STAGE(PG8_SB(1, 0), cB + kstep, voffB); PG8_STAGE(PG8_SA(1, 0), cA + kstep, voffA); PG8_STAGE(PG8_SB(1, 1), cB + hstep + kstep, voffB);
    PG8_WAIT_V(6); PG8_BAR;
    PG8_STAMP();
    for (;;) {
        const bool has_next = S.next(ui + 1, nxt);
        const char* nA = has_next ? (const char*)g.A + PG8_OFFA(nxt) : cA; const char* nB = has_next ? (const char*)g.Bt + PG8_OFFB(nxt) : cB;
        for (int t = 0; t < nt; t += 2) {
            const bool last = (t == nt - 2);
            const char* a1 = cA + (size_t)(t + 1) * kstep;
            const char* a2 = last ? nA : cA + (size_t)(t + 2) * kstep; const char* b2 = last ? nB : cB + (size_t)(t + 2) * kstep;
            const char* a3 = a2 + kstep; const char* b3 = b2 + kstep;
            if (last && has_next) S.a_ready(nxt);
            PG8_LDB(B0, 0, 0); PG8_SCHED; PG8_LDA(At, 0, 0); PG8_STAGE(PG8_SA(1, 1), a1 + hstep, voffA);
            PG8_WAIT_L(8); PG8_BAR; PG8_WAIT_L(0); PG8_MMA(0, 0, At, B0); PG8_BAR; PG8_SCHED;
            PG8_LDB(B1, 0, 1); PG8_STAGE(PG8_SB(0, 0), b2, voffB);
            PG8_BAR; PG8_WAIT_L(0); PG8_MMA(0, 1, At, B1); PG8_BAR;
            PG8_LDA(At, 0, 1); PG8_STAGE(PG8_SA(0, 0), a2, voffA);
            PG8_BAR; PG8_WAIT_L(0); PG8_MMA(1, 0, At, B0); PG8_BAR; PG8_SCHED;
            PG8_STAGE(PG8_SB(0, 1), b2 + hstep, voffB);
            PG8_WAIT_V(6); PG8_BAR; PG8_MMA(1, 1, At, B1); PG8_BAR;
            PG8_LDB(B0, 1, 0); PG8_SCHED; PG8_LDA(At, 1, 0); PG8_STAGE(PG8_SA(0, 1), a2 + hstep, voffA);
            PG8_WAIT_L(8); PG8_BAR; PG8_WAIT_L(0); PG8_MMA(0, 0, At, B0); PG8_BAR; PG8_SCHED;
            PG8_LDB(B1, 1, 1); PG8_STAGE(PG8_SB(1, 0), b3, voffB);
            PG8_BAR; PG8_WAIT_L(0); PG8_MMA(0, 1, At, B1); PG8_BAR;
            PG8_LDA(At, 1, 1); PG8_STAGE(PG8_SA(1, 0), a3, voffA);
            PG8_BAR; PG8_WAIT_L(0); PG8_MMA(1, 0, At, B0); PG8_BAR; PG8_SCHED;
            PG8_STAGE(PG8_SB(1, 1), b3 + hstep, voffB);
            PG8_WAIT_V(6); PG8_BAR; PG8_MMA(1, 1, At, B1); PG8_BAR;
        }
        PG8_STAMP();
        if constexpr (!Epi::AFTER_DRAIN) { E(acc, cur, wr, wc, fr, fq); S.done(cur); }
        PG8_STAMP();
        if (!has_next) break;
#pragma unroll
        for (int a = 0; a < 2; ++a)
#pragma unroll
            for (int b = 0; b < 2; ++b)
#pragma unroll
                for (int m = 0; m < 4; ++m)
#pragma unroll
                    for (int n = 0; n < 2; ++n) acc[a][b][m][n] = (f32x4){0.f, 0.f, 0.f, 0.f};
        cur = nxt; cA = nA; cB = nB; ++ui;
    }
    PG8_WAIT_V(0);
    if (wr == 0) PG8_BAR;
    PG8_BAR;
    if constexpr (Epi::AFTER_DRAIN) { E.fused(acc, cur, wr, wc, fr, fq, lds, wid, lane); S.done(cur); }
    PG8_STAMP();
    if (STAMP && wid == 0) { stamps[lane] = lane < nts ? (((unsigned long long)(unsigned)ts_hi << 32) | (unsigned)ts_lo) : 0ull;
        if (lane == 62) stamps[62] = rt_entry; if (lane == 63) stamps[63] = (unsigned long long)wall_clock64(); }
#undef PG8_STAMP
#undef PG8_SA
#undef PG8_SB
#undef PG8_STAGE
#undef PG8_LDA
#undef PG8_LDB
#undef PG8_MMA
#undef PG8_WAIT_V
#undef PG8_WAIT_L
#undef PG8_BAR
#undef PG8_SCHED
}
}
#ifndef LAS
#define LAS __attribute__((address_space(3)))
#endif
#define XB_TMO      128
#define XB_XCNT(j)  (256  + 64 * (j))
#define XB_XSUB(j)  (1280 + 64 * (j))
#define XB_XGEN(j)  (2304 + 64 * (j))
#define XB_TOP      3328
#define XB_TOPGEN   3392
#define XCD_BAR_WORDS 3456
#define XB_SPIN_CAP (1u << 18)

__device__ __forceinline__ unsigned xb_ld(unsigned* p)              { return __hip_atomic_load(p, __ATOMIC_RELAXED, __HIP_MEMORY_SCOPE_AGENT); }
__device__ __forceinline__ unsigned xb_add(unsigned* p, unsigned v) { return __hip_atomic_fetch_add(p, v, __ATOMIC_RELAXED, __HIP_MEMORY_SCOPE_AGENT); }
__device__ __forceinline__ unsigned xb_xcc_id() { return (unsigned)__builtin_amdgcn_s_getreg((3 << 11) | 20) & 0xFu; }
#define XB_SPIN(cond, bar) do { unsigned _sp = 0; while (cond) { __builtin_amdgcn_s_sleep(1); \
    if ((++_sp & 255u) == 0u) { if (xb_ld(&(bar)[XB_TMO])) break; if (_sp > XB_SPIN_CAP) { atomicAdd(&(bar)[XB_TMO], 1u); break; } } } } while (0)

struct XcdBarrier {
    unsigned* bar; unsigned x;
    volatile LAS unsigned* st;
};

__device__ __forceinline__ XcdBarrier xcd_barrier_post(unsigned* bar, volatile LAS unsigned* st) {
    XcdBarrier b; b.bar = bar; b.x = xb_xcc_id(); b.st = st;
    if (threadIdx.x == 0) (void)xb_add(&bar[XB_XCNT(b.x)], 1u);
    return b;
}
__device__ __forceinline__ void xcd_barrier_complete(unsigned* bar, unsigned x, unsigned& nloc, unsigned& nx) {
    const unsigned G = gridDim.x * gridDim.y * gridDim.z;
    unsigned sum, cnt, mine, sp = 0u;
    for (;;) {
        sum = 0u; cnt = 0u; mine = 0u;
#pragma unroll
        for (unsigned j = 0; j < 16; ++j) { const unsigned c = xb_ld(&bar[XB_XCNT(j)]); sum += c; cnt += (c > 0u) ? 1u : 0u; mine = (j == x) ? c : mine; }
        if (sum == G) break;
        __builtin_amdgcn_s_sleep(1);
        if ((++sp & 255u) == 0u) { if (xb_ld(&bar[XB_TMO])) break; if (sp > XB_SPIN_CAP) { atomicAdd(&bar[XB_TMO], 1u); break; } }
    }
    nloc = mine > 0u ? mine : 1u; nx = cnt > 0u ? cnt : 1u;
}

__device__ __forceinline__ void xcd_barrier(const XcdBarrier& b) {
    asm volatile("s_waitcnt vmcnt(0)" ::: "memory");
    __syncthreads();
    if (threadIdx.x == 0) {
        unsigned* bar = b.bar;
        __builtin_amdgcn_s_waitcnt(0);
        unsigned nloc = b.st[0], nx = b.st[1];
        if (nloc == 0u) { xcd_barrier_complete(bar, b.x, nloc, nx); b.st[0] = nloc; b.st[1] = nx; }
        const unsigned old = xb_add(&bar[XB_XSUB(b.x)], 1u);
        const unsigned gen = old / nloc;
        if (old + 1u == (gen + 1u) * nloc) {
            __builtin_amdgcn_fence(__ATOMIC_RELEASE, "agent");
            asm volatile("s_waitcnt vmcnt(0)" ::: "memory");
            const unsigned og = xb_add(&bar[XB_TOP], 1u);
            const unsigned tg = og / nx;
            if (og + 1u == (tg + 1u) * nx) xb_add(&bar[XB_TOPGEN], 1u);
            else XB_SPIN(xb_ld(&bar[XB_TOPGEN]) == tg, bar);
            __builtin_amdgcn_fence(__ATOMIC_ACQUIRE, "agent");
            xb_add(&bar[XB_XGEN(b.x)], 1u);
            asm volatile("s_waitcnt vmcnt(0)" ::: "memory");
        } else {
            XB_SPIN(xb_ld(&bar[XB_XGEN(b.x)]) == gen, bar);
            __builtin_amdgcn_fence(__ATOMIC_ACQUIRE, "agent");
            asm volatile("s_waitcnt vmcnt(0)" ::: "memory");
        }
    }
    __syncthreads();
}


using namespace pg8;
#undef LAS
#define LAS PG8_LAS
typedef unsigned u32x2 __attribute__((ext_vector_type(2)));

constexpr int D = 2048, NBATCH = 4, SEQ = 2048, CTXL = 256, DFF = 5632;
constexpr int MLAT = NBATCH * SEQ, MCTX = NBATCH * CTXL, MR = MLAT + MCTX;
constexpr int INW = 4160, INWP = 3328, GLUW = 1024;
constexpr int OFF_RQ = 0, OFF_RK = 384, OFF_RV = 768, OFF_RG = 1536, OFF_CQ = 2304, OFF_CKV = 2816, OFF_KR = 3072;
constexpr int NKEY = CTXL + SEQ;
constexpr int NCH = 18;
constexpr float EPS = 1e-6f;
constexpr int NTHR = 512;
constexpr int DEFER_GRID = 256;
constexpr int LDS_BYTES = 151552;

constexpr size_t SZ_WFFIN = (size_t)2 * DFF * D * 2;
constexpr size_t SZ_WFFOUT = (size_t)D * DFF * 2;
constexpr size_t SZ_WIN = (size_t)INWP * D * 2;
constexpr size_t SZ_WOUT = (size_t)D * D * 2;
constexpr size_t SZ_WUQ = (size_t)1280 * 512 * 2;
constexpr size_t SZ_WUKV = (size_t)1536 * 256 * 2;
constexpr size_t SZ_WPW = (size_t)512 * 512 * 2;
constexpr size_t WS_WFFIN = 0;
constexpr size_t WS_WFFOUT = WS_WFFIN + 4 * SZ_WFFIN;
constexpr size_t WS_WIN = WS_WFFOUT + 4 * SZ_WFFOUT;
constexpr size_t WS_WOUT = WS_WIN + 2 * SZ_WIN;
constexpr size_t WS_WUQ = WS_WOUT + 2 * SZ_WOUT;
constexpr size_t WS_WUKV = WS_WUQ + 2 * SZ_WUQ;
constexpr size_t WS_WPW = WS_WUKV + 2 * SZ_WUKV;
constexpr size_t WS_MOD = WS_WPW + 2 * SZ_WPW;
constexpr size_t WS_X = WS_MOD + (size_t)2 * 5 * 18432 * 4;
constexpr size_t WS_H = WS_X + (size_t)MR * D * 4;
constexpr size_t WS_Y = WS_H + (size_t)MR * D * 2;
constexpr size_t WS_P = WS_Y + (size_t)MR * D * 4;
constexpr size_t WS_QR = WS_P + (size_t)MR * INWP * 4;
constexpr size_t WS_KR = WS_QR + (size_t)MR * 384 * 4;
constexpr size_t WS_CQN = WS_KR + (size_t)MR * 384 * 4;
constexpr size_t WS_CKVN = WS_CQN + (size_t)MR * 512 * 2;
constexpr size_t WS_CVN = WS_CKVN + (size_t)MR * 256 * 2;
constexpr size_t WS_QF = WS_CVN + (size_t)MR * 512 * 2;
constexpr size_t WS_KVF = WS_QF + (size_t)MR * 1280 * 4;
constexpr size_t WS_QB = WS_KVF + (size_t)MR * 1536 * 4;
constexpr size_t WS_KB = WS_QB + (size_t)NBATCH * 6 * NKEY * 192 * 2;
constexpr size_t WS_VT = WS_KB + (size_t)NBATCH * 6 * NKEY * 192 * 2;
constexpr size_t WS_CAT = WS_VT + (size_t)NBATCH * 6 * 128 * NKEY * 2;
constexpr size_t WS_SF = WS_CAT + (size_t)MR * D * 2;
constexpr size_t WS_SB = WS_SF + (size_t)NBATCH * 6 * NCH * 8192 * 4;
constexpr size_t WS_TAB = WS_SB + (size_t)NBATCH * 6 * NCH * 8192 * 4;
constexpr size_t WS_YP = WS_TAB + (size_t)2048 * 32 * 8;
constexpr size_t WS_BAR = WS_YP + (size_t)4 * MCTX * D * 4;
constexpr size_t WS_RKB = WS_BAR + 16384;
constexpr size_t WS_RVT = WS_RKB + (size_t)24 * NCH * 128 * 64 * 2;
constexpr size_t SZ_WGLU = (size_t)GLUW * D * 2;
constexpr size_t WS_WGLU = WS_RVT + (size_t)24 * NCH * 128 * 128 * 2;
constexpr size_t WS_PG = WS_WGLU + 2 * SZ_WGLU;
constexpr size_t WS_END = WS_PG + (size_t)MR * GLUW * 2;

#ifndef REPMASK
#define REPMASK 0ull
#endif
struct Args { const float* in[23]; float* out; unsigned char* ws; unsigned long long sub; int ph_lo, ph_hi; };

__device__ __forceinline__ float wave_sum(float v) {
#pragma unroll
    for (int o = 32; o; o >>= 1) v += __shfl_xor(v, o);
    return v;
}
__device__ __forceinline__ float siluf(float a) { return a * __builtin_amdgcn_rcpf(1.f + __expf(-a)); }
__device__ __forceinline__ float sigmf(float a) { return __builtin_amdgcn_rcpf(1.f + __expf(-a)); }
__device__ __forceinline__ bf16_t f2bf(float f) { unsigned u = __float_as_uint(f); u += 0x7FFFu + ((u >> 16) & 1u); return (bf16_t)(u >> 16); }
__device__ __forceinline__ float bf2f(bf16_t v) { return __uint_as_float((unsigned)v << 16); }
__device__ __forceinline__ f32x4 ld_bf4(const bf16_t* p) { const u32x2 w = *(const u32x2*)p; return (f32x4){__uint_as_float(w.x << 16), __uint_as_float(w.x & 0xffff0000u), __uint_as_float(w.y << 16), __uint_as_float(w.y & 0xffff0000u)}; }
__device__ __forceinline__ int mod_of_row(int row) { return row < MLAT ? (row >> 11) : 4; }

__device__ __forceinline__ void rope_compute(int i, int t, float& cs, float& sn) {
    const float inv = exp2f(-(float)(i & 15) * (13.287712379549449f / 16.f));
    const float pos = (float)((i < 16) ? (t >> 6) : (t & 63));
    sincosf(pos * inv, &sn, &cs);
}
__device__ __forceinline__ void rope_cs(const f32x2* tab, int i, int t, bool latent, float& cs, float& sn) {
    const f32x2 v = tab[(latent ? t : 0) * 32 + i]; cs = latent ? v.x : 1.f; sn = latent ? v.y : 0.f;
}

__device__ __forceinline__ int map_col(int mode, int n) {
    if (mode == 1) { const int g = n >> 8, r = n & 255; return (r < 128) ? g * 128 + r : DFF + g * 128 + (r - 128); }
    if (mode == 2) return n < 2304 ? n : n + GLUW;
    if (mode == 3) return n + 2304;
    return n;
}
template <int MODE>
__device__ __forceinline__ void transpose_job(const float* src, bf16_t* dst, const int K, const int Nsrc, const int Ndst, const int goff, LAS float* tl) {
    const int tid = threadIdx.x, G = gridDim.x;
    const int ntn = Ndst >> 7, ntile = (K >> 7) * ntn;
    int t = ((int)blockIdx.x - goff % G + G) % G;
    const int n4 = (tid & 31) * 4, kr = tid >> 5;
    f32x4 v[8];
#define TJ_ISSUE(tt) do { const int tk_ = (tt) / ntn, tn_ = (tt) % ntn, k0_ = tk_ * 128, n_ = tn_ * 128 + n4; \
        const int scol_ = map_col(MODE, n_); \
        const bool valid_ = scol_ < Nsrc; const float* p_ = src + (size_t)(k0_ + kr) * Nsrc + scol_; \
        _Pragma("unroll") for (int i = 0; i < 8; ++i) v[i] = valid_ ? __builtin_nontemporal_load((const f32x4*)(p_ + (size_t)(16 * i) * Nsrc)) : (f32x4){0.f, 0.f, 0.f, 0.f}; } while (0)
    if (t < ntile) TJ_ISSUE(t);
    for (; t < ntile; t += G) {
        const int tk = t / ntn, tn = t % ntn, k0 = tk * 128, n0 = tn * 128;
#pragma unroll
        for (int i = 0; i < 8; ++i) { LAS float* q = tl + (kr + 16 * i) * 129 + n4; q[0] = v[i][0]; q[1] = v[i][1]; q[2] = v[i][2]; q[3] = v[i][3]; }
        __syncthreads();
        if (t + G < ntile) TJ_ISSUE(t + G);
#pragma unroll
        for (int i = 0; i < 4; ++i) { const int idx = tid + 512 * i, k8 = (idx & 15) * 8, n = idx >> 4; float x[8];
#pragma unroll
            for (int j = 0; j < 8; ++j) x[j] = tl[(k8 + j) * 129 + n];
            u32x4 w; w.x = cvt_pk_bf16(x[0], x[1]); w.y = cvt_pk_bf16(x[2], x[3]); w.z = cvt_pk_bf16(x[4], x[5]); w.w = cvt_pk_bf16(x[6], x[7]);
            *(u32x4*)(dst + (size_t)(n0 + n) * K + k0 + k8) = w; }
        __syncthreads();
    }
}

__device__ __forceinline__ void phase_prologue(const Args& a, LAS unsigned char* lds) {
    const int tid = threadIdx.x, G = gridDim.x, bid = blockIdx.x;
    LAS float* sl = (LAS float*)lds;
    LAS float* red = (LAS float*)(lds + 40960);
    LAS float* tl = (LAS float*)lds;
    for (int i = tid; i < 5 * 2048; i += NTHR) { const int m = i >> 11, k = i & 2047; const float c = m < 4 ? a.in[1][m * 2048 + k] : a.in[3][k]; sl[i] = siluf(c); }
    __syncthreads();
    float* MOD = (float*)(a.ws + WS_MOD);
    for (int it = bid; it < 256; it += G) {
        const int l = it >> 7, n0 = (it & 127) * 144, c4 = tid % 36, sl_i = tid / 36;
        f32x4 acc[5];
#pragma unroll
        for (int m = 0; m < 5; ++m) acc[m] = (f32x4){0.f, 0.f, 0.f, 0.f};
        if (sl_i < 14) {
            const float* w = a.in[4] + (size_t)l * 2048 * 18432 + n0 + c4 * 4;
#pragma unroll 8
            for (int k = sl_i; k < 2048; k += 14) { const f32x4 wv = __builtin_nontemporal_load((const f32x4*)(w + (size_t)k * 18432));
#pragma unroll
                for (int m = 0; m < 5; ++m) acc[m] += wv * sl[m * 2048 + k]; }
#pragma unroll
            for (int m = 0; m < 5; ++m) { LAS float* q = red + (sl_i * 5 + m) * 144 + c4 * 4; q[0] = acc[m][0]; q[1] = acc[m][1]; q[2] = acc[m][2]; q[3] = acc[m][3]; }
        }
        __syncthreads();
        for (int o = tid; o < 5 * 144; o += NTHR) { const int m = o / 144, c = o % 144; float s = 0.f;
#pragma unroll
            for (int q = 0; q < 14; ++q) s += red[(q * 5 + m) * 144 + c];
            MOD[((size_t)l * 5 + m) * 18432 + n0 + c] = s + a.in[5][l * 18432 + n0 + c]; }
        __syncthreads();
    }
    { f32x2* tab = (f32x2*)(a.ws + WS_TAB);
      for (int e = bid * NTHR + tid; e < 2048 * 32; e += G * NTHR) { float cs, sn; rope_compute(e & 31, e >> 5, cs, sn); tab[e] = (f32x2){cs, sn}; } }
    unsigned char* ws = a.ws; int goff = 0;
    const bool defer = (G == DEFER_GRID);
#pragma unroll 1
    for (int l = 0; l < 2; ++l) {
        if (defer && l == 1) break;
        transpose_job<1>(a.in[7] + (size_t)l * D * 2 * DFF, (bf16_t*)(ws + WS_WFFIN + (size_t)(l * 2 + 0) * SZ_WFFIN), D, 2 * DFF, 2 * DFF, goff, tl); goff += 16 * 88;
        transpose_job<0>(a.in[8] + (size_t)l * DFF * D, (bf16_t*)(ws + WS_WFFOUT + (size_t)(l * 2 + 0) * SZ_WFFOUT), DFF, D, D, goff, tl); goff += 44 * 16;
        transpose_job<2>(a.in[11] + (size_t)l * D * INW, (bf16_t*)(ws + WS_WIN + (size_t)l * SZ_WIN), D, INW, INWP, goff, tl); goff += 16 * 26;
        transpose_job<3>(a.in[11] + (size_t)l * D * INW, (bf16_t*)(ws + WS_WGLU + (size_t)l * SZ_WGLU), D, INW, GLUW, goff, tl); goff += 16 * 8;
        transpose_job<0>(a.in[20] + (size_t)l * 512 * 1152, (bf16_t*)(ws + WS_WUQ + (size_t)l * SZ_WUQ), 512, 1152, 1280, goff, tl); goff += 4 * 10;
        transpose_job<0>(a.in[22] + (size_t)l * 256 * 1536, (bf16_t*)(ws + WS_WUKV + (size_t)l * SZ_WUKV), 256, 1536, 1536, goff, tl); goff += 2 * 12;
        transpose_job<0>(a.in[18] + (size_t)l * 512 * 512, (bf16_t*)(ws + WS_WPW + (size_t)l * SZ_WPW), 512, 512, 512, goff, tl); goff += 4 * 4;
        if (defer) break;
        transpose_job<0>(a.in[12] + (size_t)l * D * D, (bf16_t*)(ws + WS_WOUT + (size_t)l * SZ_WOUT), D, D, D, goff, tl); goff += 16 * 16;
        transpose_job<1>(a.in[9] + (size_t)l * D * 2 * DFF, (bf16_t*)(ws + WS_WFFIN + (size_t)(l * 2 + 1) * SZ_WFFIN), D, 2 * DFF, 2 * DFF, goff, tl); goff += 16 * 88;
        transpose_job<0>(a.in[10] + (size_t)l * DFF * D, (bf16_t*)(ws + WS_WFFOUT + (size_t)(l * 2 + 1) * SZ_WFFOUT), DFF, D, D, goff, tl); goff += 44 * 16;
    }
}

constexpr int DJ_N[12] = {256, 1408, 704,   1408, 704, 544, 40, 24, 16, 256, 1408, 704};
constexpr int NDEF = 256 + 1408 + 704 + 1408 + 704 + 544 + 40 + 24 + 16 + 256 + 1408 + 704;
__device__ __forceinline__ void dj_decode(const Args& a, int d, const float*& src, bf16_t*& dst, int& K, int& Nsrc, int& Ndst, int& mode, int& t) {
    unsigned char* ws = a.ws; mode = 0; t = d;
    if (t < 256)  { src = a.in[12];                        dst = (bf16_t*)(ws + WS_WOUT);                  K = D;   Nsrc = D;       Ndst = D;       return; } t -= 256;
    if (t < 1408) { src = a.in[9];                         dst = (bf16_t*)(ws + WS_WFFIN + 1 * SZ_WFFIN);  K = D;   Nsrc = 2 * DFF; Ndst = 2 * DFF; mode = 1; return; } t -= 1408;
    if (t < 704)  { src = a.in[10];                        dst = (bf16_t*)(ws + WS_WFFOUT + 1 * SZ_WFFOUT); K = DFF; Nsrc = D;      Ndst = D;       return; } t -= 704;
    if (t < 1408) { src = a.in[7] + (size_t)D * 2 * DFF;   dst = (bf16_t*)(ws + WS_WFFIN + 2 * SZ_WFFIN);  K = D;   Nsrc = 2 * DFF; Ndst = 2 * DFF; mode = 1; return; } t -= 1408;
    if (t < 704)  { src = a.in[8] + (size_t)DFF * D;       dst = (bf16_t*)(ws + WS_WFFOUT + 2 * SZ_WFFOUT); K = DFF; Nsrc = D;      Ndst = D;       return; } t -= 704;
    if (t < 416)  { src = a.in[11] + (size_t)D * INW;      dst = (bf16_t*)(ws + WS_WIN + SZ_WIN);          K = D;   Nsrc = INW;     Ndst = INWP;    mode = 2; return; } t -= 416;
    if (t < 128)  { src = a.in[11] + (size_t)D * INW;      dst = (bf16_t*)(ws + WS_WGLU + SZ_WGLU);        K = D;   Nsrc = INW;     Ndst = GLUW;    mode = 3; return; } t -= 128;
    if (t < 40)   { src = a.in[20] + (size_t)512 * 1152;   dst = (bf16_t*)(ws + WS_WUQ + SZ_WUQ);          K = 512; Nsrc = 1152;    Ndst = 1280;    return; } t -= 40;
    if (t < 24)   { src = a.in[22] + (size_t)256 * 1536;   dst = (bf16_t*)(ws + WS_WUKV + SZ_WUKV);        K = 256; Nsrc = 1536;    Ndst = 1536;    return; } t -= 24;
    if (t < 16)   { src = a.in[18] + (size_t)512 * 512;    dst = (bf16_t*)(ws + WS_WPW + SZ_WPW);          K = 512; Nsrc = 512;     Ndst = 512;     return; } t -= 16;
    if (t < 256)  { src = a.in[12] + (size_t)D * D;        dst = (bf16_t*)(ws + WS_WOUT + SZ_WOUT);        K = D;   Nsrc = D;       Ndst = D;       return; } t -= 256;
    if (t < 1408) { src = a.in[9] + (size_t)D * 2 * DFF;   dst = (bf16_t*)(ws + WS_WFFIN + 3 * SZ_WFFIN);  K = D;   Nsrc = 2 * DFF; Ndst = 2 * DFF; mode = 1; return; } t -= 1408;
    src = a.in[10] + (size_t)DFF * D; dst = (bf16_t*)(ws + WS_WFFOUT + 3 * SZ_WFFOUT); K = DFF; Nsrc = D; Ndst = D;
}
__device__ __forceinline__ void deferred_convert(const Args& a, int first, int stride, int count, LAS float* tl) {
    const int tid = threadIdx.x, n4 = (tid & 31) * 4, kr = tid >> 5;
    f32x4 v[8];
#define DJ_ISSUE(dd) do { const float* src_; bf16_t* dst_; int K_, Ns_, Nd_, md_, t_; dj_decode(a, (dd), src_, dst_, K_, Ns_, Nd_, md_, t_); \
        const int ntn_ = Nd_ >> 7, tk_ = t_ / ntn_, tn_ = t_ % ntn_, k0_ = tk_ * 128, n_ = tn_ * 128 + n4; \
        const int scol_ = map_col(md_, n_); \
        const bool valid_ = scol_ < Ns_; const float* p_ = src_ + (size_t)(k0_ + kr) * Ns_ + scol_; \
        _Pragma("unroll") for (int i = 0; i < 8; ++i) v[i] = valid_ ? __builtin_nontemporal_load((const f32x4*)(p_ + (size_t)(16 * i) * Ns_)) : (f32x4){0.f, 0.f, 0.f, 0.f}; } while (0)
    int d = first;
    if (count > 0 && d < NDEF) DJ_ISSUE(d);
    for (int k = 0; k < count && d < NDEF; ++k, d += stride) {
        const float* src; bf16_t* dst; int K, Nsrc, Ndst, mode, t; dj_decode(a, d, src, dst, K, Nsrc, Ndst, mode, t);
        const int ntn = Ndst >> 7, tk = t / ntn, tn = t % ntn, k0 = tk * 128, n0 = tn * 128;
#pragma unroll
        for (int i = 0; i < 8; ++i) { LAS float* q = tl + (kr + 16 * i) * 129 + n4; q[0] = v[i][0]; q[1] = v[i][1]; q[2] = v[i][2]; q[3] = v[i][3]; }
        __syncthreads();
        if (k + 1 < count && d + stride < NDEF) DJ_ISSUE(d + stride);
#pragma unroll
        for (int i = 0; i < 4; ++i) { const int idx = tid + 512 * i, k8 = (idx & 15) * 8, n = idx >> 4; float x[8];
#pragma unroll
            for (int j = 0; j < 8; ++j) x[j] = tl[(k8 + j) * 129 + n];
            u32x4 w; w.x = cvt_pk_bf16(x[0], x[1]); w.y = cvt_pk_bf16(x[2], x[3]); w.z = cvt_pk_bf16(x[4], x[5]); w.w = cvt_pk_bf16(x[6], x[7]);
            *(u32x4*)(dst + (size_t)(n0 + n) * K + k0 + k8) = w; }
        __syncthreads();
    }
#undef DJ_ISSUE
}
constexpr int DW_START2 = 0,    DW_IDLE2 = 48,   DW_Q2 = 10;
constexpr int DW_START3 = DW_START2 + (256 - DW_IDLE2) * DW_Q2,   DW_IDLE3 = 128,  DW_Q3 = 6;
constexpr int DW_START5 = DW_START3 + (256 - DW_IDLE3) * DW_Q3,   DW_IDLE5 = 212,  DW_Q5 = 12;
constexpr int DW_START9 = DW_START5 + (256 - DW_IDLE5) * DW_Q5,   DW_IDLE9 = 216,  DW_Q9 = 22;
constexpr int DW_START10 = DW_START9 + (256 - DW_IDLE9) * DW_Q9,  DW_IDLE10 = 128, DW_Q10 = 2;
constexpr int DW_START12 = DW_START10 + (256 - DW_IDLE10) * DW_Q10, DW_IDLE12 = 48, DW_Q12 = 10;
constexpr int DW_START13 = DW_START12 + (256 - DW_IDLE12) * DW_Q12, DW_IDLE13 = 128, DW_Q13 = 8;
constexpr int DW_END = DW_START13 + (256 - DW_IDLE13) * DW_Q13;
static_assert(DW_START3 >= 256, "W_out(0) must be converted before phase 10");
static_assert(DW_START3 >= 256 + 1408, "FFN-b in (0) must be converted before phase 12");
static_assert(DW_START5 >= 256 + 1408 + 704, "FFN-b out (0) must be converted before phase 13");
static_assert(DW_END >= NDEF, "every deferred tile must be converted before layer 1 starts");
__device__ __forceinline__ void deferred_window(const Args& a, int l, int idle0, int start, int quota, LAS unsigned char* lds) {
    if (l != 0 || gridDim.x != DEFER_GRID || (int)blockIdx.x < idle0) return;
    deferred_convert(a, start + ((int)blockIdx.x - idle0), DEFER_GRID - idle0, quota, (LAS float*)lds);
}

__device__ __forceinline__ void norm_mod_store(const f32x4 (&x)[8], const float* g, const float* shift, const float* scale, bf16_t* hrow, int lane) {
    float ss = 0.f;
#pragma unroll
    for (int i = 0; i < 8; ++i) ss += (x[i][0] * x[i][0] + x[i][1] * x[i][1]) + (x[i][2] * x[i][2] + x[i][3] * x[i][3]);
    ss = wave_sum(ss);
    const float r = rsqrtf(ss * (1.f / 2048.f) + EPS);
#pragma unroll
    for (int i = 0; i < 8; ++i) { const int c = lane * 4 + i * 256;
        const f32x4 gv = *(const f32x4*)(g + c), sh = *(const f32x4*)(shift + c), sc = *(const f32x4*)(scale + c);
        const f32x4 h = (x[i] * r * gv) * (sc + 1.f) + sh;
        u32x2 w; w.x = cvt_pk_bf16(h[0], h[1]); w.y = cvt_pk_bf16(h[2], h[3]);
        *(u32x2*)(hrow + c) = w; }
}

__device__ __forceinline__ void phase_norm0(const Args& a, LAS unsigned char* lds) {
    const int tid = threadIdx.x, lane = tid & 63, wid = tid >> 6, G = gridDim.x;
    float* X = (float*)(a.ws + WS_X); bf16_t* H = (bf16_t*)(a.ws + WS_H); const float* MOD = (const float*)(a.ws + WS_MOD);
    const float* gpre = a.in[6];
    LAS float* G2 = (LAS float*)lds; LAS float* SH = G2 + D;
    const int per = (MR + G - 1) / G, r0 = (int)blockIdx.x * per, r1 = (r0 + per < MR) ? r0 + per : MR;
    if (r0 >= MR) return;
    const int m0 = mod_of_row(r0);
    { const float* md = MOD + (size_t)m0 * 18432; const int c = tid * 4;
      *(LAS f32x4*)(G2 + c) = *(const f32x4*)(gpre + c) * (*(const f32x4*)(md + D + c) + 1.f); *(LAS f32x4*)(SH + c) = *(const f32x4*)(md + c); }
    __syncthreads();
#define RC(k) (lane * 8 + ((k) >> 1) * 512 + ((k) & 1) * 4)
#define N0_LOAD(xx, rw) do { const float* src_ = (rw) < MLAT ? a.in[0] + (size_t)(rw) * D : a.in[2] + (size_t)((rw) - MLAT) * D; \
        _Pragma("unroll") for (int k = 0; k < 8; ++k) xx[k] = __builtin_nontemporal_load((const f32x4*)(src_ + RC(k))); } while (0)
    f32x4 x[8], xn[8];
    if (r0 + wid < r1) N0_LOAD(x, r0 + wid);
    for (int row = r0 + wid; row < r1; row += 8) {
        const int m = mod_of_row(row); const bool fast = (m == m0); const bool more = row + 8 < r1;
        if (more) N0_LOAD(xn, row + 8);
        const float* md = MOD + (size_t)m * 18432;
        float s2 = 0.f;
#pragma unroll
        for (int k = 0; k < 8; ++k) { *(f32x4*)(X + (size_t)row * D + RC(k)) = x[k]; s2 += (x[k][0] * x[k][0] + x[k][1] * x[k][1]) + (x[k][2] * x[k][2] + x[k][3] * x[k][3]); }
        s2 = wave_sum(s2);
        const float r2 = rsqrtf(s2 * (1.f / 2048.f) + EPS);
#pragma unroll
        for (int i = 0; i < 4; ++i) { f32x4 h[2];
#pragma unroll
            for (int hh = 0; hh < 2; ++hh) { const int k = 2 * i + hh, c = RC(k);
                const f32x4 g2 = fast ? *(const LAS f32x4*)(G2 + c) : *(const f32x4*)(gpre + c) * (*(const f32x4*)(md + D + c) + 1.f);
                const f32x4 sh = fast ? *(const LAS f32x4*)(SH + c) : *(const f32x4*)(md + c);
                h[hh] = x[k] * r2 * g2 + sh; }
            u32x4 w; w.x = cvt_pk_bf16(h[0][0], h[0][1]); w.y = cvt_pk_bf16(h[0][2], h[0][3]); w.z = cvt_pk_bf16(h[1][0], h[1][1]); w.w = cvt_pk_bf16(h[1][2], h[1][3]);
            *(u32x4*)(H + (size_t)row * D + lane * 8 + i * 512) = w; }
        if (more) {
#pragma unroll
            for (int k = 0; k < 8; ++k) x[k] = xn[k]; }
    }
#undef N0_LOAD
#undef RC
    __syncthreads();
}

__device__ __forceinline__ void phase_resnorm(const Args& a, int l, int gi_post, int mi_gate, float rs, bool has_next, int ln, int gi_pre, int mi_shift, int mi_scale, bool final_out, int M, LAS unsigned char* lds) {
    const float* YP = (const float*)(a.ws + WS_YP);
    const int tid = threadIdx.x, lane = tid & 63, wid = tid >> 6, G = gridDim.x;
    float* X = (float*)(a.ws + WS_X); const bf16_t* Y = (const bf16_t*)(a.ws + WS_Y); bf16_t* H = (bf16_t*)(a.ws + WS_H); const float* MOD = (const float*)(a.ws + WS_MOD);
    const float* gpost = a.in[6] + (size_t)(l * 6 + gi_post) * D; const float* gpre = a.in[6] + (size_t)(ln * 6 + gi_pre) * D;
    LAS float* GG = (LAS float*)lds; LAS float* G2 = GG + D; LAS float* SH = G2 + D;
    const int per = (M + G - 1) / G, r0 = (int)blockIdx.x * per, r1 = (r0 + per < M) ? r0 + per : M;
    if (r0 >= M) return;
    const int m0 = mod_of_row(r0);
    { const float* gate = MOD + ((size_t)l * 5 + m0) * 18432 + (size_t)mi_gate * D; const float* md = MOD + ((size_t)ln * 5 + m0) * 18432;
      const int c = tid * 4;
      const f32x4 gt = *(const f32x4*)(gate + c), gp = *(const f32x4*)(gpost + c);
      *(LAS f32x4*)(GG + c) = gt * rs * gp;
      if (has_next) { const f32x4 g = *(const f32x4*)(gpre + c), sc = *(const f32x4*)(md + (size_t)mi_scale * D + c), sh = *(const f32x4*)(md + (size_t)mi_shift * D + c);
          *(LAS f32x4*)(G2 + c) = g * (sc + 1.f); *(LAS f32x4*)(SH + c) = sh; } }
    __syncthreads();
#define RC(k) (lane * 8 + ((k) >> 1) * 512 + ((k) & 1) * 4)
#define RN_LOAD(xx, yy, rw) do { _Pragma("unroll") for (int k = 0; k < 8; ++k) xx[k] = *(const f32x4*)(X + (size_t)(rw) * D + RC(k)); \
        if ((rw) < MLAT) { _Pragma("unroll") for (int i = 0; i < 4; ++i) { const u32x4 w = *(const u32x4*)(Y + (size_t)(rw) * D + lane * 8 + i * 512); \
                yy[2 * i] = (f32x4){__uint_as_float(w.x << 16), __uint_as_float(w.x & 0xffff0000u), __uint_as_float(w.y << 16), __uint_as_float(w.y & 0xffff0000u)}; \
                yy[2 * i + 1] = (f32x4){__uint_as_float(w.z << 16), __uint_as_float(w.z & 0xffff0000u), __uint_as_float(w.w << 16), __uint_as_float(w.w & 0xffff0000u)}; } } \
        else { _Pragma("unroll") for (int k = 0; k < 8; ++k) { const float* yp = YP + (size_t)((rw) - MLAT) * D + RC(k); yy[k] = (*(const f32x4*)yp + *(const f32x4*)(yp + (size_t)MCTX * D)) + (*(const f32x4*)(yp + (size_t)2 * MCTX * D) + *(const f32x4*)(yp + (size_t)3 * MCTX * D)); } } } while (0)
    f32x4 y[8], x[8], yn[8], xn[8];
    if (r0 + wid < r1) RN_LOAD(x, y, r0 + wid);
    for (int row = r0 + wid; row < r1; row += 8) {
        const int m = mod_of_row(row); const bool fast = (m == m0);
        const bool more = row + 8 < r1;
        if (more) RN_LOAD(xn, yn, row + 8);
        float ss = 0.f;
#pragma unroll
        for (int i = 0; i < 8; ++i) ss += (y[i][0] * y[i][0] + y[i][1] * y[i][1]) + (y[i][2] * y[i][2] + y[i][3] * y[i][3]);
        ss = wave_sum(ss);
        const float r = rsqrtf(ss * (1.f / 2048.f) + EPS);
        const float* gate = MOD + ((size_t)l * 5 + m) * 18432 + (size_t)mi_gate * D; const float* md = MOD + ((size_t)ln * 5 + m) * 18432;
        float s2 = 0.f;
#pragma unroll
        for (int i = 0; i < 8; ++i) { const int c = RC(i);
            const f32x4 gg = fast ? *(const LAS f32x4*)(GG + c) : *(const f32x4*)(gate + c) * rs * *(const f32x4*)(gpost + c);
            x[i] = x[i] + gg * (y[i] * r);
            if (final_out) __builtin_nontemporal_store(x[i], (f32x4*)(a.out + (size_t)row * D + c)); else *(f32x4*)(X + (size_t)row * D + c) = x[i];
            s2 += (x[i][0] * x[i][0] + x[i][1] * x[i][1]) + (x[i][2] * x[i][2] + x[i][3] * x[i][3]); }
        if (has_next) {
            s2 = wave_sum(s2);
            const float r2 = rsqrtf(s2 * (1.f / 2048.f) + EPS);
#pragma unroll
            for (int i = 0; i < 4; ++i) { f32x4 h[2];
#pragma unroll
                for (int hh = 0; hh < 2; ++hh) { const int k = 2 * i + hh, c = RC(k);
                    const f32x4 g2 = fast ? *(const LAS f32x4*)(G2 + c) : *(const f32x4*)(gpre + c) * (*(const f32x4*)(md + (size_t)mi_scale * D + c) + 1.f);
                    const f32x4 sh = fast ? *(const LAS f32x4*)(SH + c) : *(const f32x4*)(md + (size_t)mi_shift * D + c);
                    h[hh] = x[k] * r2 * g2 + sh; }
                u32x4 w; w.x = cvt_pk_bf16(h[0][0], h[0][1]); w.y = cvt_pk_bf16(h[0][2], h[0][3]); w.z = cvt_pk_bf16(h[1][0], h[1][1]); w.w = cvt_pk_bf16(h[1][2], h[1][3]);
                *(u32x4*)(H + (size_t)row * D + lane * 8 + i * 512) = w; } }
        if (more) {
#pragma unroll
            for (int i = 0; i < 8; ++i) { x[i] = xn[i]; y[i] = yn[i]; } }
    }
#undef RC
#undef RN_LOAD
    __syncthreads();
}

struct EpiF32 {
    static constexpr bool PERM = false, AFTER_DRAIN = false;
    float* C; int ldc;
    __device__ __forceinline__ void operator()(const f32x4 (&acc)[2][2][4][2], const Unit& u, int wr, int wc, int fr, int fq) const {
        const int row0 = u.pm * BM + wr * 64 + fr, col0 = u.pn * BM + wc * 32 + 4 * fq;
#pragma unroll
        for (int ai = 0; ai < 2; ++ai)
#pragma unroll
            for (int m = 0; m < 4; ++m) { float* rowp = C + (size_t)(row0 + ai * HALF + m * 16) * ldc + col0;
#pragma unroll
                for (int bj = 0; bj < 2; ++bj)
#pragma unroll
                    for (int n = 0; n < 2; ++n) *(f32x4*)(rowp + bj * HALF + n * 16) = acc[ai][bj][m][n]; }
    }
};
struct EpiSwiGLU {
    static constexpr bool PERM = true, AFTER_DRAIN = false;
    bf16_t* O; int ldc;
    __device__ __forceinline__ void operator()(const f32x4 (&acc)[2][2][4][2], const Unit& u, int wr, int wc, int fr, int fq) const {
        const int row0 = u.pm * BM + wr * 64 + fr, col0 = u.pn * 128 + wc * 32 + 8 * fq;
#pragma unroll
        for (int ai = 0; ai < 2; ++ai)
#pragma unroll
            for (int m = 0; m < 4; ++m) { bf16_t* rowp = O + (size_t)(row0 + ai * HALF + m * 16) * ldc + col0; float v[8];
#pragma unroll
                for (int n = 0; n < 2; ++n)
#pragma unroll
                    for (int j = 0; j < 4; ++j) v[4 * n + j] = siluf(acc[ai][0][m][n][j]) * acc[ai][1][m][n][j];
                u32x4 w; w.x = cvt_pk_bf16(v[0], v[1]); w.y = cvt_pk_bf16(v[2], v[3]); w.z = cvt_pk_bf16(v[4], v[5]); w.w = cvt_pk_bf16(v[6], v[7]);
                *(u32x4*)rowp = w; }
    }
};
struct EpiBf16 {
    static constexpr bool PERM = true, AFTER_DRAIN = false;
    bf16_t* O; int ldc;
    __device__ __forceinline__ void operator()(const f32x4 (&acc)[2][2][4][2], const Unit& u, int wr, int wc, int fr, int fq) const {
        const int row0 = u.pm * BM + wr * 64 + fr, col0 = u.pn * BM + wc * 32 + 8 * fq;
#pragma unroll
        for (int ai = 0; ai < 2; ++ai)
#pragma unroll
            for (int m = 0; m < 4; ++m) { bf16_t* rowp = O + (size_t)(row0 + ai * HALF + m * 16) * ldc + col0;
#pragma unroll
                for (int bj = 0; bj < 2; ++bj) { const f32x4 v0 = acc[ai][bj][m][0], v1 = acc[ai][bj][m][1];
                    u32x4 w; w.x = cvt_pk_bf16(v0[0], v0[1]); w.y = cvt_pk_bf16(v0[2], v0[3]); w.z = cvt_pk_bf16(v1[0], v1[1]); w.w = cvt_pk_bf16(v1[2], v1[3]);
                    *(u32x4*)(rowp + bj * HALF) = w; } }
    }
};

template <class Epi>
__device__ __forceinline__ void run_gemm(LAS unsigned char* lds, const bf16_t* A, const bf16_t* Bt, int M, int N, int K, const Epi& E, int rot, int ld = 0, int msplit = 0, int gsub = 0, int csub = 0) {
    Gemm g; g.A = A; g.Bt = Bt; g.M = M; g.N = N; g.K = K; g.ld = ld ? ld : K; g.msplit = msplit;
    StaticOrder S; const int G = gridDim.x; if (gsub) S.init(M, N, gsub, csub); else S.init(M, N, G, (int)((blockIdx.x + rot) % G));
    gemm_phase<Epi, StaticOrder, false>(lds, g, S, E, nullptr);
    __syncthreads();
}

__device__ __forceinline__ void phase_prep(const Args& a, int l) {
    const int lane = threadIdx.x & 63, gw = blockIdx.x * 8 + (threadIdx.x >> 6), nw = gridDim.x * 8;
    const bf16_t* P = (const bf16_t*)(a.ws + WS_P); const f32x2* tab = (const f32x2*)(a.ws + WS_TAB);
    float* QR = (float*)(a.ws + WS_QR);
    bf16_t* CQN = (bf16_t*)(a.ws + WS_CQN); bf16_t* CKVN = (bf16_t*)(a.ws + WS_CKVN); bf16_t* KB = (bf16_t*)(a.ws + WS_KB);
    const float* qn = a.in[19] + l * 512; const float* kvn = a.in[21] + l * 256;
    const int i = lane & 31;
    for (int row0 = gw; row0 < MR; row0 += 2 * nw) {
        float q1[2][3], q2[2][3], k1[2], k2[2], cs[2], sn[2]; f32x4 cq0[2], cq1[2], ckv[2]; int rw[2]; bool ok[2];
#pragma unroll
        for (int s2 = 0; s2 < 2; ++s2) { const int r = row0 + s2 * nw; ok[s2] = r < MR; rw[s2] = ok[s2] ? r : row0;
            const int row = rw[s2]; const bool latent = row < MLAT; const int t = latent ? (row & 2047) : 0;
            const bf16_t* pr = P + (size_t)row * INWP;
            const f32x2 cv = tab[t * 32 + i]; cs[s2] = latent ? cv.x : 1.f; sn[s2] = latent ? cv.y : 0.f;
#pragma unroll
            for (int j = 0; j < 3; ++j) { const int hh = (lane >> 5) + 2 * j; q1[s2][j] = bf2f(pr[OFF_RQ + hh * 64 + i]); q2[s2][j] = bf2f(pr[OFF_RQ + hh * 64 + 32 + i]); }
            cq0[s2] = ld_bf4(pr + OFF_CQ + lane * 4); cq1[s2] = ld_bf4(pr + OFF_CQ + 256 + lane * 4); ckv[s2] = ld_bf4(pr + OFF_CKV + lane * 4);
            k1[s2] = bf2f(pr[OFF_KR + i]); k2[s2] = bf2f(pr[OFF_KR + 32 + i]); }
#pragma unroll
        for (int s2 = 0; s2 < 2; ++s2) { if (!ok[s2]) continue;
            const int row = rw[s2]; const bool latent = row < MLAT;
            const int b = latent ? (row >> 11) : ((row - MLAT) >> 8), t = latent ? (row & 2047) : ((row - MLAT) & 255), ki = latent ? 256 + t : t;
#pragma unroll
            for (int j = 0; j < 3; ++j) { const int hh = (lane >> 5) + 2 * j;
                QR[(size_t)row * 384 + hh * 64 + i] = q1[s2][j] * cs[s2] - q2[s2][j] * sn[s2]; QR[(size_t)row * 384 + hh * 64 + 32 + i] = q1[s2][j] * sn[s2] + q2[s2][j] * cs[s2]; }
            { f32x4 v0 = cq0[s2], v1 = cq1[s2];
              float ss = (v0[0] * v0[0] + v0[1] * v0[1]) + (v0[2] * v0[2] + v0[3] * v0[3]) + (v1[0] * v1[0] + v1[1] * v1[1]) + (v1[2] * v1[2] + v1[3] * v1[3]);
              ss = wave_sum(ss); const float r = rsqrtf(ss * (1.f / 512.f) + EPS);
              const f32x4 g0 = *(const f32x4*)(qn + lane * 4), g1 = *(const f32x4*)(qn + 256 + lane * 4);
              v0 = v0 * r * g0; v1 = v1 * r * g1;
              u32x2 w; w.x = cvt_pk_bf16(v0[0], v0[1]); w.y = cvt_pk_bf16(v0[2], v0[3]); *(u32x2*)(CQN + (size_t)row * 512 + lane * 4) = w;
              w.x = cvt_pk_bf16(v1[0], v1[1]); w.y = cvt_pk_bf16(v1[2], v1[3]); *(u32x2*)(CQN + (size_t)row * 512 + 256 + lane * 4) = w; }
            { f32x4 v0 = ckv[s2];
              float ss = (v0[0] * v0[0] + v0[1] * v0[1]) + (v0[2] * v0[2] + v0[3] * v0[3]);
              ss = wave_sum(ss); const float r = rsqrtf(ss * (1.f / 256.f) + EPS);
              const f32x4 g0 = *(const f32x4*)(kvn + lane * 4);
              v0 = v0 * r * g0;
              u32x2 w; w.x = cvt_pk_bf16(v0[0], v0[1]); w.y = cvt_pk_bf16(v0[2], v0[3]); *(u32x2*)(CKVN + (size_t)row * 256 + lane * 4) = w; }
            { const bf16_t o1 = f2bf(k1[s2] * cs[s2] - k2[s2] * sn[s2]), o2 = f2bf(k1[s2] * sn[s2] + k2[s2] * cs[s2]);
              const int h0 = (lane >> 5) * 3;
#pragma unroll
              for (int hh = 0; hh < 3; ++hh) { bf16_t* kp = KB + ((size_t)(b * 6 + h0 + hh) * NKEY + ki) * 192; kp[128 + i] = o1; kp[160 + i] = o2; } } }
    }
}

__device__ __forceinline__ void phase_conv(const Args& a, int l, LAS unsigned char* lds) {
    const int tid = threadIdx.x, lane = tid & 63, wid = tid >> 6;
    const bf16_t* PG = (const bf16_t*)(a.ws + WS_PG); bf16_t* CVN = (bf16_t*)(a.ws + WS_CVN);
    LAS float* red = (LAS float*)lds;
    LAS float* fin = (LAS float*)(lds + 1024);
    float dwc[31];
#pragma unroll
    for (int w = 0; w < 31; ++w) dwc[w] = a.in[14][(size_t)(l * 31 + w) * 512 + tid];
    const float bias = a.in[15][l * 512 + tid], lg = a.in[16][l * 512 + tid], lb = a.in[17][l * 512 + tid];
    for (int it = gridDim.x - 1 - blockIdx.x; it < MR / 16; it += gridDim.x) {
        const int row0 = it * 16;
        int s0, s1; if (row0 < MLAT) { s0 = (row0 >> 11) << 11; s1 = s0 + 2048; } else { s0 = MLAT + (((row0 - MLAT) >> 8) << 8); s1 = s0 + 256; }
        float acc[16], rv[32];
#pragma unroll
        for (int j = 0; j < 16; ++j) acc[j] = bias;
#pragma unroll
        for (int i = 0; i < 46; ++i) { const int r = row0 - 15 + i; const bool ok = (r >= s0 && r < s1); const int rc = ok ? r : row0;
            const float av = bf2f(PG[(size_t)rc * GLUW + tid]), gv = bf2f(PG[(size_t)rc * GLUW + 512 + tid]);
            const float u = ok ? av * sigmf(gv) : 0.f;
#pragma unroll
            for (int j = 0; j < 16; ++j) { const int w = i - j; if (w >= 0 && w <= 30) acc[j] += u * dwc[w]; } }
#pragma unroll
        for (int j = 0; j < 16; ++j) { rv[2 * j] = acc[j]; rv[2 * j + 1] = acc[j] * acc[j]; }
#pragma unroll
        for (int k = 0; k < 16; ++k) { const bool up = (lane & 32) != 0; const float keep = up ? rv[k + 16] : rv[k], send = up ? rv[k] : rv[k + 16]; rv[k] = keep + __shfl_xor(send, 32); }
#pragma unroll
        for (int k = 0; k < 8; ++k) { const bool up = (lane & 16) != 0; const float keep = up ? rv[k + 8] : rv[k], send = up ? rv[k] : rv[k + 8]; rv[k] = keep + __shfl_xor(send, 16); }
#pragma unroll
        for (int k = 0; k < 4; ++k) { const bool up = (lane & 8) != 0; const float keep = up ? rv[k + 4] : rv[k], send = up ? rv[k] : rv[k + 4]; rv[k] = keep + __shfl_xor(send, 8); }
#pragma unroll
        for (int k = 0; k < 2; ++k) { const bool up = (lane & 4) != 0; const float keep = up ? rv[k + 2] : rv[k], send = up ? rv[k] : rv[k + 2]; rv[k] = keep + __shfl_xor(send, 4); }
        { const bool up = (lane & 2) != 0; const float keep = up ? rv[1] : rv[0], send = up ? rv[0] : rv[1]; rv[0] = keep + __shfl_xor(send, 2); }
        rv[0] += __shfl_xor(rv[0], 1);
        if ((lane & 1) == 0) red[wid * 32 + (lane >> 1)] = rv[0];
        __syncthreads();
        if (tid < 32) { float s = 0.f;
#pragma unroll
            for (int w = 0; w < 8; ++w) s += red[w * 32 + tid];
            fin[tid] = s; }
        __syncthreads();
#pragma unroll
        for (int j = 0; j < 16; ++j) { const float mean = fin[2 * j] * (1.f / 512.f), var = fin[2 * j + 1] * (1.f / 512.f) - mean * mean;
            const float y = (acc[j] - mean) * rsqrtf(fmaxf(var, 0.f) + EPS) * lg + lb;
            CVN[(size_t)(row0 + j) * 512 + tid] = f2bf(siluf(y)); }
        __syncthreads();
    }
}

__device__ __forceinline__ void phase_ret_local(const Args& a, LAS unsigned char* lds) {
    const int tid = threadIdx.x;
    const bf16_t* P = (const bf16_t*)(a.ws + WS_P); const f32x2* tab = (const f32x2*)(a.ws + WS_TAB);
    float* SF = (float*)(a.ws + WS_SF); float* SB = (float*)(a.ws + WS_SB);
    LAS float* kl = (LAS float*)lds;
    LAS float* vl = kl + 128 * 64;
    LAS float* wl = vl + 128 * 128;
    for (int it = blockIdx.x; it < 24 * NCH; it += gridDim.x) {
        const int cidx = it % NCH, bh = it / NCH, b = bh / 6, h = bh % 6;
        const bool latent = cidx >= 2;
        const int rowbase = latent ? b * 2048 + (cidx - 2) * 128 : MLAT + b * 256 + cidx * 128, t0 = latent ? (cidx - 2) * 128 : 0;
        const float l2g = log2f(1.f - exp2f(-5.f - (float)h));
#pragma unroll
        for (int j = 0; j < 8; ++j) { const int idx = tid + 512 * j, t = idx >> 5, i = idx & 31;
            const float x1 = bf2f(P[(size_t)(rowbase + t) * INWP + OFF_RK + h * 64 + i]), x2 = bf2f(P[(size_t)(rowbase + t) * INWP + OFF_RK + h * 64 + 32 + i]);
            float cs, sn; rope_cs(tab, i, t0 + t, latent, cs, sn);
            kl[t * 64 + i] = (x1 * cs - x2 * sn) * 0.125f; kl[t * 64 + 32 + i] = (x1 * sn + x2 * cs) * 0.125f; }
#pragma unroll
        for (int ii = 0; ii < 8; ++ii) { const int idx = tid + 512 * ii, j = idx >> 5, c4 = idx & 31;
            *(LAS f32x4*)(vl + j * 128 + c4 * 4) = ld_bf4(P + (size_t)(rowbase + j) * INWP + OFF_RV + h * 128 + c4 * 4); }
        if (tid < 256) { const int t = tid & 127; wl[tid] = exp2f(l2g * (float)(tid < 128 ? 127 - t : t)); }
        __syncthreads();
        { const int lane = tid & 63, wid = tid >> 6, fr = lane & 15, fq = lane >> 4;
          f32x4 accF[4], accB[4];
#pragma unroll
          for (int db = 0; db < 4; ++db) { accF[db] = (f32x4){0.f, 0.f, 0.f, 0.f}; accB[db] = (f32x4){0.f, 0.f, 0.f, 0.f}; }
#pragma unroll
          for (int ks = 0; ks < 4; ++ks) { const int t0q = ks * 32 + fq * 8; float vv[8], wfv[8], wbv[8];
#pragma unroll
              for (int j = 0; j < 8; ++j) { vv[j] = vl[(t0q + j) * 128 + wid * 16 + fr]; wfv[j] = wl[t0q + j]; wbv[j] = wl[128 + t0q + j]; }
              u32x4 w; w.x = cvt_pk_bf16(vv[0], vv[1]); w.y = cvt_pk_bf16(vv[2], vv[3]); w.z = cvt_pk_bf16(vv[4], vv[5]); w.w = cvt_pk_bf16(vv[6], vv[7]);
              const bf16x8 vb = __builtin_bit_cast(bf16x8, w);
#pragma unroll
              for (int db = 0; db < 4; ++db) { float kk[8];
#pragma unroll
                  for (int j = 0; j < 8; ++j) kk[j] = kl[(t0q + j) * 64 + db * 16 + fr];
                  w.x = cvt_pk_bf16(kk[0] * wfv[0], kk[1] * wfv[1]); w.y = cvt_pk_bf16(kk[2] * wfv[2], kk[3] * wfv[3]); w.z = cvt_pk_bf16(kk[4] * wfv[4], kk[5] * wfv[5]); w.w = cvt_pk_bf16(kk[6] * wfv[6], kk[7] * wfv[7]);
                  accF[db] = __builtin_amdgcn_mfma_f32_16x16x32_bf16(__builtin_bit_cast(bf16x8, w), vb, accF[db], 0, 0, 0);
                  w.x = cvt_pk_bf16(kk[0] * wbv[0], kk[1] * wbv[1]); w.y = cvt_pk_bf16(kk[2] * wbv[2], kk[3] * wbv[3]); w.z = cvt_pk_bf16(kk[4] * wbv[4], kk[5] * wbv[5]); w.w = cvt_pk_bf16(kk[6] * wbv[6], kk[7] * wbv[7]);
                  accB[db] = __builtin_amdgcn_mfma_f32_16x16x32_bf16(__builtin_bit_cast(bf16x8, w), vb, accB[db], 0, 0, 0); } }
          float* fo = SF + ((size_t)bh * NCH + cidx) * 8192 + (wid * 16 + fr) * 64 + fq * 4; float* go = SB + ((size_t)bh * NCH + cidx) * 8192 + (wid * 16 + fr) * 64 + fq * 4;
#pragma unroll
          for (int db = 0; db < 4; ++db) { *(f32x4*)(fo + db * 16) = accF[db]; *(f32x4*)(go + db * 16) = accB[db]; } }
        { bf16_t* rk = (bf16_t*)(a.ws + WS_RKB) + ((size_t)bh * NCH + cidx) * 8192; const int tok = tid >> 2, d0 = (tid & 3) * 16;
#pragma unroll
          for (int hq = 0; hq < 2; ++hq) { const f32x4 x0 = *(const LAS f32x4*)(kl + tok * 64 + d0 + hq * 8), x1 = *(const LAS f32x4*)(kl + tok * 64 + d0 + hq * 8 + 4);
              u32x4 w; w.x = cvt_pk_bf16(x0[0], x0[1]); w.y = cvt_pk_bf16(x0[2], x0[3]); w.z = cvt_pk_bf16(x1[0], x1[1]); w.w = cvt_pk_bf16(x1[2], x1[3]);
              *(u32x4*)(rk + tok * 64 + d0 + hq * 8) = w; } }
        { bf16_t* rv = (bf16_t*)(a.ws + WS_RVT) + ((size_t)bh * NCH + cidx) * 16384; const int dv = tid & 127, tg = tid >> 7;
#pragma unroll
          for (int i = 0; i < 4; ++i) { const int t0q = tg * 32 + i * 8; float x[8];
#pragma unroll
              for (int j = 0; j < 8; ++j) x[j] = vl[(t0q + j) * 128 + dv];
              u32x4 w; w.x = cvt_pk_bf16(x[0], x[1]); w.y = cvt_pk_bf16(x[2], x[3]); w.z = cvt_pk_bf16(x[4], x[5]); w.w = cvt_pk_bf16(x[6], x[7]);
              *(u32x4*)(rv + dv * 128 + t0q) = w; } }
        __syncthreads();
    }
}
__device__ __forceinline__ void phase_ret_combine(const Args& a) {
    for (int e = blockIdx.x * NTHR + threadIdx.x; e < 24 * 2 * 2048; e += gridDim.x * NTHR) {
        const int q = e & 2047, bhd = e >> 11, dir = bhd & 1, bh = bhd >> 1, h = bh % 6;
        const float gC = exp2f(128.f * log2f(1.f - exp2f(-5.f - (float)h)));
        float* base = (float*)(a.ws + (dir ? WS_SB : WS_SF)) + (size_t)bh * NCH * 8192 + q * 4;
        f32x4 F[NCH];
#pragma unroll
        for (int c = 0; c < NCH; ++c) F[c] = *(const f32x4*)(base + (size_t)c * 8192);
        f32x4 S = {0.f, 0.f, 0.f, 0.f};
        if (dir == 0) {
#pragma unroll
            for (int c = 0; c < NCH; ++c) { *(f32x4*)(base + (size_t)c * 8192) = S; S = S * gC + F[c]; }
        } else {
#pragma unroll
            for (int st = 0; st < NCH; ++st) { const int c = st < 2 ? 1 - st : 19 - st; *(f32x4*)(base + (size_t)c * 8192) = S; S = S * gC + F[c]; }
        }
    }
}

constexpr int RK_STRIDE = 144, RV_STRIDE = 272;
__device__ __forceinline__ void phase_ret_out(const Args& a, int l, LAS unsigned char* lds) {
    const int tid = threadIdx.x, lane = tid & 63, wid = tid >> 6, fr = lane & 15, fq = lane >> 4;
    const bf16_t* P = (const bf16_t*)(a.ws + WS_P); const float* QR = (const float*)(a.ws + WS_QR);
    const float* SF = (const float*)(a.ws + WS_SF); const float* SB = (const float*)(a.ws + WS_SB); bf16_t* CAT = (bf16_t*)(a.ws + WS_CAT);
    LAS unsigned char* Kb = lds;
    LAS unsigned char* Vt = Kb + 128 * RK_STRIDE;
    LAS unsigned char* St = Vt + 128 * RV_STRIDE;
    const int nch = (l == 0) ? 18 : 16, nitem = 24 * nch;
    for (int it = blockIdx.x; it < nitem; it += gridDim.x) {
        const int c = it % nch, bh = it / nch, cidx = c + (18 - nch), b = bh / 6, h = bh % 6;
        const int rowbase = cidx < 2 ? MLAT + b * 256 + cidx * 128 : b * 2048 + (cidx - 2) * 128;
        const float l2g = log2f(1.f - exp2f(-5.f - (float)h));
        { const bf16_t* rk = (const bf16_t*)(a.ws + WS_RKB) + ((size_t)bh * NCH + cidx) * 8192;
          const bf16_t* rv = (const bf16_t*)(a.ws + WS_RVT) + ((size_t)bh * NCH + cidx) * 16384;
          const float* sf = SF + ((size_t)bh * NCH + cidx) * 8192; const float* sb = SB + ((size_t)bh * NCH + cidx) * 8192;
#pragma unroll
          for (int i = 0; i < 2; ++i) { const int idx = tid + 512 * i, r = idx >> 3, cc = idx & 7; *(LAS u32x4*)(Kb + r * RK_STRIDE + cc * 16) = *(const u32x4*)(rk + r * 64 + cc * 8); }
#pragma unroll
          for (int i = 0; i < 4; ++i) { const int idx = tid + 512 * i, r = idx >> 4, cc = idx & 15; *(LAS u32x4*)(Vt + r * RV_STRIDE + cc * 16) = *(const u32x4*)(rv + r * 128 + cc * 8); }
#pragma unroll
          for (int i = 0; i < 4; ++i) { const int idx = tid + 512 * i, r = idx >> 4, c4 = idx & 15;
              const f32x4 f4 = *(const f32x4*)(sf + r * 64 + c4 * 4), b4 = *(const f32x4*)(sb + r * 64 + c4 * 4);
              u32x2 w; w.x = cvt_pk_bf16(f4[0], f4[1]); w.y = cvt_pk_bf16(f4[2], f4[3]); *(LAS u32x2*)(St + r * RV_STRIDE + c4 * 8) = w;
              w.x = cvt_pk_bf16(b4[0], b4[1]); w.y = cvt_pk_bf16(b4[2], b4[3]); *(LAS u32x2*)(St + r * RV_STRIDE + 128 + c4 * 8) = w; } }
        const int il = wid * 16 + fr, row = rowbase + il;
        f32x4 qv[2][2];
#pragma unroll
        for (int ks = 0; ks < 2; ++ks) { qv[ks][0] = *(const f32x4*)(QR + (size_t)row * 384 + h * 64 + ks * 32 + fq * 8); qv[ks][1] = *(const f32x4*)(QR + (size_t)row * 384 + h * 64 + ks * 32 + fq * 8 + 4); }
        const float wf = exp2f(l2g * (float)(il + 1)), wb = exp2f(l2g * (float)(128 - il));
        bf16x8 qb[2], qw[4];
#pragma unroll
        for (int ks = 0; ks < 2; ++ks) { const f32x4 x0 = qv[ks][0], x1 = qv[ks][1]; u32x4 w;
            w.x = cvt_pk_bf16(x0[0], x0[1]); w.y = cvt_pk_bf16(x0[2], x0[3]); w.z = cvt_pk_bf16(x1[0], x1[1]); w.w = cvt_pk_bf16(x1[2], x1[3]); qb[ks] = __builtin_bit_cast(bf16x8, w);
            const f32x4 y0 = x0 * wf, y1 = x1 * wf, z0 = x0 * wb, z1 = x1 * wb;
            w.x = cvt_pk_bf16(y0[0], y0[1]); w.y = cvt_pk_bf16(y0[2], y0[3]); w.z = cvt_pk_bf16(y1[0], y1[1]); w.w = cvt_pk_bf16(y1[2], y1[3]); qw[ks] = __builtin_bit_cast(bf16x8, w);
            w.x = cvt_pk_bf16(z0[0], z0[1]); w.y = cvt_pk_bf16(z0[2], z0[3]); w.z = cvt_pk_bf16(z1[0], z1[1]); w.w = cvt_pk_bf16(z1[2], z1[3]); qw[2 + ks] = __builtin_bit_cast(bf16x8, w); }
        __syncthreads();
        bf16x8 pf[4];
#pragma unroll
        for (int p = 0; p < 4; ++p) { f32x4 s0 = {0.f, 0.f, 0.f, 0.f}, s1 = {0.f, 0.f, 0.f, 0.f};
            const int kr0 = p * 32 + (fr >> 2) * 8 + (fr & 3);
#pragma unroll
            for (int ks = 0; ks < 2; ++ks) { const bf16x8 k0 = *(const LAS bf16x8*)(Kb + kr0 * RK_STRIDE + ks * 64 + fq * 16), k1 = *(const LAS bf16x8*)(Kb + (kr0 + 4) * RK_STRIDE + ks * 64 + fq * 16);
                s0 = __builtin_amdgcn_mfma_f32_16x16x32_bf16(k0, qb[ks], s0, 0, 0, 0); s1 = __builtin_amdgcn_mfma_f32_16x16x32_bf16(k1, qb[ks], s1, 0, 0, 0); }
#pragma unroll
            for (int j = 0; j < 4; ++j) { const int k0i = p * 32 + fq * 8 + j, k1i = k0i + 4; const int d0 = il > k0i ? il - k0i : k0i - il, d1 = il > k1i ? il - k1i : k1i - il;
                s0[j] *= exp2f(l2g * (float)d0); s1[j] *= exp2f(l2g * (float)d1); }
            u32x4 w; w.x = cvt_pk_bf16(s0[0], s0[1]); w.y = cvt_pk_bf16(s0[2], s0[3]); w.z = cvt_pk_bf16(s1[0], s1[1]); w.w = cvt_pk_bf16(s1[2], s1[3]); pf[p] = __builtin_bit_cast(bf16x8, w); }
        f32x4 o[8];
#pragma unroll
        for (int db = 0; db < 8; ++db) o[db] = (f32x4){0.f, 0.f, 0.f, 0.f};
#pragma unroll
        for (int p = 0; p < 4; ++p)
#pragma unroll
            for (int db = 0; db < 8; ++db) { const bf16x8 vf = *(const LAS bf16x8*)(Vt + (db * 16 + fr) * RV_STRIDE + p * 64 + fq * 16), sfr = *(const LAS bf16x8*)(St + (db * 16 + fr) * RV_STRIDE + p * 64 + fq * 16);
                o[db] = __builtin_amdgcn_mfma_f32_16x16x32_bf16(vf, pf[p], o[db], 0, 0, 0);
                o[db] = __builtin_amdgcn_mfma_f32_16x16x32_bf16(sfr, qw[p], o[db], 0, 0, 0); }
        float sm = 0.f;
#pragma unroll
        for (int db = 0; db < 8; ++db) sm += (o[db][0] + o[db][1]) + (o[db][2] + o[db][3]);
        sm += __shfl_xor(sm, 16); sm += __shfl_xor(sm, 32);
        const float mu = sm * (1.f / 128.f); float qd = 0.f;
#pragma unroll
        for (int db = 0; db < 8; ++db) { o[db] = o[db] - mu; qd += (o[db][0] * o[db][0] + o[db][1] * o[db][1]) + (o[db][2] * o[db][2] + o[db][3] * o[db][3]); }
        qd += __shfl_xor(qd, 16); qd += __shfl_xor(qd, 32);
        const float rstd = rsqrtf(qd * (1.f / 128.f) + EPS);
#pragma unroll
        for (int db = 0; db < 8; ++db) { const int cc = h * 128 + db * 16 + fq * 4;
            const f32x4 rg = ld_bf4(P + (size_t)row * INWP + OFF_RG + cc), gn4 = *(const f32x4*)(a.in[13] + l * 768 + cc); float v[4];
#pragma unroll
            for (int e = 0; e < 4; ++e) v[e] = siluf(rg[e]) * (o[db][e] * rstd * gn4[e]);
            u32x2 w; w.x = cvt_pk_bf16(v[0], v[1]); w.y = cvt_pk_bf16(v[2], v[3]);
            *(u32x2*)(CAT + (size_t)row * D + cc) = w; }
        __syncthreads();
    }
}

__device__ __forceinline__ void phase_post(const Args& a) {
    const int lane = threadIdx.x & 63, gw = blockIdx.x * 8 + (threadIdx.x >> 6), nw = gridDim.x * 8;
    const bf16_t* QF = (const bf16_t*)(a.ws + WS_QF); const bf16_t* KVF = (const bf16_t*)(a.ws + WS_KVF);
    bf16_t* QB = (bf16_t*)(a.ws + WS_QB); bf16_t* KB = (bf16_t*)(a.ws + WS_KB); bf16_t* VT = (bf16_t*)(a.ws + WS_VT);
    const float qscale = 0.07216878364870322f * 1.4426950408889634f;
    for (int wi = gw; wi < MR / 8; wi += nw) {
        const int r0 = wi * 8; const bool latent = r0 < MLAT;
        const int b = latent ? (r0 >> 11) : ((r0 - MLAT) >> 8), t0 = latent ? (r0 & 2047) : ((r0 - MLAT) & 255), ki0 = latent ? 256 + t0 : t0;
        const int i = lane & 31; const f32x2* tab = (const f32x2*)(a.ws + WS_TAB);
        for (int r4 = 0; r4 < 8; r4 += 4) {
            u32x2 qraw[4][3], kraw[4][3]; float x1[4][3], x2[4][3], cs[4], sn[4];
#pragma unroll
            for (int rr = 0; rr < 4; ++rr) { const int row = r0 + r4 + rr, t = t0 + r4 + rr;
                const f32x2 cv = tab[(latent ? t : 0) * 32 + i]; cs[rr] = latent ? cv.x : 1.f; sn[rr] = latent ? cv.y : 0.f;
#pragma unroll
                for (int ii = 0; ii < 3; ++ii) { const int idx = lane * 4 + ii * 256, hh = idx >> 7, dd = idx & 127;
                    qraw[rr][ii] = *(const u32x2*)(QF + (size_t)row * 1280 + hh * 192 + dd); kraw[rr][ii] = *(const u32x2*)(KVF + (size_t)row * 1536 + hh * 256 + dd); }
#pragma unroll
                for (int j = 0; j < 3; ++j) { const int hh = (lane >> 5) + 2 * j; x1[rr][j] = bf2f(QF[(size_t)row * 1280 + hh * 192 + 128 + i]); x2[rr][j] = bf2f(QF[(size_t)row * 1280 + hh * 192 + 160 + i]); } }
#pragma unroll
            for (int rr = 0; rr < 4; ++rr) { const int ki = ki0 + r4 + rr;
#pragma unroll
                for (int ii = 0; ii < 3; ++ii) { const int idx = lane * 4 + ii * 256, hh = idx >> 7, dd = idx & 127;
                    const u32x2 qw = qraw[rr][ii];
                    const f32x4 q4 = (f32x4){__uint_as_float(qw.x << 16), __uint_as_float(qw.x & 0xffff0000u), __uint_as_float(qw.y << 16), __uint_as_float(qw.y & 0xffff0000u)} * qscale;
                    u32x2 w; w.x = cvt_pk_bf16(q4[0], q4[1]); w.y = cvt_pk_bf16(q4[2], q4[3]);
                    *(u32x2*)(QB + ((size_t)(b * 6 + hh) * NKEY + ki) * 192 + dd) = w;
                    *(u32x2*)(KB + ((size_t)(b * 6 + hh) * NKEY + ki) * 192 + dd) = kraw[rr][ii]; }
#pragma unroll
                for (int j = 0; j < 3; ++j) { const int hh = (lane >> 5) + 2 * j;
                    bf16_t* qp = QB + ((size_t)(b * 6 + hh) * NKEY + ki) * 192;
                    qp[128 + i] = f2bf((x1[rr][j] * cs[rr] - x2[rr][j] * sn[rr]) * qscale); qp[160 + i] = f2bf((x1[rr][j] * sn[rr] + x2[rr][j] * cs[rr]) * qscale); } } }
#pragma unroll 4
        for (int ii = 0; ii < 12; ++ii) { const int hd = lane + 64 * ii, hh = hd >> 7, dv = hd & 127; bf16_t v[8];
#pragma unroll
            for (int rr = 0; rr < 8; ++rr) v[rr] = KVF[(size_t)(r0 + rr) * 1536 + hh * 256 + 128 + dv];
            u32x4 w; w.x = (unsigned)v[0] | ((unsigned)v[1] << 16); w.y = (unsigned)v[2] | ((unsigned)v[3] << 16); w.z = (unsigned)v[4] | ((unsigned)v[5] << 16); w.w = (unsigned)v[6] | ((unsigned)v[7] << 16);
            *(u32x4*)(VT + (((size_t)(b * 6 + hh) * 36 + (ki0 >> 6)) * 128 + dv) * 64 + (ki0 & 63)) = w; }
    }
}

constexpr int KS_STRIDE = 400, VS_STRIDE = 144, KS_BYTES = 64 * KS_STRIDE, VS_BYTES = 128 * VS_STRIDE, ATT_BUF = KS_BYTES + VS_BYTES;
__device__ __forceinline__ void phase_attn(const Args& a, int l, LAS unsigned char* lds) {
    const int tid = threadIdx.x, lane = tid & 63, wid = tid >> 6, fr = lane & 15, fq = lane >> 4;
    const bf16_t* QB = (const bf16_t*)(a.ws + WS_QB); const bf16_t* KB = (const bf16_t*)(a.ws + WS_KB); const bf16_t* VT = (const bf16_t*)(a.ws + WS_VT);
    bf16_t* CAT = (bf16_t*)(a.ws + WS_CAT);
    LAS unsigned char* kring = lds; LAS unsigned char* vring = lds + 2 * KS_BYTES;
    const int nqt = (l == 0) ? 9 : 8, nitem = 24 * nqt;
    for (int it = blockIdx.x; it < nitem; it += gridDim.x) {
        const int bh = it % 24, qi = it / 24, qt = (l == 0) ? (qi == 8 ? 0 : qi + 1) : qi + 1, b = bh / 6, h = bh % 6;
        const int nk = (qt == 0) ? 256 : NKEY, ntile = nk / 64;
        const bf16_t* kbase = KB + (size_t)bh * NKEY * 192; const bf16_t* vbase = VT + (size_t)bh * 128 * NKEY; const bf16_t* qbase = QB + (size_t)bh * NKEY * 192;
        const int q0 = qt * 256 + wid * 32;
        bf16x8 qf[2][6];
#pragma unroll
        for (int g = 0; g < 2; ++g)
#pragma unroll
            for (int ks = 0; ks < 6; ++ks) qf[g][ks] = *(const bf16x8*)(qbase + (size_t)(q0 + g * 16 + fr) * 192 + ks * 32 + fq * 8);
        f32x4 o[8][2];
#pragma unroll
        for (int db = 0; db < 8; ++db) { o[db][0] = (f32x4){0.f, 0.f, 0.f, 0.f}; o[db][1] = (f32x4){0.f, 0.f, 0.f, 0.f}; }
        float mrun[2] = {-1e30f, -1e30f}, lrun[2] = {0.f, 0.f};
        u32x4 kst[3], vst[2];
#define AT_KLOAD(tile) do { const bf16_t* kp_ = kbase + (size_t)(tile) * (64 * 192) + tid * 8; _Pragma("unroll") for (int i = 0; i < 3; ++i) kst[i] = *(const u32x4*)(kp_ + i * 4096); } while (0)
#define AT_VLOAD(tile) do { const bf16_t* vp_ = vbase + (size_t)(tile) * (128 * 64) + tid * 8; _Pragma("unroll") for (int i = 0; i < 2; ++i) vst[i] = *(const u32x4*)(vp_ + i * 4096); } while (0)
#define AT_KSTORE(buf) do { LAS unsigned char* kb_ = kring + (buf) * KS_BYTES; _Pragma("unroll") for (int i = 0; i < 3; ++i) { const int c = tid + 512 * i, r = c / 24, cc = c % 24; *(LAS u32x4*)(kb_ + r * KS_STRIDE + cc * 16) = kst[i]; } } while (0)
#define AT_VSTORE(buf) do { LAS unsigned char* vb_ = vring + (buf) * VS_BYTES; _Pragma("unroll") for (int i = 0; i < 2; ++i) { const int c = tid + 512 * i, r = c >> 3, cc = c & 7; *(LAS u32x4*)(vb_ + r * VS_STRIDE + cc * 16) = vst[i]; } } while (0)
#define AT_QK(sx, buf) do { LAS unsigned char* kb_ = kring + (buf) * KS_BYTES; \
            _Pragma("unroll") for (int kbk = 0; kbk < 4; ++kbk) { sx[kbk][0] = (f32x4){0.f, 0.f, 0.f, 0.f}; sx[kbk][1] = (f32x4){0.f, 0.f, 0.f, 0.f}; \
                const int krow = (kbk >> 1) * 32 + (fr >> 2) * 8 + (kbk & 1) * 4 + (fr & 3); \
                _Pragma("unroll") for (int ks = 0; ks < 6; ++ks) { const bf16x8 kf = *(const LAS bf16x8*)(kb_ + krow * KS_STRIDE + ks * 64 + fq * 16); \
                    sx[kbk][0] = __builtin_amdgcn_mfma_f32_16x16x32_bf16(kf, qf[0][ks], sx[kbk][0], 0, 0, 0); \
                    sx[kbk][1] = __builtin_amdgcn_mfma_f32_16x16x32_bf16(kf, qf[1][ks], sx[kbk][1], 0, 0, 0); } } } while (0)
#define AT_SMPV(sx, buf) do { LAS unsigned char* vb_ = vring + (buf) * VS_BYTES; bf16x8 pf[2][2]; \
            _Pragma("unroll") for (int g = 0; g < 2; ++g) { \
                float mx = sx[0][g][0]; \
                _Pragma("unroll") for (int kbk = 0; kbk < 4; ++kbk) _Pragma("unroll") for (int j = 0; j < 4; ++j) mx = fmaxf(mx, sx[kbk][g][j]); \
                mx = fmaxf(mx, __shfl_xor(mx, 16)); mx = fmaxf(mx, __shfl_xor(mx, 32)); \
                const float mnew = fmaxf(mrun[g], mx), alpha = __builtin_amdgcn_exp2f(mrun[g] - mnew); mrun[g] = mnew; \
                float ps = 0.f; \
                _Pragma("unroll") for (int kbk = 0; kbk < 4; ++kbk) _Pragma("unroll") for (int j = 0; j < 4; ++j) { const float p = __builtin_amdgcn_exp2f(sx[kbk][g][j] - mnew); sx[kbk][g][j] = p; ps += p; } \
                lrun[g] = lrun[g] * alpha + ps; \
                _Pragma("unroll") for (int db = 0; db < 8; ++db) o[db][g] *= alpha; \
                _Pragma("unroll") for (int p = 0; p < 2; ++p) { u32x4 w; w.x = cvt_pk_bf16(sx[2 * p][g][0], sx[2 * p][g][1]); w.y = cvt_pk_bf16(sx[2 * p][g][2], sx[2 * p][g][3]); \
                    w.z = cvt_pk_bf16(sx[2 * p + 1][g][0], sx[2 * p + 1][g][1]); w.w = cvt_pk_bf16(sx[2 * p + 1][g][2], sx[2 * p + 1][g][3]); pf[g][p] = __builtin_bit_cast(bf16x8, w); } } \
            _Pragma("unroll") for (int p = 0; p < 2; ++p) _Pragma("unroll") for (int db = 0; db < 8; ++db) { const bf16x8 vf = *(const LAS bf16x8*)(vb_ + (db * 16 + fr) * VS_STRIDE + p * 64 + fq * 16); \
                o[db][0] = __builtin_amdgcn_mfma_f32_16x16x32_bf16(vf, pf[0][p], o[db][0], 0, 0, 0); \
                o[db][1] = __builtin_amdgcn_mfma_f32_16x16x32_bf16(vf, pf[1][p], o[db][1], 0, 0, 0); } } while (0)
        AT_KLOAD(0); AT_VLOAD(0); AT_KSTORE(0); AT_VSTORE(0);
        __syncthreads();
        f32x4 sx[4][2];
        int vb_cur = 0, vb_prev = 2;
        for (int tile = 0; tile < ntile; ++tile) {
            const int kb_cur = tile & 1, vb_nxt = (vb_cur == 2) ? 0 : vb_cur + 1;
            if (tile + 1 < ntile) { AT_KLOAD(tile + 1); AT_VLOAD(tile + 1); }
            if (wid < 4) { AT_QK(sx, kb_cur); AT_SMPV(sx, vb_cur); }
            else { if (tile > 0) AT_SMPV(sx, vb_prev); AT_QK(sx, kb_cur); }
            if (tile + 1 < ntile) { AT_KSTORE(kb_cur ^ 1); AT_VSTORE(vb_nxt); }
            __syncthreads();
            vb_prev = vb_cur; vb_cur = vb_nxt;
        }
        if (wid >= 4) AT_SMPV(sx, vb_prev);
        __syncthreads();
#pragma unroll
        for (int g = 0; g < 2; ++g) { float lt = lrun[g]; lt += __shfl_xor(lt, 16); lt += __shfl_xor(lt, 32); const float inv = 1.f / lt;
            const int q = q0 + g * 16 + fr; const int row = q < 256 ? MLAT + b * 256 + q : b * 2048 + (q - 256);
#pragma unroll
            for (int db = 0; db < 8; ++db) { const f32x4 v = o[db][g] * inv; u32x2 w; w.x = cvt_pk_bf16(v[0], v[1]); w.y = cvt_pk_bf16(v[2], v[3]);
                *(u32x2*)(CAT + (size_t)row * D + 1280 + h * 128 + db * 16 + fq * 4) = w; } }
#undef AT_KLOAD
#undef AT_VLOAD
#undef AT_KSTORE
#undef AT_VSTORE
#undef AT_QK
#undef AT_SMPV
    }
}

constexpr int PH_PER_LAYER = 13, NPHASE = 2 + 2 * PH_PER_LAYER;

template <int LP>
__device__ __forceinline__ void layer_phase(const Args& a, const int l, LAS unsigned char* lds) {
    unsigned char* ws = a.ws; const bool last = (l == 1); const int Mlate = last ? MLAT : MR;
    bf16_t* H = (bf16_t*)(ws + WS_H); bf16_t* ACT = (bf16_t*)(ws + WS_P); bf16_t* Y = (bf16_t*)(ws + WS_Y); bf16_t* CAT = (bf16_t*)(ws + WS_CAT);
    if constexpr (LP == 0) { EpiSwiGLU E; E.O = ACT; E.ldc = DFF; run_gemm(lds, H, (const bf16_t*)(ws + WS_WFFIN + (size_t)(l * 2) * SZ_WFFIN), MR, 2 * DFF, D, E, 0); deferred_window(a, l, DW_IDLE2, DW_START2, DW_Q2, lds); }
    if constexpr (LP == 1) { const bf16_t* W = (const bf16_t*)(ws + WS_WFFOUT + (size_t)(l * 2) * SZ_WFFOUT);
        { EpiBf16 E; E.O = Y; E.ldc = D; run_gemm(lds, ACT, W, MLAT, D, DFF, E, 0); }
        { EpiF32 E; E.C = (float*)(ws + WS_YP); E.ldc = D; run_gemm(lds, ACT + (size_t)MLAT * DFF, W, 4 * MCTX, D, DFF / 4, E, 0, DFF, MCTX / 256); } deferred_window(a, l, DW_IDLE3, DW_START3, DW_Q3, lds); }
    if constexpr (LP == 2) phase_resnorm(a, l, 1, 2, 0.5f, true, l, 2, 3, 4, false, MR, lds);
    if constexpr (LP == 3) { EpiBf16 E; E.O = (bf16_t*)(ws + WS_P); E.ldc = INWP; run_gemm(lds, H, (const bf16_t*)(ws + WS_WIN + (size_t)l * SZ_WIN), MR, INWP, D, E, 0); deferred_window(a, l, DW_IDLE5, DW_START5, DW_Q5, lds); }
    if constexpr (LP == 4) { if (a.sub & 1) phase_prep(a, l); if (a.sub & 4) phase_ret_local(a, lds); }
    if constexpr (LP == 5) {
        {
          const int G = gridDim.x, bid = (int)blockIdx.x; const bool part = (G == DEFER_GRID);
          if (!part || bid < 144) { EpiBf16 E; E.O = (bf16_t*)(ws + WS_PG); E.ldc = GLUW; run_gemm(lds, H, (const bf16_t*)(ws + WS_WGLU + (size_t)l * SZ_WGLU), MR, GLUW, D, E, 0, 0, 0, part ? 144 : 0, bid); }
          if (!part || bid >= 144) {
              { EpiBf16 E; E.O = (bf16_t*)(ws + WS_QF); E.ldc = 1280; run_gemm(lds, (const bf16_t*)(ws + WS_CQN), (const bf16_t*)(ws + WS_WUQ + (size_t)l * SZ_WUQ), MR, 1280, 512, E, 0, 0, 0, part ? G - 144 : 0, bid - 144); }
              { EpiBf16 E; E.O = (bf16_t*)(ws + WS_KVF); E.ldc = 1536; run_gemm(lds, (const bf16_t*)(ws + WS_CKVN), (const bf16_t*)(ws + WS_WUKV + (size_t)l * SZ_WUKV), MR, 1536, 256, E, 0, 0, 0, part ? G - 144 : 0, part ? (bid - 144 + 68) % (DEFER_GRID - 144) : 0); } } }
        if (a.sub & 256) phase_ret_combine(a);
    }
    if constexpr (LP == 6) { if (a.sub & 2) phase_conv(a, l, lds); if (a.sub & 8) phase_post(a); if (a.sub & 16) phase_ret_out(a, l, lds); }
    if constexpr (LP == 7) { phase_attn(a, l, lds);
        { const int nitem = 24 * (last ? 8 : 9), G = gridDim.x;
          if ((int)blockIdx.x >= nitem && G > nitem) { EpiBf16 E; E.O = CAT + 768; E.ldc = D; run_gemm(lds, (const bf16_t*)(ws + WS_CVN), (const bf16_t*)(ws + WS_WPW + (size_t)l * SZ_WPW), MR, 512, 512, E, 0, 0, 0, G - nitem, (int)blockIdx.x - nitem); }
          else if (G <= nitem) { EpiBf16 E; E.O = CAT + 768; E.ldc = D; run_gemm(lds, (const bf16_t*)(ws + WS_CVN), (const bf16_t*)(ws + WS_WPW + (size_t)l * SZ_WPW), MR, 512, 512, E, 0); } }
        deferred_window(a, l, DW_IDLE9, DW_START9, DW_Q9, lds); }
    if constexpr (LP == 8) { const bf16_t* W = (const bf16_t*)(ws + WS_WOUT + (size_t)l * SZ_WOUT);
        { EpiBf16 E; E.O = Y; E.ldc = D; run_gemm(lds, CAT, W, MLAT, D, D, E, 0); }
        if (!last) { EpiF32 E; E.C = (float*)(ws + WS_YP); E.ldc = D; run_gemm(lds, CAT + (size_t)MLAT * D, W, 4 * MCTX, D, D / 4, E, 0, D, MCTX / 256); } deferred_window(a, l, DW_IDLE10, DW_START10, DW_Q10, lds); }
    if constexpr (LP == 9) phase_resnorm(a, l, 3, 5, 1.0f, true, l, 4, 6, 7, false, Mlate, lds);
    if constexpr (LP == 10) { EpiSwiGLU E; E.O = ACT; E.ldc = DFF; run_gemm(lds, H, (const bf16_t*)(ws + WS_WFFIN + (size_t)(l * 2 + 1) * SZ_WFFIN), Mlate, 2 * DFF, D, E, 0); deferred_window(a, l, DW_IDLE12, DW_START12, DW_Q12, lds); }
    if constexpr (LP == 11) { const bf16_t* W = (const bf16_t*)(ws + WS_WFFOUT + (size_t)(l * 2 + 1) * SZ_WFFOUT);
        { EpiBf16 E; E.O = Y; E.ldc = D; run_gemm(lds, ACT, W, MLAT, D, DFF, E, 0); }
        if (!last) { EpiF32 E; E.C = (float*)(ws + WS_YP); E.ldc = D; run_gemm(lds, ACT + (size_t)MLAT * DFF, W, 4 * MCTX, D, DFF / 4, E, 0, DFF, MCTX / 256); } deferred_window(a, l, DW_IDLE13, DW_START13, DW_Q13, lds); }
    if constexpr (LP == 12) phase_resnorm(a, l, 5, 8, 0.5f, !last, last ? l : l + 1, 0, 0, 1, last, Mlate, lds);
}

__global__ void __launch_bounds__(NTHR, 2) hybrid_fwd(Args a) {
    extern __shared__ __attribute__((aligned(16))) unsigned char lds_raw[];
    LAS unsigned char* lds = (LAS unsigned char*)lds_raw;
    cg::grid_group grid = cg::this_grid();
    volatile LAS unsigned* xst = (volatile LAS unsigned*)(lds + LDS_BYTES - 16);
    if (threadIdx.x == 0) { xst[0] = 0u; xst[1] = 0u; }
    __syncthreads();
    XcdBarrier xbar = xcd_barrier_post((unsigned*)(a.ws + WS_BAR), xst);
#ifndef REPMASK
#define REPMASK 0ull
#endif
#define RUN_PH(ph, stmt) if (a.ph_lo <= (ph) && (ph) < a.ph_hi) { if ((ph) > a.ph_lo) { if ((ph) == 1) grid.sync(); else xcd_barrier(xbar); } stmt; }
    RUN_PH(0, phase_prologue(a, lds))
    RUN_PH(1, phase_norm0(a, lds))
#define RUN_LAYER(l) \
    RUN_PH(2 + (l) * 13 + 0, layer_phase<0>(a, l, lds)) RUN_PH(2 + (l) * 13 + 1, layer_phase<1>(a, l, lds)) RUN_PH(2 + (l) * 13 + 2, layer_phase<2>(a, l, lds)) \
    RUN_PH(2 + (l) * 13 + 3, layer_phase<3>(a, l, lds)) RUN_PH(2 + (l) * 13 + 4, layer_phase<4>(a, l, lds)) RUN_PH(2 + (l) * 13 + 5, layer_phase<5>(a, l, lds)) \
    RUN_PH(2 + (l) * 13 + 6, layer_phase<6>(a, l, lds)) RUN_PH(2 + (l) * 13 + 7, layer_phase<7>(a, l, lds)) RUN_PH(2 + (l) * 13 + 8, layer_phase<8>(a, l, lds)) \
    RUN_PH(2 + (l) * 13 + 9, layer_phase<9>(a, l, lds)) RUN_PH(2 + (l) * 13 + 10, layer_phase<10>(a, l, lds)) RUN_PH(2 + (l) * 13 + 11, layer_phase<11>(a, l, lds)) \
    RUN_PH(2 + (l) * 13 + 12, layer_phase<12>(a, l, lds))
    RUN_LAYER(0)
    RUN_LAYER(1)
#ifdef EXTRA_SYNCS
    if (a.ph_hi - a.ph_lo > 1) { for (int i = 0; i < EXTRA_SYNCS; ++i) grid.sync(); }
#endif
}

#ifndef ONE_LAUNCH
#define ONE_LAUNCH 0
#endif

extern "C" void kernel_launch(void* const* d_in, const int* in_sizes, int n_in, void* d_out, int out_size, void* d_ws, size_t ws_size, hipStream_t stream) {
    static int grid = 0;
    if (grid == 0) {
        if (n_in != 23 || ws_size < WS_END) { fprintf(stderr, "kernel_launch: need 23 inputs and %zu bytes of workspace; got %d, %zu\n", (size_t)WS_END, n_in, ws_size); grid = -1; return; }
        int dev = 0, cus = 0, per_cu = 0;
        hipGetDevice(&dev); hipDeviceGetAttribute(&cus, hipDeviceAttributeMultiprocessorCount, dev);
        if (hipFuncSetAttribute((const void*)hybrid_fwd, hipFuncAttributeMaxDynamicSharedMemorySize, LDS_BYTES) != hipSuccess) { fprintf(stderr, "kernel_launch: hipFuncSetAttribute failed\n"); grid = -1; return; }
        if (hipOccupancyMaxActiveBlocksPerMultiprocessor(&per_cu, (const void*)hybrid_fwd, NTHR, LDS_BYTES) != hipSuccess || per_cu < 1) { fprintf(stderr, "kernel_launch: occupancy query gave %d\n", per_cu); per_cu = 1; }
        (void)hipGetLastError();
        grid = cus * 1;
        fprintf(stderr, "kernel_launch: grid %d (per_cu %d)\n", grid, per_cu);
    }
    if (grid < 0) return;
    if (hipMemsetAsync((char*)d_ws + WS_BAR, 0, 16384, stream) != hipSuccess) { fprintf(stderr, "kernel_launch: memset failed\n"); return; }
    Args a{};
    for (int i = 0; i < 23; ++i) a.in[i] = (const float*)d_in[i];
    a.out = (float*)d_out; a.ws = (unsigned char*)d_ws; a.sub = ~0ull;
#if ONE_LAUNCH
    a.ph_lo = 0; a.ph_hi = NPHASE;
    { void* args[] = {&a}; hipError_t e = hipLaunchCooperativeKernel((const void*)hybrid_fwd, dim3(grid), dim3(NTHR), args, LDS_BYTES, stream);
      if (e != hipSuccess) fprintf(stderr, "cooperative launch failed: %s\n", hipGetErrorString(e)); }
#ifdef EXTRA_PH
    { const int extra[] = EXTRA_PH; a.sub = EXTRA_SUB; for (int ph : extra) { a.ph_lo = ph; a.ph_hi = ph + 1; void* args[] = {&a}; (void)hipLaunchCooperativeKernel((const void*)hybrid_fwd, dim3(grid), dim3(NTHR), args, LDS_BYTES, stream); } }
#endif
#else
    for (int ph = 0; ph < NPHASE; ++ph) {
        a.ph_lo = ph; a.ph_hi = ph + 1;
        void* args[] = {&a}; hipError_t e = hipLaunchCooperativeKernel((const void*)hybrid_fwd, dim3(grid), dim3(NTHR), args, LDS_BYTES, stream);
        if (e != hipSuccess) { fprintf(stderr, "launch %d failed: %s\n", ph, hipGetErrorString(e)); break; }
    }
#endif
}
```

```cpp
#include <hip/hip_runtime.h>
#include <hip/hip_cooperative_groups.h>
#include <cstdio>
namespace cg = cooperative_groups;

#define ONE_LAUNCH 1
#define EXTRA_SUB ~0ull
namespace pg8 {
#define PG8_LAS __attribute__((address_space(3)))
typedef unsigned short bf16_t;
typedef short bf16x8 __attribute__((ext_vector_type(8)));
typedef float f32x4 __attribute__((ext_vector_type(4)));
typedef unsigned u32x4 __attribute__((ext_vector_type(4)));
constexpr int BM = 256, BK = 64, HALF = 128, HTB = HALF * BK * 2  , STAGE_BYTES = 8 * HTB, NXCD = 8, WGM = 8;

__host__ __device__ __forceinline__ int lds_byte(int r, int c) { const int st = (r >> 4) * 2 + (c >> 5), rr = r & 15, cc = c & 31, ob = rr * 64 + cc * 2; return st * 1024 + (ob ^ (((ob >> 9) & 1) << 5)); }
__host__ __device__ __forceinline__ void stage_rc(int b, int& R, int& C) { const int st = b / 1024, sb = b % 1024, swz = sb ^ (((sb >> 9) & 1) << 5); R = (st >> 1) * 16 + swz / 64; C = (st & 1) * 32 + (swz % 64) / 2; }
__host__ __device__ __forceinline__ int perm32(int rho) { const int n = rho >> 4, i = rho & 15; return 8 * (i >> 2) + 4 * n + (i & 3); }

struct Unit { int pm, pn; };
struct Gemm { const bf16_t* A; const bf16_t* Bt; int M, N, K, ld, msplit; };

struct StaticOrder {
    int nM, nN, nwg, G, c;
    __host__ __device__ void init(int M, int N, int G_, int c_) { nM = M / BM; nN = N / BM; nwg = nM * nN; G = G_; c = c_; }
    __host__ __device__ bool next(int i, Unit& u) const {
        const long L = (long)i * G + c; if (L >= nwg) return false;
        int wgid = (int)L; { const int q = nwg / NXCD, r = nwg % NXCD, xcd = wgid % NXCD, off = wgid / NXCD; wgid = (xcd < r ? xcd * (q + 1) : r * (q + 1) + (xcd - r) * q) + off; }
        const int nig = WGM * nN, gid = wgid / nig, fm = gid * WGM, gsz = (nM - fm) < WGM ? (nM - fm) : WGM;
        u.pm = fm + ((wgid % nig) % gsz); u.pn = (wgid % nig) / gsz; return true;
    }
    __device__ __forceinline__ void a_ready(const Unit&) const {}
    __device__ __forceinline__ void done(const Unit&) const {}
};
__device__ __forceinline__ unsigned cvt_pk_bf16(float lo, float hi) { unsigned r; asm volatile("v_cvt_pk_bf16_f32 %0, %1, %2" : "=v"(r) : "v"(lo), "v"(hi)); return r; }
typedef float f32x2 __attribute__((ext_vector_type(2)));

template <class Epi, class Sched, bool STAMP = false>
__device__ __forceinline__ void gemm_phase(PG8_LAS unsigned char* lds, const Gemm g, const Sched& S, const Epi& E, unsigned long long* stamps) {
    const int tid = threadIdx.x, wid = __builtin_amdgcn_readfirstlane(tid >> 6), lane = tid & 63, wr = wid >> 2, wc = wid & 3, fr = lane & 15, fq = lane >> 4;
    const int K = g.K, nt = K / BK, LD = g.ld, MSPL = g.msplit;
    int ts_lo = 0, ts_hi = 0, nts = 0; const unsigned long long rt_entry = STAMP ? (unsigned long long)wall_clock64() : 0ull;
#define PG8_STAMP() do { if (STAMP && wid == 0 && nts < 64) { const unsigned long long _c = (unsigned long long)clock64(); \
        ts_lo = (lane == nts) ? (int)(unsigned)_c : ts_lo; ts_hi = (lane == nts) ? (int)(unsigned)(_c >> 32) : ts_hi; ++nts; } } while (0)
    PG8_STAMP();
    unsigned voffA[2], voffB[2];
#pragma unroll
    for (int i = 0; i < 2; ++i) { int R, C; stage_rc(tid * 16 + i * 8192, R, C); const int Rb = Epi::PERM ? ((R & ~31) + perm32(R & 31)) : R;
        voffA[i] = (unsigned)(R * LD + C) * 2u; voffB[i] = (unsigned)(Rb * LD + C) * 2u; }
    const size_t kstep = (size_t)(BK * 2);
    const size_t hstep = (size_t)HALF * LD * 2;
    const size_t tstep = 2 * hstep;
    const unsigned ldsw = (unsigned)wid * 1024u;
    const int aoff = lds_byte(wr * 64 + fr, fq * 8), boff = lds_byte(wc * 32 + fr, fq * 8);
#define PG8_SA(b, h) (((b) * 2 + (h)) * HTB)
#define PG8_SB(b, h) ((4 + (b) * 2 + (h)) * HTB)
#define PG8_STAGE(bufoff, gbase, voff) do { _Pragma("unroll") for (int _i = 0; _i < 2; ++_i) \
        __builtin_amdgcn_global_load_lds((const unsigned*)((const char*)(gbase) + (voff)[_i]), (PG8_LAS unsigned*)(lds + (bufoff) + ldsw + _i * 8192), 16, 0, 0); } while (0)
#define PG8_LDA(dst, b, h) do { _Pragma("unroll") for (int m = 0; m < 4; ++m) _Pragma("unroll") for (int k = 0; k < 2; ++k) dst[m][k] = *(const PG8_LAS bf16x8*)(lds + PG8_SA(b, h) + aoff + m * 2048 + k * 1024); } while (0)
#define PG8_LDB(dst, b, h) do { _Pragma("unroll") for (int n = 0; n < 2; ++n) _Pragma("unroll") for (int k = 0; k < 2; ++k) dst[n][k] = *(const PG8_LAS bf16x8*)(lds + PG8_SB(b, h) + boff + n * 2048 + k * 1024); } while (0)
#define PG8_MMA(ai, bj, At, Bt) do { __builtin_amdgcn_s_setprio(1); _Pragma("unroll") for (int m = 0; m < 4; ++m) _Pragma("unroll") for (int n = 0; n < 2; ++n) _Pragma("unroll") for (int k = 0; k < 2; ++k) \
        acc[ai][bj][m][n] = __builtin_amdgcn_mfma_f32_16x16x32_bf16(Bt[n][k], At[m][k], acc[ai][bj][m][n], 0, 0, 0); __builtin_amdgcn_s_setprio(0); } while (0)
#define PG8_WAIT_V(n) asm volatile("s_waitcnt vmcnt(" #n ")" ::: "memory")
#define PG8_WAIT_L(n) asm volatile("s_waitcnt lgkmcnt(" #n ")" ::: "memory")
#define PG8_BAR __builtin_amdgcn_s_barrier()
#define PG8_SCHED __builtin_amdgcn_sched_barrier(0)
    Unit cur, nxt; int ui = 0;
    if (!S.next(0, cur)) return;
    f32x4 acc[2][2][4][2];
#pragma unroll
    for (int a = 0; a < 2; ++a)
#pragma unroll
        for (int b = 0; b < 2; ++b)
#pragma unroll
            for (int m = 0; m < 4; ++m)
#pragma unroll
                for (int n = 0; n < 2; ++n) acc[a][b][m][n] = (f32x4){0.f, 0.f, 0.f, 0.f};
    bf16x8 At[4][2], B0[2][2], B1[2][2];
#define PG8_OFFA(u) (MSPL ? (size_t)((u).pm % MSPL) * tstep + (size_t)((u).pm / MSPL) * ((size_t)K * 2) : (size_t)(u).pm * tstep)
#define PG8_OFFB(u) ((size_t)(u).pn * tstep + (MSPL ? (size_t)((u).pm / MSPL) * ((size_t)K * 2) : (size_t)0))
    const char* cA = (const char*)g.A + PG8_OFFA(cur); const char* cB = (const char*)g.Bt + PG8_OFFB(cur);
    S.a_ready(cur);
    PG8_STAGE(PG8_SB(0, 0), cB, voffB); PG8_STAGE(PG8_SA(0, 0), cA, voffA); PG8_STAGE(PG8_SB(0, 1), cB + hstep, voffB); PG8_STAGE(PG8_SA(0, 1), cA + hstep, voffA);
    if (wr == 1) PG8_BAR;
    PG8_WAIT_V(4); PG8_BAR;
    PG8_STAGE(PG8_SB(1, 0), cB + kstep, voffB); PG8_STAGE(PG8_SA(1, 0), cA + kstep, voffA); PG8_STAGE(PG8_SB(1, 1), cB + hstep + kstep, voffB);
    PG8_WAIT_V(6); PG8_BAR;
    PG8_STAMP();
    for (;;) {
        const bool has_next = S.next(ui + 1, nxt);
        const char* nA = has_next ? (const char*)g.A + PG8_OFFA(nxt) : cA; const char* nB = has_next ? (const char*)g.Bt + PG8_OFFB(nxt) : cB;
        for (int t = 0; t < nt; t += 2) {
            const bool last = (t == nt - 2);
            const char* a1 = cA + (size_t)(t + 1) * kstep;
            const char* a2 = last ? nA : cA + (size_t)(t + 2) * kstep; const char* b2 = last ? nB : cB + (size_t)(t + 2) * kstep;
            const char* a3 = a2 + kstep; const char* b3 = b2 + kstep;
            if (last && has_next) S.a_ready(nxt);
            PG8_LDB(B0, 0, 0); PG8_SCHED; PG8_LDA(At, 0, 0); PG8_STAGE(PG8_SA(1, 1), a1 + hstep, voffA);
            PG8_WAIT_L(8); PG8_BAR; PG8_WAIT_L(0); PG8_MMA(0, 0, At, B0); PG8_BAR; PG8_SCHED;
            PG8_LDB(B1, 0, 1); PG8_STAGE(PG8_SB(0, 0), b2, voffB);
            PG8_BAR; PG8_WAIT_L(0); PG8_MMA(0, 1, At, B1); PG8_BAR;
            PG8_LDA(At, 0, 1); PG8_STAGE(PG8_SA(0, 0), a2, voffA);
            PG8_BAR; PG8_WAIT_L(0); PG8_MMA(1, 0, At, B0); PG8_BAR; PG8_SCHED;
            PG8_STAGE(PG8_SB(0, 1), b2 + hstep, voffB);
            PG8_WAIT_V(6); PG8_BAR; PG8_MMA(1, 1, At, B1); PG8_BAR;
            PG8_LDB(B0, 1, 0); PG8_SCHED; PG8_LDA(At, 1, 0); PG8_STAGE(PG8_SA(0, 1), a2 + hstep, voffA);
            PG8_WAIT_L(8); PG8_BAR; PG8_WAIT_L(0); PG8_MMA(0, 0, At, B0); PG8_BAR; PG8_SCHED;
            PG8_LDB(B1, 1, 1); PG8_STAGE(PG8_SB(1, 0), b3, voffB);
            PG8_BAR; PG8_WAIT_L(0); PG8_MMA(0, 1, At, B1); PG8_BAR;
            PG8_LDA(At, 1, 1); PG8_STAGE(PG8_SA(1, 0), a3, voffA);
            PG8_BAR; PG8_WAIT_L(0); PG8_MMA(1, 0, At, B0); PG8_BAR; PG8_SCHED;
            PG8_STAGE(PG8_SB(1, 1), b3 + hstep, voffB);
            PG8_WAIT_V(6); PG8_BAR; PG8_MMA(1, 1, At, B1); PG8_BAR;
        }
        PG8_STAMP();
        if constexpr (!Epi::AFTER_DRAIN) { E(acc, cur, wr, wc, fr, fq); S.done(cur); }
        PG8_STAMP();
        if (!has_next) break;
#pragma unroll
        for (int a = 0; a < 2; ++a)
#pragma unroll
            for (int b = 0; b < 2; ++b)
#pragma unroll
                for (int m = 0; m < 4; ++m)
#pragma unroll
                    for (int n = 0; n < 2; ++n) acc[a][b][m][n] = (f32x4){0.f, 0.f, 0.f, 0.f};
        cur = nxt; cA = nA; cB = nB; ++ui;
    }
    PG8_WAIT_V(0);
    if (wr == 0) PG8_BAR;
    PG8_BAR;
    if constexpr (Epi::AFTER_DRAIN) { E.fused(acc, cur, wr, wc, fr, fq, lds, wid, lane); S.done(cur); }
    PG8_STAMP();
    if (STAMP && wid == 0) { stamps[lane] = lane < nts ? (((unsigned long long)(unsigned)ts_hi << 32) | (unsigned)ts_lo) : 0ull;
        if (lane == 62) stamps[62] = rt_entry; if (lane == 63) stamps[63] = (unsigned long long)wall_clock64(); }
#undef PG8_STAMP
#undef PG8_SA
#undef PG8_SB
#undef PG8_STAGE
#undef PG8_LDA
#undef PG8_LDB
#undef PG8_MMA
#undef PG8_WAIT_V
#undef PG8_WAIT_L
#undef PG8_BAR
#undef PG8_SCHED
}
}
#ifndef LAS
#define LAS __attribute__((address_space(3)))
#endif
#define XB_TMO      128
#define XB_XCNT(j)  (256  + 64 * (j))
#define XB_XSUB(j)  (1280 + 64 * (j))
#define XB_XGEN(j)  (2304 + 64 * (j))
#define XB_TOP      3328
#define XB_TOPGEN   3392
#define XCD_BAR_WORDS 3456
#define XB_SPIN_CAP (1u << 18)

__device__ __forceinline__ unsigned xb_ld(unsigned* p)              { return __hip_atomic_load(p, __ATOMIC_RELAXED, __HIP_MEMORY_SCOPE_AGENT); }
__device__ __forceinline__ unsigned xb_add(unsigned* p, unsigned v) { return __hip_atomic_fetch_add(p, v, __ATOMIC_RELAXED, __HIP_MEMORY_SCOPE_AGENT); }
__device__ __forceinline__ unsigned xb_xcc_id() { return (unsigned)__builtin_amdgcn_s_getreg((3 << 11) | 20) & 0xFu; }
#define XB_SPIN(cond, bar) do { unsigned _sp = 0; while (cond) { __builtin_amdgcn_s_sleep(1); \
    if ((++_sp & 255u) == 0u) { if (xb_ld(&(bar)[XB_TMO])) break; if (_sp > XB_SPIN_CAP) { atomicAdd(&(bar)[XB_TMO], 1u); break; } } } } while (0)

struct XcdBarrier {
    unsigned* bar; unsigned x;
    volatile LAS unsigned* st;
};

__device__ __forceinline__ XcdBarrier xcd_barrier_post(unsigned* bar, volatile LAS unsigned* st) {
    XcdBarrier b; b.bar = bar; b.x = xb_xcc_id(); b.st = st;
    if (threadIdx.x == 0) (void)xb_add(&bar[XB_XCNT(b.x)], 1u);
    return b;
}
__device__ __forceinline__ void xcd_barrier_complete(unsigned* bar, unsigned x, unsigned& nloc, unsigned& nx) {
    const unsigned G = gridDim.x * gridDim.y * gridDim.z;
    unsigned sum, cnt, mine, sp = 0u;
    for (;;) {
        sum = 0u; cnt = 0u; mine = 0u;
#pragma unroll
        for (unsigned j = 0; j < 16; ++j) { const unsigned c = xb_ld(&bar[XB_XCNT(j)]); sum += c; cnt += (c > 0u) ? 1u : 0u; mine = (j == x) ? c : mine; }
        if (sum == G) break;
        __builtin_amdgcn_s_sleep(1);
        if ((++sp & 255u) == 0u) { if (xb_ld(&bar[XB_TMO])) break; if (sp > XB_SPIN_CAP) { atomicAdd(&bar[XB_TMO], 1u); break; } }
    }
    nloc = mine > 0u ? mine : 1u; nx = cnt > 0u ? cnt : 1u;
}

__device__ __forceinline__ void xcd_barrier(const XcdBarrier& b) {
    asm volatile("s_waitcnt vmcnt(0)" ::: "memory");
    __syncthreads();
    if (threadIdx.x == 0) {
        unsigned* bar = b.bar;
        __builtin_amdgcn_s_waitcnt(0);
        unsigned nloc = b.st[0], nx = b.st[1];
        if (nloc == 0u) { xcd_barrier_complete(bar, b.x, nloc, nx); b.st[0] = nloc; b.st[1] = nx; }
        const unsigned old = xb_add(&bar[XB_XSUB(b.x)], 1u);
        const unsigned gen = old / nloc;
        if (old + 1u == (gen + 1u) * nloc) {
            __builtin_amdgcn_fence(__ATOMIC_RELEASE, "agent");
            asm volatile("s_waitcnt vmcnt(0)" ::: "memory");
            const unsigned og = xb_add(&bar[XB_TOP], 1u);
            const unsigned tg = og / nx;
            if (og + 1u == (tg + 1u) * nx) xb_add(&bar[XB_TOPGEN], 1u);
            else XB_SPIN(xb_ld(&bar[XB_TOPGEN]) == tg, bar);
            __builtin_amdgcn_fence(__ATOMIC_ACQUIRE, "agent");
            xb_add(&bar[XB_XGEN(b.x)], 1u);
            asm volatile("s_waitcnt vmcnt(0)" ::: "memory");
        } else {
            XB_SPIN(xb_ld(&bar[XB_XGEN(b.x)]) == gen, bar);
            __builtin_amdgcn_fence(__ATOMIC_ACQUIRE, "agent");
            asm volatile("s_waitcnt vmcnt(0)" ::: "memory");
        }
    }
    __syncthreads();
}


using namespace pg8;
#undef LAS
#define LAS PG8_LAS
typedef unsigned u32x2 __attribute__((ext_vector_type(2)));

constexpr int D = 2048, NBATCH = 4, SEQ = 2048, CTXL = 256, DFF = 5632;
constexpr int MLAT = NBATCH * SEQ, MCTX = NBATCH * CTXL, MR = MLAT + MCTX;
constexpr int INW = 4160, INWP = 3328, GLUW = 1024;
constexpr int OFF_RQ = 0, OFF_RK = 384, OFF_RV = 768, OFF_RG = 1536, OFF_CQ = 2304, OFF_CKV = 2816, OFF_KR = 3072;
constexpr int NKEY = CTXL + SEQ;
constexpr int NCH = 18;
constexpr float EPS = 1e-6f;
constexpr int NTHR = 512;
constexpr int DEFER_GRID = 256;
constexpr int LDS_BYTES = 151552;

constexpr size_t SZ_WFFIN = (size_t)2 * DFF * D * 2;
constexpr size_t SZ_WFFOUT = (size_t)D * DFF * 2;
constexpr size_t SZ_WIN = (size_t)INWP * D * 2;
constexpr size_t SZ_WOUT = (size_t)D * D * 2;
constexpr size_t SZ_WUQ = (size_t)1280 * 512 * 2;
constexpr size_t SZ_WUKV = (size_t)1536 * 256 * 2;
constexpr size_t SZ_WPW = (size_t)512 * 512 * 2;
constexpr size_t WS_WFFIN = 0;
constexpr size_t WS_WFFOUT = WS_WFFIN + 4 * SZ_WFFIN;
constexpr size_t WS_WIN = WS_WFFOUT + 4 * SZ_WFFOUT;
constexpr size_t WS_WOUT = WS_WIN + 2 * SZ_WIN;
constexpr size_t WS_WUQ = WS_WOUT + 2 * SZ_WOUT;
constexpr size_t WS_WUKV = WS_WUQ + 2 * SZ_WUQ;
constexpr size_t WS_WPW = WS_WUKV + 2 * SZ_WUKV;
constexpr size_t WS_MOD = WS_WPW + 2 * SZ_WPW;
constexpr size_t WS_X = WS_MOD + (size_t)2 * 5 * 18432 * 4;
constexpr size_t WS_H = WS_X + (size_t)MR * D * 4;
constexpr size_t WS_Y = WS_H + (size_t)MR * D * 2;
constexpr size_t WS_P = WS_Y + (size_t)MR * D * 4;
constexpr size_t WS_QR = WS_P + (size_t)MR * INWP * 4;
constexpr size_t WS_KR = WS_QR + (size_t)MR * 384 * 4;
constexpr size_t WS_CQN = WS_KR + (size_t)MR * 384 * 4;
constexpr size_t WS_CKVN = WS_CQN + (size_t)MR * 512 * 2;
constexpr size_t WS_CVN = WS_CKVN + (size_t)MR * 256 * 2;
constexpr size_t WS_QF = WS_CVN + (size_t)MR * 512 * 2;
constexpr size_t WS_KVF = WS_QF + (size_t)MR * 1280 * 4;
constexpr size_t WS_QB = WS_KVF + (size_t)MR * 1536 * 4;
constexpr size_t WS_KB = WS_QB + (size_t)NBATCH * 6 * NKEY * 192 * 2;
constexpr size_t WS_VT = WS_KB + (size_t)NBATCH * 6 * NKEY * 192 * 2;
constexpr size_t WS_CAT = WS_VT + (size_t)NBATCH * 6 * 128 * NKEY * 2;
constexpr size_t WS_SF = WS_CAT + (size_t)MR * D * 2;
constexpr size_t WS_SB = WS_SF + (size_t)NBATCH * 6 * NCH * 8192 * 4;
constexpr size_t WS_TAB = WS_SB + (size_t)NBATCH * 6 * NCH * 8192 * 4;
constexpr size_t WS_YP = WS_TAB + (size_t)2048 * 32 * 8;
constexpr size_t WS_BAR = WS_YP + (size_t)4 * MCTX * D * 4;
constexpr size_t WS_RKB = WS_BAR + 16384;
constexpr size_t WS_RVT = WS_RKB + (size_t)24 * NCH * 128 * 64 * 2;
constexpr size_t SZ_WGLU = (size_t)GLUW * D * 2;
constexpr size_t WS_WGLU = WS_RVT + (size_t)24 * NCH * 128 * 128 * 2;
constexpr size_t WS_PG = WS_WGLU + 2 * SZ_WGLU;
constexpr size_t WS_END = WS_PG + (size_t)MR * GLUW * 2;

#ifndef REPMASK
#define REPMASK 0ull
#endif
struct Args { const float* in[23]; float* out; unsigned char* ws; unsigned long long sub; int ph_lo, ph_hi; };

__device__ __forceinline__ float wave_sum(float v) {
#pragma unroll
    for (int o = 32; o; o >>= 1) v += __shfl_xor(v, o);
    return v;
}
__device__ __forceinline__ float siluf(float a) { return a * __builtin_amdgcn_rcpf(1.f + __expf(-a)); }
__device__ __forceinline__ float sigmf(float a) { return __builtin_amdgcn_rcpf(1.f + __expf(-a)); }
__device__ __forceinline__ bf16_t f2bf(float f) { unsigned u = __float_as_uint(f); u += 0x7FFFu + ((u >> 16) & 1u); return (bf16_t)(u >> 16); }
__device__ __forceinline__ float bf2f(bf16_t v) { return __uint_as_float((unsigned)v << 16); }
__device__ __forceinline__ f32x4 ld_bf4(const bf16_t* p) { const u32x2 w = *(const u32x2*)p; return (f32x4){__uint_as_float(w.x << 16), __uint_as_float(w.x & 0xffff0000u), __uint_as_float(w.y << 16), __uint_as_float(w.y & 0xffff0000u)}; }
__device__ __forceinline__ int mod_of_row(int row) { return row < MLAT ? (row >> 11) : 4; }

__device__ __forceinline__ void rope_compute(int i, int t, float& cs, float& sn) {
    const float inv = exp2f(-(float)(i & 15) * (13.287712379549449f / 16.f));
    const float pos = (float)((i < 16) ? (t >> 6) : (t & 63));
    sincosf(pos * inv, &sn, &cs);
}
__device__ __forceinline__ void rope_cs(const f32x2* tab, int i, int t, bool latent, float& cs, float& sn) {
    const f32x2 v = tab[(latent ? t : 0) * 32 + i]; cs = latent ? v.x : 1.f; sn = latent ? v.y : 0.f;
}

__device__ __forceinline__ int map_col(int mode, int n) {
    if (mode == 1) { const int g = n >> 8, r = n & 255; return (r < 128) ? g * 128 + r : DFF + g * 128 + (r - 128); }
    if (mode == 2) return n < 2304 ? n : n + GLUW;
    if (mode == 3) return n + 2304;
    return n;
}
template <int MODE>
__device__ __forceinline__ void transpose_job(const float* src, bf16_t* dst, const int K, const int Nsrc, const int Ndst, const int goff, LAS float* tl) {
    const int tid = threadIdx.x, G = gridDim.x;
    const int ntn = Ndst >> 7, ntile = (K >> 7) * ntn;
    int t = ((int)blockIdx.x - goff % G + G) % G;
    const int n4 = (tid & 31) * 4, kr = tid >> 5;
    f32x4 v[8];
#define TJ_ISSUE(tt) do { const int tk_ = (tt) / ntn, tn_ = (tt) % ntn, k0_ = tk_ * 128, n_ = tn_ * 128 + n4; \
        const int scol_ = map_col(MODE, n_); \
        const bool valid_ = scol_ < Nsrc; const float* p_ = src + (size_t)(k0_ + kr) * Nsrc + scol_; \
        _Pragma("unroll") for (int i = 0; i < 8; ++i) v[i] = valid_ ? __builtin_nontemporal_load((const f32x4*)(p_ + (size_t)(16 * i) * Nsrc)) : (f32x4){0.f, 0.f, 0.f, 0.f}; } while (0)
    if (t < ntile) TJ_ISSUE(t);
    for (; t < ntile; t += G) {
        const int tk = t / ntn, tn = t % ntn, k0 = tk * 128, n0 = tn * 128;
#pragma unroll
        for (int i = 0; i < 8; ++i) { LAS float* q = tl + (kr + 16 * i) * 129 + n4; q[0] = v[i][0]; q[1] = v[i][1]; q[2] = v[i][2]; q[3] = v[i][3]; }
        __syncthreads();
        if (t + G < ntile) TJ_ISSUE(t + G);
#pragma unroll
        for (int i = 0; i < 4; ++i) { const int idx = tid + 512 * i, k8 = (idx & 15) * 8, n = idx >> 4; float x[8];
#pragma unroll
            for (int j = 0; j < 8; ++j) x[j] = tl[(k8 + j) * 129 + n];
            u32x4 w; w.x = cvt_pk_bf16(x[0], x[1]); w.y = cvt_pk_bf16(x[2], x[3]); w.z = cvt_pk_bf16(x[4], x[5]); w.w = cvt_pk_bf16(x[6], x[7]);
            *(u32x4*)(dst + (size_t)(n0 + n) * K + k0 + k8) = w; }
        __syncthreads();
    }
}

__device__ __forceinline__ void phase_prologue(const Args& a, LAS unsigned char* lds) {
    const int tid = threadIdx.x, G = gridDim.x, bid = blockIdx.x;
    LAS float* sl = (LAS float*)lds;
    LAS float* red = (LAS float*)(lds + 40960);
    LAS float* tl = (LAS float*)lds;
    for (int i = tid; i < 5 * 2048; i += NTHR) { const int m = i >> 11, k = i & 2047; const float c = m < 4 ? a.in[1][m * 2048 + k] : a.in[3][k]; sl[i] = siluf(c); }
    __syncthreads();
    float* MOD = (float*)(a.ws + WS_MOD);
    for (int it = bid; it < 256; it += G) {
        const int l = it >> 7, n0 = (it & 127) * 144, c4 = tid % 36, sl_i = tid / 36;
        f32x4 acc[5];
#pragma unroll
        for (int m = 0; m < 5; ++m) acc[m] = (f32x4){0.f, 0.f, 0.f, 0.f};
        if (sl_i < 14) {
            const float* w = a.in[4] + (size_t)l * 2048 * 18432 + n0 + c4 * 4;
#pragma unroll 8
            for (int k = sl_i; k < 2048; k += 14) { const f32x4 wv = __builtin_nontemporal_load((const f32x4*)(w + (size_t)k * 18432));
#pragma unroll
                for (int m = 0; m < 5; ++m) acc[m] += wv * sl[m * 2048 + k]; }
#pragma unroll
            for (int m = 0; m < 5; ++m) { LAS float* q = red + (sl_i * 5 + m) * 144 + c4 * 4; q[0] = acc[m][0]; q[1] = acc[m][1]; q[2] = acc[m][2]; q[3] = acc[m][3]; }
        }
        __syncthreads();
        for (int o = tid; o < 5 * 144; o += NTHR) { const int m = o / 144, c = o % 144; float s = 0.f;
#pragma unroll
            for (int q = 0; q < 14; ++q) s += red[(q * 5 + m) * 144 + c];
            MOD[((size_t)l * 5 + m) * 18432 + n0 + c] = s + a.in[5][l * 18432 + n0 + c]; }
        __syncthreads();
    }
    { f32x2* tab = (f32x2*)(a.ws + WS_TAB);
      for (int e = bid * NTHR + tid; e < 2048 * 32; e += G * NTHR) { float cs, sn; rope_compute(e & 31, e >> 5, cs, sn); tab[e] = (f32x2){cs, sn}; } }
    unsigned char* ws = a.ws; int goff = 0;
    const bool defer = (G == DEFER_GRID);
#pragma unroll 1
    for (int l = 0; l < 2; ++l) {
        if (defer && l == 1) break;
        transpose_job<1>(a.in[7] + (size_t)l * D * 2 * DFF, (bf16_t*)(ws + WS_WFFIN + (size_t)(l * 2 + 0) * SZ_WFFIN), D, 2 * DFF, 2 * DFF, goff, tl); goff += 16 * 88;
        transpose_job<0>(a.in[8] + (size_t)l * DFF * D, (bf16_t*)(ws + WS_WFFOUT + (size_t)(l * 2 + 0) * SZ_WFFOUT), DFF, D, D, goff, tl); goff += 44 * 16;
        transpose_job<2>(a.in[11] + (size_t)l * D * INW, (bf16_t*)(ws + WS_WIN + (size_t)l * SZ_WIN), D, INW, INWP, goff, tl); goff += 16 * 26;
        transpose_job<3>(a.in[11] + (size_t)l * D * INW, (bf16_t*)(ws + WS_WGLU + (size_t)l * SZ_WGLU), D, INW, GLUW, goff, tl); goff += 16 * 8;
        transpose_job<0>(a.in[20] + (size_t)l * 512 * 1152, (bf16_t*)(ws + WS_WUQ + (size_t)l * SZ_WUQ), 512, 1152, 1280, goff, tl); goff += 4 * 10;
        transpose_job<0>(a.in[22] + (size_t)l * 256 * 1536, (bf16_t*)(ws + WS_WUKV + (size_t)l * SZ_WUKV), 256, 1536, 1536, goff, tl); goff += 2 * 12;
        transpose_job<0>(a.in[18] + (size_t)l * 512 * 512, (bf16_t*)(ws + WS_WPW + (size_t)l * SZ_WPW), 512, 512, 512, goff, tl); goff += 4 * 4;
        if (defer) break;
        transpose_job<0>(a.in[12] + (size_t)l * D * D, (bf16_t*)(ws + WS_WOUT + (size_t)l * SZ_WOUT), D, D, D, goff, tl); goff += 16 * 16;
        transpose_job<1>(a.in[9] + (size_t)l * D * 2 * DFF, (bf16_t*)(ws + WS_WFFIN + (size_t)(l * 2 + 1) * SZ_WFFIN), D, 2 * DFF, 2 * DFF, goff, tl); goff += 16 * 88;
        transpose_job<0>(a.in[10] + (size_t)l * DFF * D, (bf16_t*)(ws + WS_WFFOUT + (size_t)(l * 2 + 1) * SZ_WFFOUT), DFF, D, D, goff, tl); goff += 44 * 16;
    }
}

constexpr int DJ_N[12] = {256, 1408, 704,   1408, 704, 544, 40, 24, 16, 256, 1408, 704};
constexpr int NDEF = 256 + 1408 + 704 + 1408 + 704 + 544 + 40 + 24 + 16 + 256 + 1408 + 704;
__device__ __forceinline__ void dj_decode(const Args& a, int d, const float*& src, bf16_t*& dst, int& K, int& Nsrc, int& Ndst, int& mode, int& t) {
    unsigned char* ws = a.ws; mode = 0; t = d;
    if (t < 256)  { src = a.in[12];                        dst = (bf16_t*)(ws + WS_WOUT);                  K = D;   Nsrc = D;       Ndst = D;       return; } t -= 256;
    if (t < 1408) { src = a.in[9];                         dst = (bf16_t*)(ws + WS_WFFIN + 1 * SZ_WFFIN);  K = D;   Nsrc = 2 * DFF; Ndst = 2 * DFF; mode = 1; return; } t -= 1408;
    if (t < 704)  { src = a.in[10];                        dst = (bf16_t*)(ws + WS_WFFOUT + 1 * SZ_WFFOUT); K = DFF; Nsrc = D;      Ndst = D;       return; } t -= 704;
    if (t < 1408) { src = a.in[7] + (size_t)D * 2 * DFF;   dst = (bf16_t*)(ws + WS_WFFIN + 2 * SZ_WFFIN);  K = D;   Nsrc = 2 * DFF; Ndst = 2 * DFF; mode = 1; return; } t -= 1408;
    if (t < 704)  { src = a.in[8] + (size_t)DFF * D;       dst = (bf16_t*)(ws + WS_WFFOUT + 2 * SZ_WFFOUT); K = DFF; Nsrc = D;      Ndst = D;       return; } t -= 704;
    if (t < 416)  { src = a.in[11] + (size_t)D * INW;      dst = (bf16_t*)(ws + WS_WIN + SZ_WIN);          K = D;   Nsrc = INW;     Ndst = INWP;    mode = 2; return; } t -= 416;
    if (t < 128)  { src = a.in[11] + (size_t)D * INW;      dst = (bf16_t*)(ws + WS_WGLU + SZ_WGLU);        K = D;   Nsrc = INW;     Ndst = GLUW;    mode = 3; return; } t -= 128;
    if (t < 40)   { src = a.in[20] + (size_t)512 * 1152;   dst = (bf16_t*)(ws + WS_WUQ + SZ_WUQ);          K = 512; Nsrc = 1152;    Ndst = 1280;    return; } t -= 40;
    if (t < 24)   { src = a.in[22] + (size_t)256 * 1536;   dst = (bf16_t*)(ws + WS_WUKV + SZ_WUKV);        K = 256; Nsrc = 1536;    Ndst = 1536;    return; } t -= 24;
    if (t < 16)   { src = a.in[18] + (size_t)512 * 512;    dst = (bf16_t*)(ws + WS_WPW + SZ_WPW);          K = 512; Nsrc = 512;     Ndst = 512;     return; } t -= 16;
    if (t < 256)  { src = a.in[12] + (size_t)D * D;        dst = (bf16_t*)(ws + WS_WOUT + SZ_WOUT);        K = D;   Nsrc = D;       Ndst = D;       return; } t -= 256;
    if (t < 1408) { src = a.in[9] + (size_t)D * 2 * DFF;   dst = (bf16_t*)(ws + WS_WFFIN + 3 * SZ_WFFIN);  K = D;   Nsrc = 2 * DFF; Ndst = 2 * DFF; mode = 1; return; } t -= 1408;
    src = a.in[10] + (size_t)DFF * D; dst = (bf16_t*)(ws + WS_WFFOUT + 3 * SZ_WFFOUT); K = DFF; Nsrc = D; Ndst = D;
}
__device__ __forceinline__ void deferred_convert(const Args& a, int first, int stride, int count, LAS float* tl) {
    const int tid = threadIdx.x, n4 = (tid & 31) * 4, kr = tid >> 5;
    f32x4 v[8];
#define DJ_ISSUE(dd) do { const float* src_; bf16_t* dst_; int K_, Ns_, Nd_, md_, t_; dj_decode(a, (dd), src_, dst_, K_, Ns_, Nd_, md_, t_); \
        const int ntn_ = Nd_ >> 7, tk_ = t_ / ntn_, tn_ = t_ % ntn_, k0_ = tk_ * 128, n_ = tn_ * 128 + n4; \
        const int scol_ = map_col(md_, n_); \
        const bool valid_ = scol_ < Ns_; const float* p_ = src_ + (size_t)(k0_ + kr) * Ns_ + scol_; \
        _Pragma("unroll") for (int i = 0; i < 8; ++i) v[i] = valid_ ? __builtin_nontemporal_load((const f32x4*)(p_ + (size_t)(16 * i) * Ns_)) : (f32x4){0.f, 0.f, 0.f, 0.f}; } while (0)
    int d = first;
    if (count > 0 && d < NDEF) DJ_ISSUE(d);
    for (int k = 0; k < count && d < NDEF; ++k, d += stride) {
        const float* src; bf16_t* dst; int K, Nsrc, Ndst, mode, t; dj_decode(a, d, src, dst, K, Nsrc, Ndst, mode, t);
        const int ntn = Ndst >> 7, tk = t / ntn, tn = t % ntn, k0 = tk * 128, n0 = tn * 128;
#pragma unroll
        for (int i = 0; i < 8; ++i) { LAS float* q = tl + (kr + 16 * i) * 129 + n4; q[0] = v[i][0]; q[1] = v[i][1]; q[2] = v[i][2]; q[3] = v[i][3]; }
        __syncthreads();
        if (k + 1 < count && d + stride < NDEF) DJ_ISSUE(d + stride);
#pragma unroll
        for (int i = 0; i < 4; ++i) { const int idx = tid + 512 * i, k8 = (idx & 15) * 8, n = idx >> 4; float x[8];
#pragma unroll
            for (int j = 0; j < 8; ++j) x[j] = tl[(k8 + j) * 129 + n];
            u32x4 w; w.x = cvt_pk_bf16(x[0], x[1]); w.y = cvt_pk_bf16(x[2], x[3]); w.z = cvt_pk_bf16(x[4], x[5]); w.w = cvt_pk_bf16(x[6], x[7]);
            __builtin_nontemporal_store(w, (u32x4*)(dst + (size_t)(n0 + n) * K + k0 + k8)); }
        __syncthreads();
    }
#undef DJ_ISSUE
}
constexpr int DW_START2 = 0,    DW_IDLE2 = 48,   DW_Q2 = 10;
constexpr int DW_START3 = DW_START2 + (256 - DW_IDLE2) * DW_Q2,   DW_IDLE3 = 128,  DW_Q3 = 6;
constexpr int DW_START5 = DW_START3 + (256 - DW_IDLE3) * DW_Q3,   DW_IDLE5 = 212,  DW_Q5 = 12;
constexpr int DW_START9 = DW_START5 + (256 - DW_IDLE5) * DW_Q5,   DW_IDLE9 = 216,  DW_Q9 = 22;
constexpr int DW_START10 = DW_START9 + (256 - DW_IDLE9) * DW_Q9,  DW_IDLE10 = 128, DW_Q10 = 2;
constexpr int DW_START12 = DW_START10 + (256 - DW_IDLE10) * DW_Q10, DW_IDLE12 = 48, DW_Q12 = 10;
constexpr int DW_START13 = DW_START12 + (256 - DW_IDLE12) * DW_Q12, DW_IDLE13 = 128, DW_Q13 = 8;
constexpr int DW_END = DW_START13 + (256 - DW_IDLE13) * DW_Q13;
static_assert(DW_START3 >= 256, "W_out(0) must be converted before phase 10");
static_assert(DW_START3 >= 256 + 1408, "FFN-b in (0) must be converted before phase 12");
static_assert(DW_START5 >= 256 + 1408 + 704, "FFN-b out (0) must be converted before phase 13");
static_assert(DW_END >= NDEF, "every deferred tile must be converted before layer 1 starts");
__device__ __forceinline__ void deferred_window(const Args& a, int l, int idle0, int start, int quota, LAS unsigned char* lds) {
    if (l != 0 || gridDim.x != DEFER_GRID || (int)blockIdx.x < idle0) return;
    deferred_convert(a, start + ((int)blockIdx.x - idle0), DEFER_GRID - idle0, quota, (LAS float*)lds);
}

__device__ __forceinline__ void norm_mod_store(const f32x4 (&x)[8], const float* g, const float* shift, const float* scale, bf16_t* hrow, int lane) {
    float ss = 0.f;
#pragma unroll
    for (int i = 0; i < 8; ++i) ss += (x[i][0] * x[i][0] + x[i][1] * x[i][1]) + (x[i][2] * x[i][2] + x[i][3] * x[i][3]);
    ss = wave_sum(ss);
    const float r = rsqrtf(ss * (1.f / 2048.f) + EPS);
#pragma unroll
    for (int i = 0; i < 8; ++i) { const int c = lane * 4 + i * 256;
        const f32x4 gv = *(const f32x4*)(g + c), sh = *(const f32x4*)(shift + c), sc = *(const f32x4*)(scale + c);
        const f32x4 h = (x[i] * r * gv) * (sc + 1.f) + sh;
        u32x2 w; w.x = cvt_pk_bf16(h[0], h[1]); w.y = cvt_pk_bf16(h[2], h[3]);
        *(u32x2*)(hrow + c) = w; }
}

__device__ __forceinline__ void phase_norm0(const Args& a, LAS unsigned char* lds) {
    const int tid = threadIdx.x, lane = tid & 63, wid = tid >> 6, G = gridDim.x;
    float* X = (float*)(a.ws + WS_X); bf16_t* H = (bf16_t*)(a.ws + WS_H); const float* MOD = (const float*)(a.ws + WS_MOD);
    const float* gpre = a.in[6];
    LAS float* G2 = (LAS float*)lds; LAS float* SH = G2 + D;
    const int per = (MR + G - 1) / G, r0 = (int)blockIdx.x * per, r1 = (r0 + per < MR) ? r0 + per : MR;
    if (r0 >= MR) return;
    const int m0 = mod_of_row(r0);
    { const float* md = MOD + (size_t)m0 * 18432; const int c = tid * 4;
      *(LAS f32x4*)(G2 + c) = *(const f32x4*)(gpre + c) * (*(const f32x4*)(md + D + c) + 1.f); *(LAS f32x4*)(SH + c) = *(const f32x4*)(md + c); }
    __syncthreads();
#define RC(k) (lane * 8 + ((k) >> 1) * 512 + ((k) & 1) * 4)
#define N0_LOAD(xx, rw) do { const float* src_ = (rw) < MLAT ? a.in[0] + (size_t)(rw) * D : a.in[2] + (size_t)((rw) - MLAT) * D; \
        _Pragma("unroll") for (int k = 0; k < 8; ++k) xx[k] = __builtin_nontemporal_load((const f32x4*)(src_ + RC(k))); } while (0)
    f32x4 x[8], xn[8];
    if (r0 + wid < r1) N0_LOAD(x, r0 + wid);
    for (int row = r0 + wid; row < r1; row += 8) {
        const int m = mod_of_row(row); const bool fast = (m == m0); const bool more = row + 8 < r1;
        if (more) N0_LOAD(xn, row + 8);
        const float* md = MOD + (size_t)m * 18432;
        float s2 = 0.f;
#pragma unroll
        for (int k = 0; k < 8; ++k) { *(f32x4*)(X + (size_t)row * D + RC(k)) = x[k]; s2 += (x[k][0] * x[k][0] + x[k][1] * x[k][1]) + (x[k][2] * x[k][2] + x[k][3] * x[k][3]); }
        s2 = wave_sum(s2);
        const float r2 = rsqrtf(s2 * (1.f / 2048.f) + EPS);
#pragma unroll
        for (int i = 0; i < 4; ++i) { f32x4 h[2];
#pragma unroll
            for (int hh = 0; hh < 2; ++hh) { const int k = 2 * i + hh, c = RC(k);
                const f32x4 g2 = fast ? *(const LAS f32x4*)(G2 + c) : *(const f32x4*)(gpre + c) * (*(const f32x4*)(md + D + c) + 1.f);
                const f32x4 sh = fast ? *(const LAS f32x4*)(SH + c) : *(const f32x4*)(md + c);
                h[hh] = x[k] * r2 * g2 + sh; }
            u32x4 w; w.x = cvt_pk_bf16(h[0][0], h[0][1]); w.y = cvt_pk_bf16(h[0][2], h[0][3]); w.z = cvt_pk_bf16(h[1][0], h[1][1]); w.w = cvt_pk_bf16(h[1][2], h[1][3]);
            *(u32x4*)(H + (size_t)row * D + lane * 8 + i * 512) = w; }
        if (more) {
#pragma unroll
            for (int k = 0; k < 8; ++k) x[k] = xn[k]; }
    }
#undef N0_LOAD
#undef RC
    __syncthreads();
}

__device__ __forceinline__ void phase_resnorm(const Args& a, int l, int gi_post, int mi_gate, float rs, bool has_next, int ln, int gi_pre, int mi_shift, int mi_scale, bool final_out, int M, LAS unsigned char* lds) {
    const float* YP = (const float*)(a.ws + WS_YP);
    const int tid = threadIdx.x, lane = tid & 63, wid = tid >> 6, G = gridDim.x;
    float* X = (float*)(a.ws + WS_X); const bf16_t* Y = (const bf16_t*)(a.ws + WS_Y); bf16_t* H = (bf16_t*)(a.ws + WS_H); const float* MOD = (const float*)(a.ws + WS_MOD);
    const float* gpost = a.in[6] + (size_t)(l * 6 + gi_post) * D; const float* gpre = a.in[6] + (size_t)(ln * 6 + gi_pre) * D;
    LAS float* GG = (LAS float*)lds; LAS float* G2 = GG + D; LAS float* SH = G2 + D;
    const int per = (M + G - 1) / G, r0 = (int)blockIdx.x * per, r1 = (r0 + per < M) ? r0 + per : M;
    if (r0 >= M) return;
    const int m0 = mod_of_row(r0);
    { const float* gate = MOD + ((size_t)l * 5 + m0) * 18432 + (size_t)mi_gate * D; const float* md = MOD + ((size_t)ln * 5 + m0) * 18432;
      const int c = tid * 4;
      const f32x4 gt = *(const f32x4*)(gate + c), gp = *(const f32x4*)(gpost + c);
      *(LAS f32x4*)(GG + c) = gt * rs * gp;
      if (has_next) { const f32x4 g = *(const f32x4*)(gpre + c), sc = *(const f32x4*)(md + (size_t)mi_scale * D + c), sh = *(const f32x4*)(md + (size_t)mi_shift * D + c);
          *(LAS f32x4*)(G2 + c) = g * (sc + 1.f); *(LAS f32x4*)(SH + c) = sh; } }
    __syncthreads();
#define RC(k) (lane * 8 + ((k) >> 1) * 512 + ((k) & 1) * 4)
#define RN_LOAD(xx, yy, rw) do { _Pragma("unroll") for (int k = 0; k < 8; ++k) xx[k] = *(const f32x4*)(X + (size_t)(rw) * D + RC(k)); \
        if ((rw) < MLAT) { _Pragma("unroll") for (int i = 0; i < 4; ++i) { const u32x4 w = *(const u32x4*)(Y + (size_t)(rw) * D + lane * 8 + i * 512); \
                yy[2 * i] = (f32x4){__uint_as_float(w.x << 16), __uint_as_float(w.x & 0xffff0000u), __uint_as_float(w.y << 16), __uint_as_float(w.y & 0xffff0000u)}; \
                yy[2 * i + 1] = (f32x4){__uint_as_float(w.z << 16), __uint_as_float(w.z & 0xffff0000u), __uint_as_float(w.w << 16), __uint_as_float(w.w & 0xffff0000u)}; } } \
        else { _Pragma("unroll") for (int k = 0; k < 8; ++k) { const float* yp = YP + (size_t)((rw) - MLAT) * D + RC(k); yy[k] = (*(const f32x4*)yp + *(const f32x4*)(yp + (size_t)MCTX * D)) + (*(const f32x4*)(yp + (size_t)2 * MCTX * D) + *(const f32x4*)(yp + (size_t)3 * MCTX * D)); } } } while (0)
    f32x4 y[8], x[8], yn[8], xn[8];
    if (r0 + wid < r1) RN_LOAD(x, y, r0 + wid);
    for (int row = r0 + wid; row < r1; row += 8) {
        const int m = mod_of_row(row); const bool fast = (m == m0);
        const bool more = row + 8 < r1;
        if (more) RN_LOAD(xn, yn, row + 8);
        float ss = 0.f;
#pragma unroll
        for (int i = 0; i < 8; ++i) ss += (y[i][0] * y[i][0] + y[i][1] * y[i][1]) + (y[i][2] * y[i][2] + y[i][3] * y[i][3]);
        ss = wave_sum(ss);
        const float r = rsqrtf(ss * (1.f / 2048.f) + EPS);
        const float* gate = MOD + ((size_t)l * 5 + m) * 18432 + (size_t)mi_gate * D; const float* md = MOD + ((size_t)ln * 5 + m) * 18432;
        float s2 = 0.f;
#pragma unroll
        for (int i = 0; i < 8; ++i) { const int c = RC(i);
            const f32x4 gg = fast ? *(const LAS f32x4*)(GG + c) : *(const f32x4*)(gate + c) * rs * *(const f32x4*)(gpost + c);
            x[i] = x[i] + gg * (y[i] * r);
            if (final_out) __builtin_nontemporal_store(x[i], (f32x4*)(a.out + (size_t)row * D + c)); else *(f32x4*)(X + (size_t)row * D + c) = x[i];
            s2 += (x[i][0] * x[i][0] + x[i][1] * x[i][1]) + (x[i][2] * x[i][2] + x[i][3] * x[i][3]); }
        if (has_next) {
            s2 = wave_sum(s2);
            const float r2 = rsqrtf(s2 * (1.f / 2048.f) + EPS);
#pragma unroll
            for (int i = 0; i < 4; ++i) { f32x4 h[2];
#pragma unroll
                for (int hh = 0; hh < 2; ++hh) { const int k = 2 * i + hh, c = RC(k);
                    const f32x4 g2 = fast ? *(const LAS f32x4*)(G2 + c) : *(const f32x4*)(gpre + c) * (*(const f32x4*)(md + (size_t)mi_scale * D + c) + 1.f);
                    const f32x4 sh = fast ? *(const LAS f32x4*)(SH + c) : *(const f32x4*)(md + (size_t)mi_shift * D + c);
                    h[hh] = x[k] * r2 * g2 + sh; }
                u32x4 w; w.x = cvt_pk_bf16(h[0][0], h[0][1]); w.y = cvt_pk_bf16(h[0][2], h[0][3]); w.z = cvt_pk_bf16(h[1][0], h[1][1]); w.w = cvt_pk_bf16(h[1][2], h[1][3]);
                *(u32x4*)(H + (size_t)row * D + lane * 8 + i * 512) = w; } }
        if (more) {
#pragma unroll
            for (int i = 0; i < 8; ++i) { x[i] = xn[i]; y[i] = yn[i]; } }
    }
#undef RC
#undef RN_LOAD
    __syncthreads();
}

struct EpiF32 {
    static constexpr bool PERM = false, AFTER_DRAIN = false;
    float* C; int ldc;
    __device__ __forceinline__ void operator()(const f32x4 (&acc)[2][2][4][2], const Unit& u, int wr, int wc, int fr, int fq) const {
        const int row0 = u.pm * BM + wr * 64 + fr, col0 = u.pn * BM + wc * 32 + 4 * fq;
#pragma unroll
        for (int ai = 0; ai < 2; ++ai)
#pragma unroll
            for (int m = 0; m < 4; ++m) { float* rowp = C + (size_t)(row0 + ai * HALF + m * 16) * ldc + col0;
#pragma unroll
                for (int bj = 0; bj < 2; ++bj)
#pragma unroll
                    for (int n = 0; n < 2; ++n) *(f32x4*)(rowp + bj * HALF + n * 16) = acc[ai][bj][m][n]; }
    }
};
struct EpiSwiGLU {
    static constexpr bool PERM = true, AFTER_DRAIN = false;
    bf16_t* O; int ldc;
    __device__ __forceinline__ void operator()(const f32x4 (&acc)[2][2][4][2], const Unit& u, int wr, int wc, int fr, int fq) const {
        const int row0 = u.pm * BM + wr * 64 + fr, col0 = u.pn * 128 + wc * 32 + 8 * fq;
#pragma unroll
        for (int ai = 0; ai < 2; ++ai)
#pragma unroll
            for (int m = 0; m < 4; ++m) { bf16_t* rowp = O + (size_t)(row0 + ai * HALF + m * 16) * ldc + col0; float v[8];
#pragma unroll
                for (int n = 0; n < 2; ++n)
#pragma unroll
                    for (int j = 0; j < 4; ++j) v[4 * n + j] = siluf(acc[ai][0][m][n][j]) * acc[ai][1][m][n][j];
                u32x4 w; w.x = cvt_pk_bf16(v[0], v[1]); w.y = cvt_pk_bf16(v[2], v[3]); w.z = cvt_pk_bf16(v[4], v[5]); w.w = cvt_pk_bf16(v[6], v[7]);
                *(u32x4*)rowp = w; }
    }
};
struct EpiBf16 {
    static constexpr bool PERM = true, AFTER_DRAIN = false;
    bf16_t* O; int ldc;
    __device__ __forceinline__ void operator()(const f32x4 (&acc)[2][2][4][2], const Unit& u, int wr, int wc, int fr, int fq) const {
        const int row0 = u.pm * BM + wr * 64 + fr, col0 = u.pn * BM + wc * 32 + 8 * fq;
#pragma unroll
        for (int ai = 0; ai < 2; ++ai)
#pragma unroll
            for (int m = 0; m < 4; ++m) { bf16_t* rowp = O + (size_t)(row0 + ai * HALF + m * 16) * ldc + col0;
#pragma unroll
                for (int bj = 0; bj < 2; ++bj) { const f32x4 v0 = acc[ai][bj][m][0], v1 = acc[ai][bj][m][1];
                    u32x4 w; w.x = cvt_pk_bf16(v0[0], v0[1]); w.y = cvt_pk_bf16(v0[2], v0[3]); w.z = cvt_pk_bf16(v1[0], v1[1]); w.w = cvt_pk_bf16(v1[2], v1[3]);
                    *(u32x4*)(rowp + bj * HALF) = w; } }
    }
};

template <class Epi>
__device__ __forceinline__ void run_gemm(LAS unsigned char* lds, const bf16_t* A, const bf16_t* Bt, int M, int N, int K, const Epi& E, int rot, int ld = 0, int msplit = 0, int gsub = 0, int csub = 0) {
    Gemm g; g.A = A; g.Bt = Bt; g.M = M; g.N = N; g.K = K; g.ld = ld ? ld : K; g.msplit = msplit;
    StaticOrder S; const int G = gridDim.x; if (gsub) S.init(M, N, gsub, csub); else S.init(M, N, G, (int)((blockIdx.x + rot) % G));
    gemm_phase<Epi, StaticOrder, false>(lds, g, S, E, nullptr);
    __syncthreads();
}

__device__ __forceinline__ void phase_prep(const Args& a, int l) {
    const int lane = threadIdx.x & 63, gw = blockIdx.x * 8 + (threadIdx.x >> 6), nw = gridDim.x * 8;
    const bf16_t* P = (const bf16_t*)(a.ws + WS_P); const f32x2* tab = (const f32x2*)(a.ws + WS_TAB);
    float* QR = (float*)(a.ws + WS_QR);
    bf16_t* CQN = (bf16_t*)(a.ws + WS_CQN); bf16_t* CKVN = (bf16_t*)(a.ws + WS_CKVN); bf16_t* KB = (bf16_t*)(a.ws + WS_KB);
    const float* qn = a.in[19] + l * 512; const float* kvn = a.in[21] + l * 256;
    const int i = lane & 31;
    for (int row0 = gw; row0 < MR; row0 += 2 * nw) {
        float q1[2][3], q2[2][3], k1[2], k2[2], cs[2], sn[2]; f32x4 cq0[2], cq1[2], ckv[2]; int rw[2]; bool ok[2];
#pragma unroll
        for (int s2 = 0; s2 < 2; ++s2) { const int r = row0 + s2 * nw; ok[s2] = r < MR; rw[s2] = ok[s2] ? r : row0;
            const int row = rw[s2]; const bool latent = row < MLAT; const int t = latent ? (row & 2047) : 0;
            const bf16_t* pr = P + (size_t)row * INWP;
            const f32x2 cv = tab[t * 32 + i]; cs[s2] = latent ? cv.x : 1.f; sn[s2] = latent ? cv.y : 0.f;
#pragma unroll
            for (int j = 0; j < 3; ++j) { const int hh = (lane >> 5) + 2 * j; q1[s2][j] = bf2f(pr[OFF_RQ + hh * 64 + i]); q2[s2][j] = bf2f(pr[OFF_RQ + hh * 64 + 32 + i]); }
            cq0[s2] = ld_bf4(pr + OFF_CQ + lane * 4); cq1[s2] = ld_bf4(pr + OFF_CQ + 256 + lane * 4); ckv[s2] = ld_bf4(pr + OFF_CKV + lane * 4);
            k1[s2] = bf2f(pr[OFF_KR + i]); k2[s2] = bf2f(pr[OFF_KR + 32 + i]); }
#pragma unroll
        for (int s2 = 0; s2 < 2; ++s2) { if (!ok[s2]) continue;
            const int row = rw[s2]; const bool latent = row < MLAT;
            const int b = latent ? (row >> 11) : ((row - MLAT) >> 8), t = latent ? (row & 2047) : ((row - MLAT) & 255), ki = latent ? 256 + t : t;
#pragma unroll
            for (int j = 0; j < 3; ++j) { const int hh = (lane >> 5) + 2 * j;
                QR[(size_t)row * 384 + hh * 64 + i] = q1[s2][j] * cs[s2] - q2[s2][j] * sn[s2]; QR[(size_t)row * 384 + hh * 64 + 32 + i] = q1[s2][j] * sn[s2] + q2[s2][j] * cs[s2]; }
            { f32x4 v0 = cq0[s2], v1 = cq1[s2];
              float ss = (v0[0] * v0[0] + v0[1] * v0[1]) + (v0[2] * v0[2] + v0[3] * v0[3]) + (v1[0] * v1[0] + v1[1] * v1[1]) + (v1[2] * v1[2] + v1[3] * v1[3]);
              ss = wave_sum(ss); const float r = rsqrtf(ss * (1.f / 512.f) + EPS);
              const f32x4 g0 = *(const f32x4*)(qn + lane * 4), g1 = *(const f32x4*)(qn + 256 + lane * 4);
              v0 = v0 * r * g0; v1 = v1 * r * g1;
              u32x2 w; w.x = cvt_pk_bf16(v0[0], v0[1]); w.y = cvt_pk_bf16(v0[2], v0[3]); *(u32x2*)(CQN + (size_t)row * 512 + lane * 4) = w;
              w.x = cvt_pk_bf16(v1[0], v1[1]); w.y = cvt_pk_bf16(v1[2], v1[3]); *(u32x2*)(CQN + (size_t)row * 512 + 256 + lane * 4) = w; }
            { f32x4 v0 = ckv[s2];
              float ss = (v0[0] * v0[0] + v0[1] * v0[1]) + (v0[2] * v0[2] + v0[3] * v0[3]);
              ss = wave_sum(ss); const float r = rsqrtf(ss * (1.f / 256.f) + EPS);
              const f32x4 g0 = *(const f32x4*)(kvn + lane * 4);
              v0 = v0 * r * g0;
              u32x2 w; w.x = cvt_pk_bf16(v0[0], v0[1]); w.y = cvt_pk_bf16(v0[2], v0[3]); *(u32x2*)(CKVN + (size_t)row * 256 + lane * 4) = w; }
            { const bf16_t o1 = f2bf(k1[s2] * cs[s2] - k2[s2] * sn[s2]), o2 = f2bf(k1[s2] * sn[s2] + k2[s2] * cs[s2]);
              const int h0 = (lane >> 5) * 3;
#pragma unroll
              for (int hh = 0; hh < 3; ++hh) { bf16_t* kp = KB + ((size_t)(b * 6 + h0 + hh) * NKEY + ki) * 192; kp[128 + i] = o1; kp[160 + i] = o2; } } }
    }
}

__device__ __forceinline__ void phase_conv(const Args& a, int l, LAS unsigned char* lds) {
    const int tid = threadIdx.x, lane = tid & 63, wid = tid >> 6;
    const bf16_t* PG = (const bf16_t*)(a.ws + WS_PG); bf16_t* CVN = (bf16_t*)(a.ws + WS_CVN);
    LAS float* red = (LAS float*)lds;
    LAS float* fin = (LAS float*)(lds + 1024);
    float dwc[31];
#pragma unroll
    for (int w = 0; w < 31; ++w) dwc[w] = a.in[14][(size_t)(l * 31 + w) * 512 + tid];
    const float bias = a.in[15][l * 512 + tid], lg = a.in[16][l * 512 + tid], lb = a.in[17][l * 512 + tid];
    for (int it = gridDim.x - 1 - blockIdx.x; it < MR / 16; it += gridDim.x) {
        const int row0 = it * 16;
        int s0, s1; if (row0 < MLAT) { s0 = (row0 >> 11) << 11; s1 = s0 + 2048; } else { s0 = MLAT + (((row0 - MLAT) >> 8) << 8); s1 = s0 + 256; }
        float acc[16], rv[32];
#pragma unroll
        for (int j = 0; j < 16; ++j) acc[j] = bias;
#pragma unroll
        for (int i = 0; i < 46; ++i) { const int r = row0 - 15 + i; const bool ok = (r >= s0 && r < s1); const int rc = ok ? r : row0;
            const float av = bf2f(PG[(size_t)rc * GLUW + tid]), gv = bf2f(PG[(size_t)rc * GLUW + 512 + tid]);
            const float u = ok ? av * sigmf(gv) : 0.f;
#pragma unroll
            for (int j = 0; j < 16; ++j) { const int w = i - j; if (w >= 0 && w <= 30) acc[j] += u * dwc[w]; } }
#pragma unroll
        for (int j = 0; j < 16; ++j) { rv[2 * j] = acc[j]; rv[2 * j + 1] = acc[j] * acc[j]; }
#pragma unroll
        for (int k = 0; k < 16; ++k) { const bool up = (lane & 32) != 0; const float keep = up ? rv[k + 16] : rv[k], send = up ? rv[k] : rv[k + 16]; rv[k] = keep + __shfl_xor(send, 32); }
#pragma unroll
        for (int k = 0; k < 8; ++k) { const bool up = (lane & 16) != 0; const float keep = up ? rv[k + 8] : rv[k], send = up ? rv[k] : rv[k + 8]; rv[k] = keep + __shfl_xor(send, 16); }
#pragma unroll
        for (int k = 0; k < 4; ++k) { const bool up = (lane & 8) != 0; const float keep = up ? rv[k + 4] : rv[k], send = up ? rv[k] : rv[k + 4]; rv[k] = keep + __shfl_xor(send, 8); }
#pragma unroll
        for (int k = 0; k < 2; ++k) { const bool up = (lane & 4) != 0; const float keep = up ? rv[k + 2] : rv[k], send = up ? rv[k] : rv[k + 2]; rv[k] = keep + __shfl_xor(send, 4); }
        { const bool up = (lane & 2) != 0; const float keep = up ? rv[1] : rv[0], send = up ? rv[0] : rv[1]; rv[0] = keep + __shfl_xor(send, 2); }
        rv[0] += __shfl_xor(rv[0], 1);
        if ((lane & 1) == 0) red[wid * 32 + (lane >> 1)] = rv[0];
        __syncthreads();
        if (tid < 32) { float s = 0.f;
#pragma unroll
            for (int w = 0; w < 8; ++w) s += red[w * 32 + tid];
            fin[tid] = s; }
        __syncthreads();
#pragma unroll
        for (int j = 0; j < 16; ++j) { const float mean = fin[2 * j] * (1.f / 512.f), var = fin[2 * j + 1] * (1.f / 512.f) - mean * mean;
            const float y = (acc[j] - mean) * rsqrtf(fmaxf(var, 0.f) + EPS) * lg + lb;
            CVN[(size_t)(row0 + j) * 512 + tid] = f2bf(siluf(y)); }
        __syncthreads();
    }
}

__device__ __forceinline__ void phase_ret_local(const Args& a, LAS unsigned char* lds) {
    const int tid = threadIdx.x;
    const bf16_t* P = (const bf16_t*)(a.ws + WS_P); const f32x2* tab = (const f32x2*)(a.ws + WS_TAB);
    float* SF = (float*)(a.ws + WS_SF); float* SB = (float*)(a.ws + WS_SB);
    LAS float* kl = (LAS float*)lds;
    LAS float* vl = kl + 128 * 64;
    LAS float* wl = vl + 128 * 128;
    for (int it = blockIdx.x; it < 24 * NCH; it += gridDim.x) {
        const int cidx = it % NCH, bh = it / NCH, b = bh / 6, h = bh % 6;
        const bool latent = cidx >= 2;
        const int rowbase = latent ? b * 2048 + (cidx - 2) * 128 : MLAT + b * 256 + cidx * 128, t0 = latent ? (cidx - 2) * 128 : 0;
        const float l2g = log2f(1.f - exp2f(-5.f - (float)h));
#pragma unroll
        for (int j = 0; j < 8; ++j) { const int idx = tid + 512 * j, t = idx >> 5, i = idx & 31;
            const float x1 = bf2f(P[(size_t)(rowbase + t) * INWP + OFF_RK + h * 64 + i]), x2 = bf2f(P[(size_t)(rowbase + t) * INWP + OFF_RK + h * 64 + 32 + i]);
            float cs, sn; rope_cs(tab, i, t0 + t, latent, cs, sn);
            kl[t * 64 + i] = (x1 * cs - x2 * sn) * 0.125f; kl[t * 64 + 32 + i] = (x1 * sn + x2 * cs) * 0.125f; }
#pragma unroll
        for (int ii = 0; ii < 8; ++ii) { const int idx = tid + 512 * ii, j = idx >> 5, c4 = idx & 31;
            *(LAS f32x4*)(vl + j * 128 + c4 * 4) = ld_bf4(P + (size_t)(rowbase + j) * INWP + OFF_RV + h * 128 + c4 * 4); }
        if (tid < 256) { const int t = tid & 127; wl[tid] = exp2f(l2g * (float)(tid < 128 ? 127 - t : t)); }
        __syncthreads();
        { const int lane = tid & 63, wid = tid >> 6, fr = lane & 15, fq = lane >> 4;
          f32x4 accF[4], accB[4];
#pragma unroll
          for (int db = 0; db < 4; ++db) { accF[db] = (f32x4){0.f, 0.f, 0.f, 0.f}; accB[db] = (f32x4){0.f, 0.f, 0.f, 0.f}; }
#pragma unroll
          for (int ks = 0; ks < 4; ++ks) { const int t0q = ks * 32 + fq * 8; float vv[8], wfv[8], wbv[8];
#pragma unroll
              for (int j = 0; j < 8; ++j) { vv[j] = vl[(t0q + j) * 128 + wid * 16 + fr]; wfv[j] = wl[t0q + j]; wbv[j] = wl[128 + t0q + j]; }
              u32x4 w; w.x = cvt_pk_bf16(vv[0], vv[1]); w.y = cvt_pk_bf16(vv[2], vv[3]); w.z = cvt_pk_bf16(vv[4], vv[5]); w.w = cvt_pk_bf16(vv[6], vv[7]);
              const bf16x8 vb = __builtin_bit_cast(bf16x8, w);
#pragma unroll
              for (int db = 0; db < 4; ++db) { float kk[8];
#pragma unroll
                  for (int j = 0; j < 8; ++j) kk[j] = kl[(t0q + j) * 64 + db * 16 + fr];
                  w.x = cvt_pk_bf16(kk[0] * wfv[0], kk[1] * wfv[1]); w.y = cvt_pk_bf16(kk[2] * wfv[2], kk[3] * wfv[3]); w.z = cvt_pk_bf16(kk[4] * wfv[4], kk[5] * wfv[5]); w.w = cvt_pk_bf16(kk[6] * wfv[6], kk[7] * wfv[7]);
                  accF[db] = __builtin_amdgcn_mfma_f32_16x16x32_bf16(__builtin_bit_cast(bf16x8, w), vb, accF[db], 0, 0, 0);
                  w.x = cvt_pk_bf16(kk[0] * wbv[0], kk[1] * wbv[1]); w.y = cvt_pk_bf16(kk[2] * wbv[2], kk[3] * wbv[3]); w.z = cvt_pk_bf16(kk[4] * wbv[4], kk[5] * wbv[5]); w.w = cvt_pk_bf16(kk[6] * wbv[6], kk[7] * wbv[7]);
                  accB[db] = __builtin_amdgcn_mfma_f32_16x16x32_bf16(__builtin_bit_cast(bf16x8, w), vb, accB[db], 0, 0, 0); } }
          float* fo = SF + ((size_t)bh * NCH + cidx) * 8192 + (wid * 16 + fr) * 64 + fq * 4; float* go = SB + ((size_t)bh * NCH + cidx) * 8192 + (wid * 16 + fr) * 64 + fq * 4;
#pragma unroll
          for (int db = 0; db < 4; ++db) { *(f32x4*)(fo + db * 16) = accF[db]; *(f32x4*)(go + db * 16) = accB[db]; } }
        { bf16_t* rk = (bf16_t*)(a.ws + WS_RKB) + ((size_t)bh * NCH + cidx) * 8192; const int tok = tid >> 2, d0 = (tid & 3) * 16;
#pragma unroll
          for (int hq = 0; hq < 2; ++hq) { const f32x4 x0 = *(const LAS f32x4*)(kl + tok * 64 + d0 + hq * 8), x1 = *(const LAS f32x4*)(kl + tok * 64 + d0 + hq * 8 + 4);
              u32x4 w; w.x = cvt_pk_bf16(x0[0], x0[1]); w.y = cvt_pk_bf16(x0[2], x0[3]); w.z = cvt_pk_bf16(x1[0], x1[1]); w.w = cvt_pk_bf16(x1[2], x1[3]);
              *(u32x4*)(rk + tok * 64 + d0 + hq * 8) = w; } }
        { bf16_t* rv = (bf16_t*)(a.ws + WS_RVT) + ((size_t)bh * NCH + cidx) * 16384; const int dv = tid & 127, tg = tid >> 7;
#pragma unroll
          for (int i = 0; i < 4; ++i) { const int t0q = tg * 32 + i * 8; float x[8];
#pragma unroll
              for (int j = 0; j < 8; ++j) x[j] = vl[(t0q + j) * 128 + dv];
              u32x4 w; w.x = cvt_pk_bf16(x[0], x[1]); w.y = cvt_pk_bf16(x[2], x[3]); w.z = cvt_pk_bf16(x[4], x[5]); w.w = cvt_pk_bf16(x[6], x[7]);
              *(u32x4*)(rv + dv * 128 + t0q) = w; } }
        __syncthreads();
    }
}
__device__ __forceinline__ void phase_ret_combine(const Args& a) {
    for (int e = blockIdx.x * NTHR + threadIdx.x; e < 24 * 2 * 2048; e += gridDim.x * NTHR) {
        const int q = e & 2047, bhd = e >> 11, dir = bhd & 1, bh = bhd >> 1, h = bh % 6;
        const float gC = exp2f(128.f * log2f(1.f - exp2f(-5.f - (float)h)));
        float* base = (float*)(a.ws + (dir ? WS_SB : WS_SF)) + (size_t)bh * NCH * 8192 + q * 4;
        f32x4 F[NCH];
#pragma unroll
        for (int c = 0; c < NCH; ++c) F[c] = *(const f32x4*)(base + (size_t)c * 8192);
        f32x4 S = {0.f, 0.f, 0.f, 0.f};
        if (dir == 0) {
#pragma unroll
            for (int c = 0; c < NCH; ++c) { *(f32x4*)(base + (size_t)c * 8192) = S; S = S * gC + F[c]; }
        } else {
#pragma unroll
            for (int st = 0; st < NCH; ++st) { const int c = st < 2 ? 1 - st : 19 - st; *(f32x4*)(base + (size_t)c * 8192) = S; S = S * gC + F[c]; }
        }
    }
}

constexpr int RK_STRIDE = 144, RV_STRIDE = 272;
__device__ __forceinline__ void phase_ret_out(const Args& a, int l, LAS unsigned char* lds) {
    const int tid = threadIdx.x, lane = tid & 63, wid = tid >> 6, fr = lane & 15, fq = lane >> 4;
    const bf16_t* P = (const bf16_t*)(a.ws + WS_P); const float* QR = (const float*)(a.ws + WS_QR);
    const float* SF = (const float*)(a.ws + WS_SF); const float* SB = (const float*)(a.ws + WS_SB); bf16_t* CAT = (bf16_t*)(a.ws + WS_CAT);
    LAS unsigned char* Kb = lds;
    LAS unsigned char* Vt = Kb + 128 * RK_STRIDE;
    LAS unsigned char* St = Vt + 128 * RV_STRIDE;
    const int nch = (l == 0) ? 18 : 16, nitem = 24 * nch;
    for (int it = blockIdx.x; it < nitem; it += gridDim.x) {
        const int c = it % nch, bh = it / nch, cidx = c + (18 - nch), b = bh / 6, h = bh % 6;
        const int rowbase = cidx < 2 ? MLAT + b * 256 + cidx * 128 : b * 2048 + (cidx - 2) * 128;
        const float l2g = log2f(1.f - exp2f(-5.f - (float)h));
        { const bf16_t* rk = (const bf16_t*)(a.ws + WS_RKB) + ((size_t)bh * NCH + cidx) * 8192;
          const bf16_t* rv = (const bf16_t*)(a.ws + WS_RVT) + ((size_t)bh * NCH + cidx) * 16384;
          const float* sf = SF + ((size_t)bh * NCH + cidx) * 8192; const float* sb = SB + ((size_t)bh * NCH + cidx) * 8192;
#pragma unroll
          for (int i = 0; i < 2; ++i) { const int idx = tid + 512 * i, r = idx >> 3, cc = idx & 7; *(LAS u32x4*)(Kb + r * RK_STRIDE + cc * 16) = *(const u32x4*)(rk + r * 64 + cc * 8); }
#pragma unroll
          for (int i = 0; i < 4; ++i) { const int idx = tid + 512 * i, r = idx >> 4, cc = idx & 15; *(LAS u32x4*)(Vt + r * RV_STRIDE + cc * 16) = *(const u32x4*)(rv + r * 128 + cc * 8); }
#pragma unroll
          for (int i = 0; i < 4; ++i) { const int idx = tid + 512 * i, r = idx >> 4, c4 = idx & 15;
              const f32x4 f4 = *(const f32x4*)(sf + r * 64 + c4 * 4), b4 = *(const f32x4*)(sb + r * 64 + c4 * 4);
              u32x2 w; w.x = cvt_pk_bf16(f4[0], f4[1]); w.y = cvt_pk_bf16(f4[2], f4[3]); *(LAS u32x2*)(St + r * RV_STRIDE + c4 * 8) = w;
              w.x = cvt_pk_bf16(b4[0], b4[1]); w.y = cvt_pk_bf16(b4[2], b4[3]); *(LAS u32x2*)(St + r * RV_STRIDE + 128 + c4 * 8) = w; } }
        const int il = wid * 16 + fr, row = rowbase + il;
        f32x4 qv[2][2];
#pragma unroll
        for (int ks = 0; ks < 2; ++ks) { qv[ks][0] = *(const f32x4*)(QR + (size_t)row * 384 + h * 64 + ks * 32 + fq * 8); qv[ks][1] = *(const f32x4*)(QR + (size_t)row * 384 + h * 64 + ks * 32 + fq * 8 + 4); }
        const float wf = exp2f(l2g * (float)(il + 1)), wb = exp2f(l2g * (float)(128 - il));
        bf16x8 qb[2], qw[4];
#pragma unroll
        for (int ks = 0; ks < 2; ++ks) { const f32x4 x0 = qv[ks][0], x1 = qv[ks][1]; u32x4 w;
            w.x = cvt_pk_bf16(x0[0], x0[1]); w.y = cvt_pk_bf16(x0[2], x0[3]); w.z = cvt_pk_bf16(x1[0], x1[1]); w.w = cvt_pk_bf16(x1[2], x1[3]); qb[ks] = __builtin_bit_cast(bf16x8, w);
            const f32x4 y0 = x0 * wf, y1 = x1 * wf, z0 = x0 * wb, z1 = x1 * wb;
            w.x = cvt_pk_bf16(y0[0], y0[1]); w.y = cvt_pk_bf16(y0[2], y0[3]); w.z = cvt_pk_bf16(y1[0], y1[1]); w.w = cvt_pk_bf16(y1[2], y1[3]); qw[ks] = __builtin_bit_cast(bf16x8, w);
            w.x = cvt_pk_bf16(z0[0], z0[1]); w.y = cvt_pk_bf16(z0[2], z0[3]); w.z = cvt_pk_bf16(z1[0], z1[1]); w.w = cvt_pk_bf16(z1[2], z1[3]); qw[2 + ks] = __builtin_bit_cast(bf16x8, w); }
        __syncthreads();
        bf16x8 pf[4];
#pragma unroll
        for (int p = 0; p < 4; ++p) { f32x4 s0 = {0.f, 0.f, 0.f, 0.f}, s1 = {0.f, 0.f, 0.f, 0.f};
            const int kr0 = p * 32 + (fr >> 2) * 8 + (fr & 3);
#pragma unroll
            for (int ks = 0; ks < 2; ++ks) { const bf16x8 k0 = *(const LAS bf16x8*)(Kb + kr0 * RK_STRIDE + ks * 64 + fq * 16), k1 = *(const LAS bf16x8*)(Kb + (kr0 + 4) * RK_STRIDE + ks * 64 + fq * 16);
                s0 = __builtin_amdgcn_mfma_f32_16x16x32_bf16(k0, qb[ks], s0, 0, 0, 0); s1 = __builtin_amdgcn_mfma_f32_16x16x32_bf16(k1, qb[ks], s1, 0, 0, 0); }
#pragma unroll
            for (int j = 0; j < 4; ++j) { const int k0i = p * 32 + fq * 8 + j, k1i = k0i + 4; const int d0 = il > k0i ? il - k0i : k0i - il, d1 = il > k1i ? il - k1i : k1i - il;
                s0[j] *= exp2f(l2g * (float)d0); s1[j] *= exp2f(l2g * (float)d1); }
            u32x4 w; w.x = cvt_pk_bf16(s0[0], s0[1]); w.y = cvt_pk_bf16(s0[2], s0[3]); w.z = cvt_pk_bf16(s1[0], s1[1]); w.w = cvt_pk_bf16(s1[2], s1[3]); pf[p] = __builtin_bit_cast(bf16x8, w); }
        f32x4 o[8];
#pragma unroll
        for (int db = 0; db < 8; ++db) o[db] = (f32x4){0.f, 0.f, 0.f, 0.f};
#pragma unroll
        for (int p = 0; p < 4; ++p)
#pragma unroll
            for (int db = 0; db < 8; ++db) { const bf16x8 vf = *(const LAS bf16x8*)(Vt + (db * 16 + fr) * RV_STRIDE + p * 64 + fq * 16), sfr = *(const LAS bf16x8*)(St + (db * 16 + fr) * RV_STRIDE + p * 64 + fq * 16);
                o[db] = __builtin_amdgcn_mfma_f32_16x16x32_bf16(vf, pf[p], o[db], 0, 0, 0);
                o[db] = __builtin_amdgcn_mfma_f32_16x16x32_bf16(sfr, qw[p], o[db], 0, 0, 0); }
        float sm = 0.f;
#pragma unroll
        for (int db = 0; db < 8; ++db) sm += (o[db][0] + o[db][1]) + (o[db][2] + o[db][3]);
        sm += __shfl_xor(sm, 16); sm += __shfl_xor(sm, 32);
        const float mu = sm * (1.f / 128.f); float qd = 0.f;
#pragma unroll
        for (int db = 0; db < 8; ++db) { o[db] = o[db] - mu; qd += (o[db][0] * o[db][0] + o[db][1] * o[db][1]) + (o[db][2] * o[db][2] + o[db][3] * o[db][3]); }
        qd += __shfl_xor(qd, 16); qd += __shfl_xor(qd, 32);
        const float rstd = rsqrtf(qd * (1.f / 128.f) + EPS);
#pragma unroll
        for (int db = 0; db < 8; ++db) { const int cc = h * 128 + db * 16 + fq * 4;
            const f32x4 rg = ld_bf4(P + (size_t)row * INWP + OFF_RG + cc), gn4 = *(const f32x4*)(a.in[13] + l * 768 + cc); float v[4];
#pragma unroll
            for (int e = 0; e < 4; ++e) v[e] = siluf(rg[e]) * (o[db][e] * rstd * gn4[e]);
            u32x2 w; w.x = cvt_pk_bf16(v[0], v[1]); w.y = cvt_pk_bf16(v[2], v[3]);
            *(u32x2*)(CAT + (size_t)row * D + cc) = w; }
        __syncthreads();
    }
}

__device__ __forceinline__ void phase_post(const Args& a) {
    const int lane = threadIdx.x & 63, gw = blockIdx.x * 8 + (threadIdx.x >> 6), nw = gridDim.x * 8;
    const bf16_t* QF = (const bf16_t*)(a.ws + WS_QF); const bf16_t* KVF = (const bf16_t*)(a.ws + WS_KVF);
    bf16_t* QB = (bf16_t*)(a.ws + WS_QB); bf16_t* KB = (bf16_t*)(a.ws + WS_KB); bf16_t* VT = (bf16_t*)(a.ws + WS_VT);
    const float qscale = 0.07216878364870322f * 1.4426950408889634f;
    for (int wi = gw; wi < MR / 8; wi += nw) {
        const int r0 = wi * 8; const bool latent = r0 < MLAT;
        const int b = latent ? (r0 >> 11) : ((r0 - MLAT) >> 8), t0 = latent ? (r0 & 2047) : ((r0 - MLAT) & 255), ki0 = latent ? 256 + t0 : t0;
        const int i = lane & 31; const f32x2* tab = (const f32x2*)(a.ws + WS_TAB);
        for (int r4 = 0; r4 < 8; r4 += 4) {
            u32x2 qraw[4][3], kraw[4][3]; float x1[4][3], x2[4][3], cs[4], sn[4];
#pragma unroll
            for (int rr = 0; rr < 4; ++rr) { const int row = r0 + r4 + rr, t = t0 + r4 + rr;
                const f32x2 cv = tab[(latent ? t : 0) * 32 + i]; cs[rr] = latent ? cv.x : 1.f; sn[rr] = latent ? cv.y : 0.f;
#pragma unroll
                for (int ii = 0; ii < 3; ++ii) { const int idx = lane * 4 + ii * 256, hh = idx >> 7, dd = idx & 127;
                    qraw[rr][ii] = *(const u32x2*)(QF + (size_t)row * 1280 + hh * 192 + dd); kraw[rr][ii] = *(const u32x2*)(KVF + (size_t)row * 1536 + hh * 256 + dd); }
#pragma unroll
                for (int j = 0; j < 3; ++j) { const int hh = (lane >> 5) + 2 * j; x1[rr][j] = bf2f(QF[(size_t)row * 1280 + hh * 192 + 128 + i]); x2[rr][j] = bf2f(QF[(size_t)row * 1280 + hh * 192 + 160 + i]); } }
#pragma unroll
            for (int rr = 0; rr < 4; ++rr) { const int ki = ki0 + r4 + rr;
#pragma unroll
                for (int ii = 0; ii < 3; ++ii) { const int idx = lane * 4 + ii * 256, hh = idx >> 7, dd = idx & 127;
                    const u32x2 qw = qraw[rr][ii];
                    const f32x4 q4 = (f32x4){__uint_as_float(qw.x << 16), __uint_as_float(qw.x & 0xffff0000u), __uint_as_float(qw.y << 16), __uint_as_float(qw.y & 0xffff0000u)} * qscale;
                    u32x2 w; w.x = cvt_pk_bf16(q4[0], q4[1]); w.y = cvt_pk_bf16(q4[2], q4[3]);
                    *(u32x2*)(QB + ((size_t)(b * 6 + hh) * NKEY + ki) * 192 + dd) = w;
                    *(u32x2*)(KB + ((size_t)(b * 6 + hh) * NKEY + ki) * 192 + dd) = kraw[rr][ii]; }
#pragma unroll
                for (int j = 0; j < 3; ++j) { const int hh = (lane >> 5) + 2 * j;
                    bf16_t* qp = QB + ((size_t)(b * 6 + hh) * NKEY + ki) * 192;
                    qp[128 + i] = f2bf((x1[rr][j] * cs[rr] - x2[rr][j] * sn[rr]) * qscale); qp[160 + i] = f2bf((x1[rr][j] * sn[rr] + x2[rr][j] * cs[rr]) * qscale); } } }
#pragma unroll 4
        for (int ii = 0; ii < 12; ++ii) { const int hd = lane + 64 * ii, hh = hd >> 7, dv = hd & 127; bf16_t v[8];
#pragma unroll
            for (int rr = 0; rr < 8; ++rr) v[rr] = KVF[(size_t)(r0 + rr) * 1536 + hh * 256 + 128 + dv];
            u32x4 w; w.x = (unsigned)v[0] | ((unsigned)v[1] << 16); w.y = (unsigned)v[2] | ((unsigned)v[3] << 16); w.z = (unsigned)v[4] | ((unsigned)v[5] << 16); w.w = (unsigned)v[6] | ((unsigned)v[7] << 16);
            *(u32x4*)(VT + (((size_t)(b * 6 + hh) * 36 + (ki0 >> 6)) * 128 + dv) * 64 + (ki0 & 63)) = w; }
    }
}

constexpr int KS_STRIDE = 400, VS_STRIDE = 144, KS_BYTES = 64 * KS_STRIDE, VS_BYTES = 128 * VS_STRIDE, ATT_BUF = KS_BYTES + VS_BYTES;
__device__ __forceinline__ void phase_attn(const Args& a, int l, LAS unsigned char* lds) {
    const int tid = threadIdx.x, lane = tid & 63, wid = tid >> 6, fr = lane & 15, fq = lane >> 4;
    const bf16_t* QB = (const bf16_t*)(a.ws + WS_QB); const bf16_t* KB = (const bf16_t*)(a.ws + WS_KB); const bf16_t* VT = (const bf16_t*)(a.ws + WS_VT);
    bf16_t* CAT = (bf16_t*)(a.ws + WS_CAT);
    LAS unsigned char* kring = lds; LAS unsigned char* vring = lds + 2 * KS_BYTES;
    const int nqt = (l == 0) ? 9 : 8, nitem = 24 * nqt;
    for (int it = blockIdx.x; it < nitem; it += gridDim.x) {
        const int bh = it % 24, qi = it / 24, qt = (l == 0) ? (qi == 8 ? 0 : qi + 1) : qi + 1, b = bh / 6, h = bh % 6;
        const int nk = (qt == 0) ? 256 : NKEY, ntile = nk / 64;
        const bf16_t* kbase = KB + (size_t)bh * NKEY * 192; const bf16_t* vbase = VT + (size_t)bh * 128 * NKEY; const bf16_t* qbase = QB + (size_t)bh * NKEY * 192;
        const int q0 = qt * 256 + wid * 32;
        bf16x8 qf[2][6];
#pragma unroll
        for (int g = 0; g < 2; ++g)
#pragma unroll
            for (int ks = 0; ks < 6; ++ks) qf[g][ks] = *(const bf16x8*)(qbase + (size_t)(q0 + g * 16 + fr) * 192 + ks * 32 + fq * 8);
        f32x4 o[8][2];
#pragma unroll
        for (int db = 0; db < 8; ++db) { o[db][0] = (f32x4){0.f, 0.f, 0.f, 0.f}; o[db][1] = (f32x4){0.f, 0.f, 0.f, 0.f}; }
        float mrun[2] = {-1e30f, -1e30f}, lrun[2] = {0.f, 0.f};
        u32x4 kst[3], vst[2];
#define AT_KLOAD(tile) do { const bf16_t* kp_ = kbase + (size_t)(tile) * (64 * 192) + tid * 8; _Pragma("unroll") for (int i = 0; i < 3; ++i) kst[i] = *(const u32x4*)(kp_ + i * 4096); } while (0)
#define AT_VLOAD(tile) do { const bf16_t* vp_ = vbase + (size_t)(tile) * (128 * 64) + tid * 8; _Pragma("unroll") for (int i = 0; i < 2; ++i) vst[i] = *(const u32x4*)(vp_ + i * 4096); } while (0)
#define AT_KSTORE(buf) do { LAS unsigned char* kb_ = kring + (buf) * KS_BYTES; _Pragma("unroll") for (int i = 0; i < 3; ++i) { const int c = tid + 512 * i, r = c / 24, cc = c % 24; *(LAS u32x4*)(kb_ + r * KS_STRIDE + cc * 16) = kst[i]; } } while (0)
#define AT_VSTORE(buf) do { LAS unsigned char* vb_ = vring + (buf) * VS_BYTES; _Pragma("unroll") for (int i = 0; i < 2; ++i) { const int c = tid + 512 * i, r = c >> 3, cc = c & 7; *(LAS u32x4*)(vb_ + r * VS_STRIDE + cc * 16) = vst[i]; } } while (0)
#define AT_QK(sx, buf) do { LAS unsigned char* kb_ = kring + (buf) * KS_BYTES; \
            _Pragma("unroll") for (int kbk = 0; kbk < 4; ++kbk) { sx[kbk][0] = (f32x4){0.f, 0.f, 0.f, 0.f}; sx[kbk][1] = (f32x4){0.f, 0.f, 0.f, 0.f}; \
                const int krow = (kbk >> 1) * 32 + (fr >> 2) * 8 + (kbk & 1) * 4 + (fr & 3); \
                _Pragma("unroll") for (int ks = 0; ks < 6; ++ks) { const bf16x8 kf = *(const LAS bf16x8*)(kb_ + krow * KS_STRIDE + ks * 64 + fq * 16); \
                    sx[kbk][0] = __builtin_amdgcn_mfma_f32_16x16x32_bf16(kf, qf[0][ks], sx[kbk][0], 0, 0, 0); \
                    sx[kbk][1] = __builtin_amdgcn_mfma_f32_16x16x32_bf16(kf, qf[1][ks], sx[kbk][1], 0, 0, 0); } } } while (0)
#define AT_SMPV(sx, buf) do { LAS unsigned char* vb_ = vring + (buf) * VS_BYTES; bf16x8 pf[2][2]; \
            _Pragma("unroll") for (int g = 0; g < 2; ++g) { \
                float mx = sx[0][g][0]; \
                _Pragma("unroll") for (int kbk = 0; kbk < 4; ++kbk) _Pragma("unroll") for (int j = 0; j < 4; ++j) mx = fmaxf(mx, sx[kbk][g][j]); \
                mx = fmaxf(mx, __shfl_xor(mx, 16)); mx = fmaxf(mx, __shfl_xor(mx, 32)); \
                const float mnew = fmaxf(mrun[g], mx), alpha = __builtin_amdgcn_exp2f(mrun[g] - mnew); mrun[g] = mnew; \
                float ps = 0.f; \
                _Pragma("unroll") for (int kbk = 0; kbk < 4; ++kbk) _Pragma("unroll") for (int j = 0; j < 4; ++j) { const float p = __builtin_amdgcn_exp2f(sx[kbk][g][j] - mnew); sx[kbk][g][j] = p; ps += p; } \
                lrun[g] = lrun[g] * alpha + ps; \
                _Pragma("unroll") for (int db = 0; db < 8; ++db) o[db][g] *= alpha; \
                _Pragma("unroll") for (int p = 0; p < 2; ++p) { u32x4 w; w.x = cvt_pk_bf16(sx[2 * p][g][0], sx[2 * p][g][1]); w.y = cvt_pk_bf16(sx[2 * p][g][2], sx[2 * p][g][3]); \
                    w.z = cvt_pk_bf16(sx[2 * p + 1][g][0], sx[2 * p + 1][g][1]); w.w = cvt_pk_bf16(sx[2 * p + 1][g][2], sx[2 * p + 1][g][3]); pf[g][p] = __builtin_bit_cast(bf16x8, w); } } \
            _Pragma("unroll") for (int p = 0; p < 2; ++p) _Pragma("unroll") for (int db = 0; db < 8; ++db) { const bf16x8 vf = *(const LAS bf16x8*)(vb_ + (db * 16 + fr) * VS_STRIDE + p * 64 + fq * 16); \
                o[db][0] = __builtin_amdgcn_mfma_f32_16x16x32_bf16(vf, pf[0][p], o[db][0], 0, 0, 0); \
                o[db][1] = __builtin_amdgcn_mfma_f32_16x16x32_bf16(vf, pf[1][p], o[db][1], 0, 0, 0); } } while (0)
        AT_KLOAD(0); AT_VLOAD(0); AT_KSTORE(0); AT_VSTORE(0);
        __syncthreads();
        f32x4 sx[4][2];
        int vb_cur = 0, vb_prev = 2;
        for (int tile = 0; tile < ntile; ++tile) {
            const int kb_cur = tile & 1, vb_nxt = (vb_cur == 2) ? 0 : vb_cur + 1;
            if (tile + 1 < ntile) { AT_KLOAD(tile + 1); AT_VLOAD(tile + 1); }
            if (wid < 4) { AT_QK(sx, kb_cur); AT_SMPV(sx, vb_cur); }
            else { if (tile > 0) AT_SMPV(sx, vb_prev); AT_QK(sx, kb_cur); }
            if (tile + 1 < ntile) { AT_KSTORE(kb_cur ^ 1); AT_VSTORE(vb_nxt); }
            __syncthreads();
            vb_prev = vb_cur; vb_cur = vb_nxt;
        }
        if (wid >= 4) AT_SMPV(sx, vb_prev);
        __syncthreads();
#pragma unroll
        for (int g = 0; g < 2; ++g) { float lt = lrun[g]; lt += __shfl_xor(lt, 16); lt += __shfl_xor(lt, 32); const float inv = 1.f / lt;
            const int q = q0 + g * 16 + fr; const int row = q < 256 ? MLAT + b * 256 + q : b * 2048 + (q - 256);
#pragma unroll
            for (int db = 0; db < 8; ++db) { const f32x4 v = o[db][g] * inv; u32x2 w; w.x = cvt_pk_bf16(v[0], v[1]); w.y = cvt_pk_bf16(v[2], v[3]);
                *(u32x2*)(CAT + (size_t)row * D + 1280 + h * 128 + db * 16 + fq * 4) = w; } }
#undef AT_KLOAD
#undef AT_VLOAD
#undef AT_KSTORE
#undef AT_VSTORE
#undef AT_QK
#undef AT_SMPV
    }
}

constexpr int PH_PER_LAYER = 13, NPHASE = 2 + 2 * PH_PER_LAYER;

template <int LP>
__device__ __forceinline__ void layer_phase(const Args& a, const int l, LAS unsigned char* lds) {
    unsigned char* ws = a.ws; const bool last = (l == 1); const int Mlate = last ? MLAT : MR;
    bf16_t* H = (bf16_t*)(ws + WS_H); bf16_t* ACT = (bf16_t*)(ws + WS_P); bf16_t* Y = (bf16_t*)(ws + WS_Y); bf16_t* CAT = (bf16_t*)(ws + WS_CAT);
    if constexpr (LP == 0) { EpiSwiGLU E; E.O = ACT; E.ldc = DFF; run_gemm(lds, H, (const bf16_t*)(ws + WS_WFFIN + (size_t)(l * 2) * SZ_WFFIN), MR, 2 * DFF, D, E, 0); deferred_window(a, l, DW_IDLE2, DW_START2, DW_Q2, lds); }
    if constexpr (LP == 1) { const bf16_t* W = (const bf16_t*)(ws + WS_WFFOUT + (size_t)(l * 2) * SZ_WFFOUT);
        { EpiBf16 E; E.O = Y; E.ldc = D; run_gemm(lds, ACT, W, MLAT, D, DFF, E, 0); }
        { EpiF32 E; E.C = (float*)(ws + WS_YP); E.ldc = D; run_gemm(lds, ACT + (size_t)MLAT * DFF, W, 4 * MCTX, D, DFF / 4, E, 0, DFF, MCTX / 256); } deferred_window(a, l, DW_IDLE3, DW_START3, DW_Q3, lds); }
    if constexpr (LP == 2) phase_resnorm(a, l, 1, 2, 0.5f, true, l, 2, 3, 4, false, MR, lds);
    if constexpr (LP == 3) { EpiBf16 E; E.O = (bf16_t*)(ws + WS_P); E.ldc = INWP; run_gemm(lds, H, (const bf16_t*)(ws + WS_WIN + (size_t)l * SZ_WIN), MR, INWP, D, E, 0); deferred_window(a, l, DW_IDLE5, DW_START5, DW_Q5, lds); }
    if constexpr (LP == 4) { if (a.sub & 1) phase_prep(a, l); if (a.sub & 4) phase_ret_local(a, lds); }
    if constexpr (LP == 5) {
        {
          const int G = gridDim.x, bid = (int)blockIdx.x; const bool part = (G == DEFER_GRID);
          if (!part || bid < 144) { EpiBf16 E; E.O = (bf16_t*)(ws + WS_PG); E.ldc = GLUW; run_gemm(lds, H, (const bf16_t*)(ws + WS_WGLU + (size_t)l * SZ_WGLU), MR, GLUW, D, E, 0, 0, 0, part ? 144 : 0, bid); }
          if (!part || bid >= 144) {
              { EpiBf16 E; E.O = (bf16_t*)(ws + WS_QF); E.ldc = 1280; run_gemm(lds, (const bf16_t*)(ws + WS_CQN), (const bf16_t*)(ws + WS_WUQ + (size_t)l * SZ_WUQ), MR, 1280, 512, E, 0, 0, 0, part ? G - 144 : 0, bid - 144); }
              { EpiBf16 E; E.O = (bf16_t*)(ws + WS_KVF); E.ldc = 1536; run_gemm(lds, (const bf16_t*)(ws + WS_CKVN), (const bf16_t*)(ws + WS_WUKV + (size_t)l * SZ_WUKV), MR, 1536, 256, E, 0, 0, 0, part ? G - 144 : 0, part ? (bid - 144 + 68) % (DEFER_GRID - 144) : 0); } } }
        if (a.sub & 256) phase_ret_combine(a);
    }
    if constexpr (LP == 6) { if (a.sub & 2) phase_conv(a, l, lds); if (a.sub & 8) phase_post(a); if (a.sub & 16) phase_ret_out(a, l, lds); }
    if constexpr (LP == 7) { phase_attn(a, l, lds);
        { const int nitem = 24 * (last ? 8 : 9), G = gridDim.x;
          if ((int)blockIdx.x >= nitem && G > nitem) { EpiBf16 E; E.O = CAT + 768; E.ldc = D; run_gemm(lds, (const bf16_t*)(ws + WS_CVN), (const bf16_t*)(ws + WS_WPW + (size_t)l * SZ_WPW), MR, 512, 512, E, 0, 0, 0, G - nitem, (int)blockIdx.x - nitem); }
          else if (G <= nitem) { EpiBf16 E; E.O = CAT + 768; E.ldc = D; run_gemm(lds, (const bf16_t*)(ws + WS_CVN), (const bf16_t*)(ws + WS_WPW + (size_t)l * SZ_WPW), MR, 512, 512, E, 0); } }
        deferred_window(a, l, DW_IDLE9, DW_START9, DW_Q9, lds); }
    if constexpr (LP == 8) { const bf16_t* W = (const bf16_t*)(ws + WS_WOUT + (size_t)l * SZ_WOUT);
        { EpiBf16 E; E.O = Y; E.ldc = D; run_gemm(lds, CAT, W, MLAT, D, D, E, 0); }
        if (!last) { EpiF32 E; E.C = (float*)(ws + WS_YP); E.ldc = D; run_gemm(lds, CAT + (size_t)MLAT * D, W, 4 * MCTX, D, D / 4, E, 0, D, MCTX / 256); } deferred_window(a, l, DW_IDLE10, DW_START10, DW_Q10, lds); }
    if constexpr (LP == 9) phase_resnorm(a, l, 3, 5, 1.0f, true, l, 4, 6, 7, false, Mlate, lds);
    if constexpr (LP == 10) { EpiSwiGLU E; E.O = ACT; E.ldc = DFF; run_gemm(lds, H, (const bf16_t*)(ws + WS_WFFIN + (size_t)(l * 2 + 1) * SZ_WFFIN), Mlate, 2 * DFF, D, E, 0); deferred_window(a, l, DW_IDLE12, DW_START12, DW_Q12, lds); }
    if constexpr (LP == 11) { const bf16_t* W = (const bf16_t*)(ws + WS_WFFOUT + (size_t)(l * 2 + 1) * SZ_WFFOUT);
        { EpiBf16 E; E.O = Y; E.ldc = D; run_gemm(lds, ACT, W, MLAT, D, DFF, E, 0); }
        if (!last) { EpiF32 E; E.C = (float*)(ws + WS_YP); E.ldc = D; run_gemm(lds, ACT + (size_t)MLAT * DFF, W, 4 * MCTX, D, DFF / 4, E, 0, DFF, MCTX / 256); } deferred_window(a, l, DW_IDLE13, DW_START13, DW_Q13, lds); }
    if constexpr (LP == 12) phase_resnorm(a, l, 5, 8, 0.5f, !last, last ? l : l + 1, 0, 0, 1, last, Mlate, lds);
}

__global__ void __launch_bounds__(NTHR, 2) hybrid_fwd(Args a) {
    extern __shared__ __attribute__((aligned(16))) unsigned char lds_raw[];
    LAS unsigned char* lds = (LAS unsigned char*)lds_raw;
    cg::grid_group grid = cg::this_grid();
    volatile LAS unsigned* xst = (volatile LAS unsigned*)(lds + LDS_BYTES - 16);
    if (threadIdx.x == 0) { xst[0] = 0u; xst[1] = 0u; }
    __syncthreads();
    XcdBarrier xbar = xcd_barrier_post((unsigned*)(a.ws + WS_BAR), xst);
#ifndef REPMASK
#define REPMASK 0ull
#endif
#define RUN_PH(ph, stmt) if (a.ph_lo <= (ph) && (ph) < a.ph_hi) { if ((ph) > a.ph_lo) { if ((ph) == 1) grid.sync(); else xcd_barrier(xbar); } stmt; }
    RUN_PH(0, phase_prologue(a, lds))
    RUN_PH(1, phase_norm0(a, lds))
#define RUN_LAYER(l) \
    RUN_PH(2 + (l) * 13 + 0, layer_phase<0>(a, l, lds)) RUN_PH(2 + (l) * 13 + 1, layer_phase<1>(a, l, lds)) RUN_PH(2 + (l) * 13 + 2, layer_phase<2>(a, l, lds)) \
    RUN_PH(2 + (l) * 13 + 3, layer_phase<3>(a, l, lds)) RUN_PH(2 + (l) * 13 + 4, layer_phase<4>(a, l, lds)) RUN_PH(2 + (l) * 13 + 5, layer_phase<5>(a, l, lds)) \
    RUN_PH(2 + (l) * 13 + 6, layer_phase<6>(a, l, lds)) RUN_PH(2 + (l) * 13 + 7, layer_phase<7>(a, l, lds)) RUN_PH(2 + (l) * 13 + 8, layer_phase<8>(a, l, lds)) \
    RUN_PH(2 + (l) * 13 + 9, layer_phase<9>(a, l, lds)) RUN_PH(2 + (l) * 13 + 10, layer_phase<10>(a, l, lds)) RUN_PH(2 + (l) * 13 + 11, layer_phase<11>(a, l, lds)) \
    RUN_PH(2 + (l) * 13 + 12, layer_phase<12>(a, l, lds))
    RUN_LAYER(0)
    RUN_LAYER(1)
#ifdef EXTRA_SYNCS
    if (a.ph_hi - a.ph_lo > 1) { for (int i = 0; i < EXTRA_SYNCS; ++i) grid.sync(); }
#endif
}

#ifndef ONE_LAUNCH
#define ONE_LAUNCH 0
#endif

extern "C" void kernel_launch(void* const* d_in, const int* in_sizes, int n_in, void* d_out, int out_size, void* d_ws, size_t ws_size, hipStream_t stream) {
    static int grid = 0;
    if (grid == 0) {
        if (n_in != 23 || ws_size < WS_END) { fprintf(stderr, "kernel_launch: need 23 inputs and %zu bytes of workspace; got %d, %zu\n", (size_t)WS_END, n_in, ws_size); grid = -1; return; }
        int dev = 0, cus = 0, per_cu = 0;
        hipGetDevice(&dev); hipDeviceGetAttribute(&cus, hipDeviceAttributeMultiprocessorCount, dev);
        if (hipFuncSetAttribute((const void*)hybrid_fwd, hipFuncAttributeMaxDynamicSharedMemorySize, LDS_BYTES) != hipSuccess) { fprintf(stderr, "kernel_launch: hipFuncSetAttribute failed\n"); grid = -1; return; }
        if (hipOccupancyMaxActiveBlocksPerMultiprocessor(&per_cu, (const void*)hybrid_fwd, NTHR, LDS_BYTES) != hipSuccess || per_cu < 1) { fprintf(stderr, "kernel_launch: occupancy query gave %d\n", per_cu); per_cu = 1; }
        (void)hipGetLastError();
        grid = cus * 1;
        fprintf(stderr, "kernel_launch: grid %d (per_cu %d)\n", grid, per_cu);
    }
    if (grid < 0) return;
    if (hipMemsetAsync((char*)d_ws + WS_BAR, 0, 16384, stream) != hipSuccess) { fprintf(stderr, "kernel_launch: memset failed\n"); return; }
    Args a{};
    for (int i = 0; i < 23; ++i) a.in[i] = (const float*)d_in[i];
    a.out = (float*)d_out; a.ws = (unsigned char*)d_ws; a.sub = ~0ull;
#if ONE_LAUNCH
    a.ph_lo = 0; a.ph_hi = NPHASE;
    { void* args[] = {&a}; hipError_t e = hipLaunchCooperativeKernel((const void*)hybrid_fwd, dim3(grid), dim3(NTHR), args, LDS_BYTES, stream);
      if (e != hipSuccess) fprintf(stderr, "cooperative launch failed: %s\n", hipGetErrorString(e)); }
#ifdef EXTRA_PH
    { const int extra[] = EXTRA_PH; a.sub = EXTRA_SUB; for (int ph : extra) { a.ph_lo = ph; a.ph_hi = ph + 1; void* args[] = {&a}; (void)hipLaunchCooperativeKernel((const void*)hybrid_fwd, dim3(grid), dim3(NTHR), args, LDS_BYTES, stream); } }
#endif
#else
    for (int ph = 0; ph < NPHASE; ++ph) {
        a.ph_lo = ph; a.ph_hi = ph + 1;
        void* args[] = {&a}; hipError_t e = hipLaunchCooperativeKernel((const void*)hybrid_fwd, dim3(grid), dim3(NTHR), args, LDS_BYTES, stream);
        if (e != hipSuccess) { fprintf(stderr, "launch %d failed: %s\n", ph, hipGetErrorString(e)); break; }
    }
#endif
}
```
